# Optimizing an MI355X kernel written in HIP

```python
import math
import jax, jax.numpy as jnp
from jax import lax
import numpy as np

D_MODEL = 1024
BATCH = 8
SEQ = 2048
DEPTH = 2
DEC_BATCH = 4
DEC_SEQ = 4096
PAST_LEN = 128

N_MEM = 256
HY_WIDTH = 512
HY_CONV = 3
HY_EMB = 33
HY_BANDS = (HY_EMB - 1) // 2
HY_ORDER = 64
HY_DECAY_TARGET = 1e-2
HY_FAST_PCT = 0.3
HY_SLOW_PCT = 1.5
SSM_WIDTH = 512
SSM_HEAD_DIM = 64
SSM_HEADS = SSM_WIDTH // SSM_HEAD_DIM
SSM_GROUPS = 2
SSM_STATE = 128
SSM_CONV = 5
SSM_CHUNK = 128
BC_WIDTH = SSM_GROUPS * SSM_STATE
XBC_WIDTH = SSM_WIDTH + 2 * BC_WIDTH
MIX_WIDTH = HY_WIDTH + SSM_WIDTH
IN_WIDTH = 3 * HY_WIDTH + SSM_WIDTH + XBC_WIDTH + 2 * SSM_HEADS
XA_HEADS = 4
XA_HEAD_DIM = D_MODEL // XA_HEADS
D_FF = 4 * D_MODEL
EPS = 1e-5

kernel_name = "hyena_ssd_parallel_encoder"

f32 = jnp.float32


def rmsnorm(x, w):
    xf = x.astype(f32)
    y = xf * lax.rsqrt(jnp.mean(xf * xf, axis=-1, keepdims=True) + EPS) * w.astype(f32)
    return y.astype(x.dtype)


def centred_dwconv(x, w, b):
    K = w.shape[0]
    pad = K // 2
    L = x.shape[1]
    xp = jnp.pad(x, ((0, 0), (pad, pad), (0, 0)))
    return sum(xp[:, k:k + L] * w[k] for k in range(K)) + b


def hyena_filters(L, fw1, fb1, fw2, fb2, fw3, fb3, freq):
    t = jnp.linspace(0.0, 1.0, L, dtype=f32)[:, None]
    w = (2.0 * math.pi / L) * jnp.arange(L, dtype=f32)[:, None]
    f = jnp.linspace(1e-4, HY_BANDS - 1, HY_BANDS, dtype=f32)[None, :]
    feats = jnp.concatenate([t, jnp.cos(f * w), -jnp.sin(f * w)], axis=-1)
    fr = freq.astype(f32)
    h = jnp.sin(fr * (feats @ fw1.astype(f32) + fb1.astype(f32)))
    h = jnp.sin(fr * (h @ fw2.astype(f32) + fb2.astype(f32)))
    h = (h @ fw3.astype(f32) + fb3.astype(f32)).reshape(L, 2, HY_WIDTH)
    max_decay = math.log(HY_DECAY_TARGET) / HY_FAST_PCT
    min_decay = math.log(HY_DECAY_TARGET) / HY_SLOW_PCT
    deltas = jnp.abs(jnp.linspace(min_decay, max_decay, HY_WIDTH, dtype=f32))
    h = h * jnp.exp(-t * deltas)[:, None, :]
    return h[:, 0], h[:, 1]


def bidir_long_conv(u, h_fwd, h_bwd):
    L = u.shape[1]
    k = jnp.concatenate([h_fwd, jnp.zeros((1, h_fwd.shape[1]), f32), h_bwd[:0:-1]], axis=0)
    kf = jnp.fft.rfft(k, n=2 * L, axis=0)
    uf = jnp.fft.rfft(u.astype(f32), n=2 * L, axis=1)
    return jnp.fft.irfft(uf * kf[None], n=2 * L, axis=1)[:, :L]


def segsum_exp(a):
    q = a.shape[-1]
    cs = jnp.cumsum(a, axis=-1)
    diff = cs[..., :, None] - cs[..., None, :]
    mask = jnp.tril(jnp.ones((q, q), dtype=bool))
    return jnp.where(mask, jnp.exp(jnp.where(mask, diff, 0.0)), 0.0)


def ssd_scan(x, dt, A, B, C):
    b, l, h, p = x.shape
    g, n = B.shape[2], B.shape[3]
    r = h // g
    q = SSM_CHUNK
    c = l // q
    xd = (x.astype(f32) * dt[..., None]).reshape(b, c, q, g, r, p)
    dA = (dt * A.astype(f32)).reshape(b, c, q, g, r).transpose(0, 3, 4, 1, 2)
    Bc = B.astype(f32).reshape(b, c, q, g, n)
    Cc = C.astype(f32).reshape(b, c, q, g, n)
    a_cs = jnp.cumsum(dA, axis=-1)
    Lmat = segsum_exp(dA)
    cb = jnp.einsum("bclgn,bcsgn->bgcls", Cc, Bc)
    y_diag = jnp.einsum("bgrcls,bcsgrp->bclgrp", cb[:, :, None] * Lmat, xd)
    decay_states = jnp.exp(a_cs[..., -1:] - a_cs)
    states = jnp.einsum("bcsgn,bgrcs,bcsgrp->bcgrpn", Bc, decay_states, xd)
    chunk_decay = jnp.exp(a_cs[..., -1])

    def step(hstate, inp):
        s, d = inp
        return hstate * d[..., None, None] + s, hstate

    h0 = jnp.zeros((b, g, r, p, n), f32)
    _, prev = lax.scan(step, h0, (jnp.moveaxis(states, 1, 0), jnp.moveaxis(chunk_decay, -1, 0)))
    prev = jnp.moveaxis(prev, 0, 1)
    y_off = jnp.einsum("bclgn,bcgrpn,bgrcl->bclgrp", Cc, prev, jnp.exp(a_cs))
    return (y_diag + y_off).reshape(b, l, h, p)


def hybrid_mixer(u, p, i):
    b, L, _ = u.shape
    proj = u @ p["w_in"][i]
    o1 = 3 * HY_WIDTH
    o2 = o1 + SSM_WIDTH
    o3 = o2 + XBC_WIDTH
    hy = centred_dwconv(proj[..., :o1], p["hy_conv_w"][i], p["hy_conv_b"][i])
    x0, x1, v = jnp.split(hy, 3, axis=-1)
    h_fwd, h_bwd = hyena_filters(L, p["hy_fw1"][i], p["hy_fb1"][i], p["hy_fw2"][i], p["hy_fb2"][i],
                                 p["hy_fw3"][i], p["hy_fb3"][i], p["hy_sin_freq"][i])
    z = (v * x1).astype(f32)
    z = bidir_long_conv(z, h_fwd, h_bwd) + z * p["hy_bias"][i].astype(f32)
    y_hy = rmsnorm(x0.astype(f32) * z, p["hy_norm"][i])
    gate = proj[..., o1:o2]
    xbc = jax.nn.silu(centred_dwconv(proj[..., o2:o3], p["ssm_conv_w"][i], p["ssm_conv_b"][i]))
    xs = xbc[..., :SSM_WIDTH].reshape(b, L, SSM_HEADS, SSM_HEAD_DIM)
    Bm = xbc[..., SSM_WIDTH:SSM_WIDTH + BC_WIDTH].reshape(b, L, SSM_GROUPS, SSM_STATE)
    Cm = xbc[..., SSM_WIDTH + BC_WIDTH:].reshape(b, L, SSM_GROUPS, SSM_STATE)
    dt = jax.nn.softplus(proj[..., o3:].astype(f32).reshape(b, L, 2, SSM_HEADS)
                         + p["ssm_dt_bias"][i].astype(f32))
    A = -jnp.exp(p["ssm_A_log"][i].astype(f32))
    y_f = ssd_scan(xs, dt[:, :, 0], A[0], Bm, Cm)
    y_b = ssd_scan(xs[:, ::-1], dt[:, ::-1, 1], A[1], Bm[:, ::-1], Cm[:, ::-1])[:, ::-1]
    y_ssm = y_f + y_b + xs.astype(f32) * p["ssm_D"][i].astype(f32)[:, None]
    y_ssm = rmsnorm(y_ssm.reshape(b, L, SSM_WIDTH) * jax.nn.silu(gate.astype(f32)), p["ssm_norm"][i])
    y = jnp.concatenate([y_hy, y_ssm], axis=-1).astype(u.dtype)
    return y @ p["w_out"][i]


def memory_cross_attention(u, mem_n, w_q, w_kv, w_o):
    b, L, _ = u.shape
    m = mem_n.shape[1]
    q = (u @ w_q).reshape(b, L, XA_HEADS, XA_HEAD_DIM)
    kv = (mem_n @ w_kv).reshape(b, m, 2, XA_HEADS, XA_HEAD_DIM)
    k, v = kv[:, :, 0], kv[:, :, 1]
    s = jnp.einsum("bqhd,bkhd->bhqk", q.astype(f32), k.astype(f32)) * (XA_HEAD_DIM ** -0.5)
    a = jax.nn.softmax(s, axis=-1)
    o = jnp.einsum("bhqk,bkhd->bqhd", a, v.astype(f32)).reshape(b, L, D_MODEL).astype(u.dtype)
    return o @ w_o


def trunk(x, mem, p):
    for i in range(DEPTH):
        x = x + hybrid_mixer(rmsnorm(x, p["norm_mix"][i]), p, i).astype(x.dtype)
        x = x + memory_cross_attention(rmsnorm(x, p["norm_xattn"][i]), rmsnorm(mem, p["norm_mem"][i]),
                                       p["w_q"][i], p["w_kv"][i], p["w_o"][i]).astype(x.dtype)
        hdn = rmsnorm(x, p["norm_mlp"][i]) @ p["w_up"][i]
        x = x + (jnp.square(jax.nn.relu(hdn)) @ p["w_down"][i]).astype(x.dtype)
    return rmsnorm(x, p["norm_final"])


def setup_inputs(seed: int = 0) -> dict:
    key = jax.random.key(seed)
    ks = iter(jax.random.split(key, 40))

    def nrm(shape, scale):
        return scale * jax.random.normal(next(ks), shape, f32)

    def gain(shape):
        return 1.0 + nrm(shape, 0.02)

    dt0 = jnp.exp(jax.random.uniform(next(ks), (DEPTH, 2, SSM_HEADS), f32, math.log(1e-3), math.log(1e-1)))
    dt_bias = dt0 + jnp.log(-jnp.expm1(-dt0))
    a_log = jnp.log(jax.random.uniform(next(ks), (DEPTH, 2, SSM_HEADS), f32, 1.0, 16.0))
    return {
        "x_prompt": nrm((BATCH, SEQ, D_MODEL), 1.0),
        "x_sample": nrm((DEC_BATCH, DEC_SEQ, D_MODEL), 1.0),
        "mem_prompt": nrm((BATCH, N_MEM, D_MODEL), 1.0),
        "mem_sample": nrm((DEC_BATCH, N_MEM, D_MODEL), 1.0),
        "norm_mix": gain((DEPTH, D_MODEL)),
        "w_in": nrm((DEPTH, D_MODEL, IN_WIDTH), D_MODEL ** -0.5),
        "hy_conv_w": nrm((DEPTH, HY_CONV, 3 * HY_WIDTH), HY_CONV ** -0.5),
        "hy_conv_b": nrm((DEPTH, 3 * HY_WIDTH), 0.02),
        "hy_fw1": nrm((DEPTH, HY_EMB, HY_ORDER), HY_EMB ** -0.5),
        "hy_fb1": nrm((DEPTH, HY_ORDER), 0.02),
        "hy_fw2": nrm((DEPTH, HY_ORDER, HY_ORDER), HY_ORDER ** -0.5),
        "hy_fb2": nrm((DEPTH, HY_ORDER), 0.02),
        "hy_fw3": nrm((DEPTH, HY_ORDER, 2 * HY_WIDTH), HY_ORDER ** -0.5),
        "hy_fb3": nrm((DEPTH, 2 * HY_WIDTH), 0.02),
        "hy_sin_freq": gain((DEPTH, HY_ORDER)),
        "hy_bias": nrm((DEPTH, HY_WIDTH), 0.1),
        "hy_norm": gain((DEPTH, HY_WIDTH)),
        "ssm_conv_w": nrm((DEPTH, SSM_CONV, XBC_WIDTH), SSM_CONV ** -0.5),
        "ssm_conv_b": nrm((DEPTH, XBC_WIDTH), 0.02),
        "ssm_dt_bias": dt_bias,
        "ssm_A_log": a_log,
        "ssm_D": gain((DEPTH, SSM_HEADS)),
        "ssm_norm": gain((DEPTH, SSM_WIDTH)),
        "w_out": nrm((DEPTH, MIX_WIDTH, D_MODEL), MIX_WIDTH ** -0.5),
        "norm_xattn": gain((DEPTH, D_MODEL)),
        "norm_mem": gain((DEPTH, D_MODEL)),
        "w_q": nrm((DEPTH, D_MODEL, D_MODEL), D_MODEL ** -0.5),
        "w_kv": nrm((DEPTH, D_MODEL, 2 * D_MODEL), D_MODEL ** -0.5),
        "w_o": nrm((DEPTH, D_MODEL, D_MODEL), D_MODEL ** -0.5),
        "norm_mlp": gain((DEPTH, D_MODEL)),
        "w_up": nrm((DEPTH, D_MODEL, D_FF), D_MODEL ** -0.5),
        "w_down": nrm((DEPTH, D_FF, D_MODEL), D_FF ** -0.5),
        "norm_final": gain((D_MODEL,)),
    }


def reference(x_prompt, x_sample, mem_prompt, mem_sample, norm_mix, w_in, hy_conv_w, hy_conv_b,
              hy_fw1, hy_fb1, hy_fw2, hy_fb2, hy_fw3, hy_fb3, hy_sin_freq, hy_bias, hy_norm,
              ssm_conv_w, ssm_conv_b, ssm_dt_bias, ssm_A_log, ssm_D, ssm_norm, w_out,
              norm_xattn, norm_mem, w_q, w_kv, w_o, norm_mlp, w_up, w_down, norm_final):
    p = dict(norm_mix=norm_mix, w_in=w_in, hy_conv_w=hy_conv_w, hy_conv_b=hy_conv_b,
             hy_fw1=hy_fw1, hy_fb1=hy_fb1, hy_fw2=hy_fw2, hy_fb2=hy_fb2, hy_fw3=hy_fw3, hy_fb3=hy_fb3,
             hy_sin_freq=hy_sin_freq, hy_bias=hy_bias, hy_norm=hy_norm,
             ssm_conv_w=ssm_conv_w, ssm_conv_b=ssm_conv_b, ssm_dt_bias=ssm_dt_bias, ssm_A_log=ssm_A_log,
             ssm_D=ssm_D, ssm_norm=ssm_norm, w_out=w_out,
             norm_xattn=norm_xattn, norm_mem=norm_mem, w_q=w_q, w_kv=w_kv, w_o=w_o,
             norm_mlp=norm_mlp, w_up=w_up, w_down=w_down, norm_final=norm_final)
    y_prompt = trunk(x_prompt, mem_prompt, p)
    y_sample = trunk(x_sample, mem_sample, p)
    return (y_prompt, y_sample)
```

```cpp
#include <hip/hip_runtime.h>
#include <hip/hip_cooperative_groups.h>
namespace cg = cooperative_groups;

#define LAS __attribute__((address_space(3)))
typedef unsigned short bf16_t;
typedef short bf16x8 __attribute__((ext_vector_type(8)));
typedef float f32x4 __attribute__((ext_vector_type(4)));
typedef float f32x2 __attribute__((ext_vector_type(2)));
typedef unsigned u32x4 __attribute__((ext_vector_type(4)));
typedef unsigned u32x2 __attribute__((ext_vector_type(2)));

constexpr int T_ALL = 32768, TP = 16384, DM = 1024;
constexpr float EPS = 1e-5f;
constexpr size_t MiB = 1048576;
constexpr size_t WS_WHY = 0 * MiB, WS_WSSM = 3 * MiB, WS_WOUT = 6 * MiB, WS_WQ = 8 * MiB, WS_WK = 10 * MiB, WS_WV = 12 * MiB, WS_WO = 14 * MiB, WS_WUP = 16 * MiB, WS_WDOWN = 24 * MiB;
constexpr size_t WS_XB = 32 * MiB, WS_MEMB = 96 * MiB, WS_SSQ = 102 * MiB, WS_H2 = 103 * MiB, WS_TW = 106 * MiB, WS_WDT = 106 * MiB + 65536, WS_DECAY = 106 * MiB + 131072;
constexpr size_t WS_DT = 107 * MiB, WS_PSUM = 109 * MiB, WS_R1A = 111 * MiB, WS_R1B = 143 * MiB, WS_R2 = 175 * MiB, WS_R3 = 207 * MiB, WS_R4 = 239 * MiB, WS_END = 251 * MiB;
constexpr int LDS_BYTES = 131072;

typedef __bf16 bf16x2v __attribute__((ext_vector_type(2)));
__device__ __forceinline__ unsigned pk2(float lo, float hi) { const f32x2 v = {lo, hi}; const bf16x2v b = __builtin_convertvector(v, bf16x2v); return __builtin_bit_cast(unsigned, b); }
__device__ __forceinline__ float bflo(unsigned u) { return __uint_as_float(u << 16); }
__device__ __forceinline__ float bfhi(unsigned u) { return __uint_as_float(u & 0xffff0000u); }
__device__ __forceinline__ float bf2f(bf16_t b) { return __uint_as_float(((unsigned)b) << 16); }
__device__ __forceinline__ float wave_sum(float v) {
#pragma unroll
    for (int o = 32; o >= 1; o >>= 1) v += __shfl_xor(v, o);
    return v;
}
__device__ __forceinline__ int otid() { int t = (int)threadIdx.x; asm volatile("" : "+v"(t)); return t; }
#define LDS_WAIT() asm volatile("s_waitcnt lgkmcnt(0)" ::: "memory")

namespace pg8 {
constexpr int BM = 256, BK = 64, HALF = 128, HTB = HALF * BK * 2, STAGE_BYTES = 8 * HTB, NXCD = 8, WGM = 8;
__host__ __device__ __forceinline__ int lds_byte(int r, int c) { const int st = (r >> 4) * 2 + (c >> 5), rr = r & 15, cc = c & 31, ob = rr * 64 + cc * 2; return st * 1024 + (ob ^ (((ob >> 9) & 1) << 5)); }
__host__ __device__ __forceinline__ void stage_rc(int b, int& R, int& C) { const int st = b / 1024, sb = b % 1024, swz = sb ^ (((sb >> 9) & 1) << 5); R = (st >> 1) * 16 + swz / 64; C = (st & 1) * 32 + (swz % 64) / 2; }
__host__ __device__ __forceinline__ int perm32(int rho) { const int n = rho >> 4, i = rho & 15; return 8 * (i >> 2) + 4 * n + (i & 3); }
struct Unit { int pm, pn; };
struct Gemm { int lda, ldb, K, ks_shift; size_t seg_bytes; };
__device__ __forceinline__ int seq_of_pm(int pm) { return pm < 64 ? (pm >> 3) : 8 + ((pm - 64) >> 4); }
struct Sched {
    int nM, nN, nwg, G, c, mode;
    const char* A; const char* B; int lda, ldb;
    __device__ void init(int nM_, int nN_, int mode_, const void* A_, int lda_, const void* B_, int ldb_) { nM = nM_; nN = nN_; nwg = nM * nN; G = (int)gridDim.x; c = (int)blockIdx.x; mode = mode_; A = (const char*)A_; B = (const char*)B_; lda = lda_; ldb = ldb_; }
    __device__ bool next(int i, Unit& u) const {
        const long L = (long)i * G + c; if (L >= nwg) return false;
        int wgid = (int)L; { const int q = nwg / NXCD, r = nwg % NXCD, xcd = wgid % NXCD, off = wgid / NXCD; wgid = (xcd < r ? xcd * (q + 1) : r * (q + 1) + (xcd - r) * q) + off; }
        const int nig = WGM * nN, gid = wgid / nig, fm = gid * WGM, gsz = (nM - fm) < WGM ? (nM - fm) : WGM;
        u.pm = fm + ((wgid % nig) % gsz); u.pn = (wgid % nig) / gsz; return true;
    }
    __device__ __forceinline__ const char* abase(const Unit& u) const {
        if (mode == 0) return A + (size_t)u.pm * 256 * lda * 2;
        return A + ((size_t)u.pm * 256 * lda + (size_t)u.pn * 256) * 2;
    }
    __device__ __forceinline__ const char* bbase(const Unit& u) const {
        if (mode == 0) return B + (size_t)u.pn * 256 * ldb * 2;
        if (mode == 1) return B + ((size_t)seq_of_pm(u.pm) * 256 * ldb + (size_t)u.pn * 256) * 2;
        return B + ((size_t)u.pn * 256 * ldb + (size_t)seq_of_pm(u.pm) * 256) * 2;
    }
};

template <class Epi>
__device__ __forceinline__ void gemm_phase(LAS unsigned char* lds, const Gemm g, const Sched& S, const Epi& E) {
    const int tid = otid(), wid = __builtin_amdgcn_readfirstlane(tid >> 6), lane = tid & 63, wr = wid >> 2, wc = wid & 3, fr = lane & 15, fq = lane >> 4;
    const int nt = g.K / BK;
    unsigned voffA[2], voffB[2];
#pragma unroll
    for (int i = 0; i < 2; ++i) { int R, C; stage_rc(tid * 16 + i * 8192, R, C); const int Rb = Epi::PERM ? ((R & ~31) + perm32(R & 31)) : R;
        voffA[i] = (unsigned)(R * g.lda + C) * 2u; voffB[i] = (unsigned)(Rb * g.ldb + C) * 2u; }
    const size_t kstep = (size_t)(BK * 2);
    const size_t hstepA = (size_t)HALF * g.lda * 2, hstepB = (size_t)HALF * g.ldb * 2;
    const int ksm = (1 << g.ks_shift) - 1;
#define PG8_AKT(p, t) ((p) + (size_t)((t) >> g.ks_shift) * g.seg_bytes + (size_t)((t) & ksm) * kstep)
    const unsigned ldsw = (unsigned)wid * 1024u;
    const int aoff = lds_byte(wr * 64 + fr, fq * 8), boff = lds_byte(wc * 32 + fr, fq * 8);
#define PG8_SA(b, h) (((b) * 2 + (h)) * HTB)
#define PG8_SB(b, h) ((4 + (b) * 2 + (h)) * HTB)
#define PG8_STAGE(bufoff, gbase, voff) do { _Pragma("unroll") for (int _i = 0; _i < 2; ++_i) \
        __builtin_amdgcn_global_load_lds((const unsigned*)((const char*)(gbase) + (voff)[_i]), (LAS unsigned*)(lds + (bufoff) + ldsw + _i * 8192), 16, 0, 0); } while (0)
#define PG8_LDA(dst, b, h) do { _Pragma("unroll") for (int m = 0; m < 4; ++m) _Pragma("unroll") for (int k = 0; k < 2; ++k) dst[m][k] = *(const LAS bf16x8*)(lds + PG8_SA(b, h) + aoff + m * 2048 + k * 1024); } while (0)
#define PG8_LDB(dst, b, h) do { _Pragma("unroll") for (int n = 0; n < 2; ++n) _Pragma("unroll") for (int k = 0; k < 2; ++k) dst[n][k] = *(const LAS bf16x8*)(lds + PG8_SB(b, h) + boff + n * 2048 + k * 1024); } while (0)
#define PG8_MMA(ai, bj, At, Bt) do { __builtin_amdgcn_s_setprio(1); _Pragma("unroll") for (int m = 0; m < 4; ++m) _Pragma("unroll") for (int n = 0; n < 2; ++n) _Pragma("unroll") for (int k = 0; k < 2; ++k) \
        acc[ai][bj][m][n] = __builtin_amdgcn_mfma_f32_16x16x32_bf16(Bt[n][k], At[m][k], acc[ai][bj][m][n], 0, 0, 0); __builtin_amdgcn_s_setprio(0); } while (0)
#define PG8_WAIT_V(n) asm volatile("s_waitcnt vmcnt(" #n ")" ::: "memory")
#define PG8_WAIT_L(n) asm volatile("s_waitcnt lgkmcnt(" #n ")" ::: "memory")
#define PG8_BAR __builtin_amdgcn_s_barrier()
#define PG8_SCHED __builtin_amdgcn_sched_barrier(0)
    Unit cur, nxt; int ui = 0;
    if (!S.next(0, cur)) return;
    f32x4 acc[2][2][4][2];
#pragma unroll
    for (int a = 0; a < 2; ++a)
#pragma unroll
        for (int b = 0; b < 2; ++b)
#pragma unroll
            for (int m = 0; m < 4; ++m)
#pragma unroll
                for (int n = 0; n < 2; ++n) acc[a][b][m][n] = (f32x4){0.f, 0.f, 0.f, 0.f};
    bf16x8 At[4][2], B0[2][2], B1[2][2];
    const char* cA = S.abase(cur); const char* cB = S.bbase(cur);
    PG8_STAGE(PG8_SB(0, 0), cB, voffB); PG8_STAGE(PG8_SA(0, 0), cA, voffA); PG8_STAGE(PG8_SB(0, 1), cB + hstepB, voffB); PG8_STAGE(PG8_SA(0, 1), cA + hstepA, voffA);
    if (wr == 1) PG8_BAR;
    PG8_WAIT_V(4); PG8_BAR;
    PG8_STAGE(PG8_SB(1, 0), cB + kstep, voffB); PG8_STAGE(PG8_SA(1, 0), PG8_AKT(cA, 1), voffA); PG8_STAGE(PG8_SB(1, 1), cB + hstepB + kstep, voffB);
    PG8_WAIT_V(6); PG8_BAR;
    for (;;) {
        const bool has_next = S.next(ui + 1, nxt);
        const char* nA = has_next ? S.abase(nxt) : cA; const char* nB = has_next ? S.bbase(nxt) : cB;
        for (int t = 0; t < nt; t += 2) {
            const bool last = (t == nt - 2);
            const char* a1 = PG8_AKT(cA, t + 1);
            const char* a2 = last ? nA : PG8_AKT(cA, t + 2); const char* b2 = last ? nB : cB + (size_t)(t + 2) * kstep;
            const char* a3 = last ? PG8_AKT(nA, 1) : PG8_AKT(cA, t + 3); const char* b3 = b2 + kstep;
            PG8_LDB(B0, 0, 0); PG8_SCHED; PG8_LDA(At, 0, 0); PG8_STAGE(PG8_SA(1, 1), a1 + hstepA, voffA);
            PG8_WAIT_L(8); PG8_BAR; PG8_WAIT_L(0); PG8_MMA(0, 0, At, B0); PG8_BAR; PG8_SCHED;
            PG8_LDB(B1, 0, 1); PG8_STAGE(PG8_SB(0, 0), b2, voffB);
            PG8_BAR; PG8_WAIT_L(0); PG8_MMA(0, 1, At, B1); PG8_BAR;
            PG8_LDA(At, 0, 1); PG8_STAGE(PG8_SA(0, 0), a2, voffA);
            PG8_BAR; PG8_WAIT_L(0); PG8_MMA(1, 0, At, B0); PG8_BAR; PG8_SCHED;
            PG8_STAGE(PG8_SB(0, 1), b2 + hstepB, voffB);
            PG8_WAIT_V(6); PG8_BAR; PG8_MMA(1, 1, At, B1); PG8_BAR;
            PG8_LDB(B0, 1, 0); PG8_SCHED; PG8_LDA(At, 1, 0); PG8_STAGE(PG8_SA(0, 1), a2 + hstepA, voffA);
            PG8_WAIT_L(8); PG8_BAR; PG8_WAIT_L(0); PG8_MMA(0, 0, At, B0); PG8_BAR; PG8_SCHED;
            PG8_LDB(B1, 1, 1); PG8_STAGE(PG8_SB(1, 0), b3, voffB);
            PG8_BAR; PG8_WAIT_L(0); PG8_MMA(0, 1, At, B1); PG8_BAR;
            PG8_LDA(At, 1, 1); PG8_STAGE(PG8_SA(1, 0), a3, voffA);
            PG8_BAR; PG8_WAIT_L(0); PG8_MMA(1, 0, At, B0); PG8_BAR; PG8_SCHED;
            PG8_STAGE(PG8_SB(1, 1), b3 + hstepB, voffB);
            PG8_WAIT_V(6); PG8_BAR; PG8_MMA(1, 1, At, B1); PG8_BAR;
        }
        E(acc, cur, wr, wc, fr, fq);
        if (!has_next) break;
#pragma unroll
        for (int a = 0; a < 2; ++a)
#pragma unroll
            for (int b = 0; b < 2; ++b)
#pragma unroll
                for (int m = 0; m < 4; ++m)
#pragma unroll
                    for (int n = 0; n < 2; ++n) acc[a][b][m][n] = (f32x4){0.f, 0.f, 0.f, 0.f};
        cur = nxt; cA = nA; cB = nB; ++ui;
    }
    PG8_WAIT_V(0);
    if (wr == 0) PG8_BAR;
    PG8_BAR;
#undef PG8_AKT
#undef PG8_SA
#undef PG8_SB
#undef PG8_STAGE
#undef PG8_LDA
#undef PG8_LDB
#undef PG8_MMA
#undef PG8_WAIT_V
#undef PG8_WAIT_L
#undef PG8_BAR
#undef PG8_SCHED
}
}
struct Epi {
    int kind;
    static constexpr bool PERM = true;
    bf16_t* O0; long long d1, d2; int ldc; int csplit, rsplit;
    const float* ssq; float* psum; int row_off; int SCALE, ACT;
    __device__ __forceinline__ void bf_path(const f32x4 (&acc)[2][2][4][2], const pg8::Unit& u, int wr, int wc, int fr, int fq) const {
        int pm = u.pm, pn = u.pn, ai_ = 0;
        if (csplit) { ai_ = pn / csplit; pn = pn % csplit; }
        if (rsplit) { ai_ = pm / rsplit; pm = pm % rsplit; }
        bf16_t* base = O0 + (ai_ >= 1 ? d1 : 0ll) + (ai_ >= 2 ? d2 : 0ll);
        const int lrow0 = pm * 256 + wr * 64 + fr, grow0 = u.pm * 256 + wr * 64 + fr, lcol0 = pn * 256 + wc * 32 + 8 * fq, gcol0 = u.pn * 256 + wc * 32 + 8 * fq;
        f32x4 cs[2][2];
        if (SCALE == 2) {
#pragma unroll
            for (int bj = 0; bj < 2; ++bj)
#pragma unroll
                for (int n = 0; n < 2; ++n) { f32x4 q = *(const f32x4*)(ssq + gcol0 + bj * 128 + 4 * n);
#pragma unroll
                    for (int j = 0; j < 4; ++j) q[j] = rsqrtf(q[j] * (1.0f / 1024.0f) + EPS);
                    cs[bj][n] = q; }
        }
#pragma unroll
        for (int ai = 0; ai < 2; ++ai)
#pragma unroll
            for (int m = 0; m < 4; ++m) {
                const int grow = grow0 + ai * 128 + m * 16;
                float rs = 1.0f;
                if (SCALE == 1) rs = rsqrtf(ssq[grow + row_off] * (1.0f / 1024.0f) + EPS);
                if (SCALE == 3) { const f32x4 q = *(const f32x4*)(psum + ((size_t)grow * 4 + u.pn) * 4); rs = 1.0f / ((q[0] + q[1]) + (q[2] + q[3])); }
                bf16_t* rowp = base + (size_t)(lrow0 + ai * 128 + m * 16) * ldc + lcol0;
                float psacc = 0.f;
#pragma unroll
                for (int bj = 0; bj < 2; ++bj) {
                    f32x4 v0 = acc[ai][bj][m][0], v1 = acc[ai][bj][m][1];
                    if (SCALE == 1 || SCALE == 3) { v0 = v0 * rs; v1 = v1 * rs; }
                    if (SCALE == 2) { v0 = v0 * cs[bj][0]; v1 = v1 * cs[bj][1]; }
                    if (ACT == 1) {
#pragma unroll
                        for (int j = 0; j < 4; ++j) { const float a0 = fmaxf(v0[j], 0.f), a1 = fmaxf(v1[j], 0.f); v0[j] = a0 * a0; v1[j] = a1 * a1; } }
                    if (ACT == 2) {
#pragma unroll
                        for (int j = 0; j < 4; ++j) { v0[j] = __expf(v0[j]); v1[j] = __expf(v1[j]); }
                        psacc += ((v0[0] + v0[1]) + (v0[2] + v0[3])) + ((v1[0] + v1[1]) + (v1[2] + v1[3])); }
                    u32x4 w; w.x = pk2(v0[0], v0[1]); w.y = pk2(v0[2], v0[3]); w.z = pk2(v1[0], v1[1]); w.w = pk2(v1[2], v1[3]);
                    *(u32x4*)(rowp + bj * 128) = w;
                }
                if (ACT == 2) { psacc += __shfl_xor(psacc, 16); psacc += __shfl_xor(psacc, 32); if (fq == 0) psum[((size_t)grow * 4 + u.pn) * 4 + wc] = psacc; }
            }
    }
    float* X; const float* rin0; const float* rin1; bf16_t* xb; float* ssq_out;
    __device__ __forceinline__ void operator()(const f32x4 (&acc)[2][2][4][2], const pg8::Unit& u, int wr, int wc, int fr, int fq) const {
        if (kind == 0) bf_path(acc, u, wr, wc, fr, fq); else res_path(acc, u, wr, wc, fr, fq);
    }
    __device__ __forceinline__ void res_path(const f32x4 (&acc)[2][2][4][2], const pg8::Unit& u, int wr, int wc, int fr, int fq) const {
        const int row0 = u.pm * 256 + wr * 64 + fr + row_off, col0 = u.pn * 256 + wc * 32 + 8 * fq;
#pragma unroll
        for (int ai = 0; ai < 2; ++ai)
#pragma unroll
            for (int m = 0; m < 4; ++m) {
                const int row = row0 + ai * 128 + m * 16;
                const float* rp = (row < TP ? rin0 + (size_t)row * DM : rin1 + (size_t)(row - TP) * DM) + col0;
                float* xp = X + (size_t)row * DM + col0; bf16_t* bp = xb + (size_t)row * DM + col0;
                float sq = 0.f;
#pragma unroll
                for (int bj = 0; bj < 2; ++bj) {
                    const f32x4 r0 = *(const f32x4*)(rp + bj * 128), r1 = *(const f32x4*)(rp + bj * 128 + 4);
                    const f32x4 v0 = acc[ai][bj][m][0] + r0, v1 = acc[ai][bj][m][1] + r1;
                    *(f32x4*)(xp + bj * 128) = v0; *(f32x4*)(xp + bj * 128 + 4) = v1;
                    u32x4 w; w.x = pk2(v0[0], v0[1]); w.y = pk2(v0[2], v0[3]); w.z = pk2(v1[0], v1[1]); w.w = pk2(v1[2], v1[3]);
                    *(u32x4*)(bp + bj * 128) = w;
                    sq += ((v0[0] * v0[0] + v0[1] * v0[1]) + (v0[2] * v0[2] + v0[3] * v0[3])) + ((v1[0] * v1[0] + v1[1] * v1[1]) + (v1[2] * v1[2] + v1[3] * v1[3]));
                }
                sq += __shfl_xor(sq, 16); sq += __shfl_xor(sq, 32);
                if (fq == 0) unsafeAtomicAdd(ssq_out + row, sq);
            }
    }
};

struct Args { const float* in[33]; float* out; unsigned char* ws; };
typedef const __attribute__((address_space(4))) Args* ArgsP;
enum { I_XP = 0, I_XS, I_MP, I_MS, I_NMIX, I_WIN, I_HCW, I_HCB, I_FW1, I_FB1, I_FW2, I_FB2, I_FW3, I_FB3, I_FREQ, I_HBIAS, I_HNORM, I_SCW, I_SCB, I_DTB, I_ALOG, I_SD, I_SNORM,
       I_WOUT, I_NXA, I_NMEM, I_WQ, I_WKV, I_WO, I_NMLP, I_WUP, I_WDOWN, I_NFIN };

__device__ __forceinline__ void transpose_item(const float* W, int K, int N, bf16_t* WT, int n0, int k0, int dst_row0, const float* ksc, float gs, LAS float* scr, int lane) {
#pragma unroll 8
    for (int i = 0; i < 32; ++i) { const int kk = 2 * i + (lane >> 5); float v = W[(size_t)(k0 + kk) * N + n0 + (lane & 31)] * gs; if (ksc) v *= ksc[k0 + kk]; scr[kk * 33 + (lane & 31)] = v; }
    LDS_WAIT();
    const int c = lane & 7;
#pragma unroll
    for (int j = 0; j < 4; ++j) { const int n = (lane >> 3) + 8 * j; const LAS float* s = scr + (8 * c) * 33 + n;
        u32x4 o; o.x = pk2(s[0 * 33], s[1 * 33]); o.y = pk2(s[2 * 33], s[3 * 33]); o.z = pk2(s[4 * 33], s[5 * 33]); o.w = pk2(s[6 * 33], s[7 * 33]);
        *(u32x4*)(WT + (size_t)(dst_row0 + n) * K + k0 + 8 * c) = o; }
    LDS_WAIT();
}
__device__ __forceinline__ void phase_wconv(ArgsP a, int l, LAS unsigned char* lds) {
    const int lane = otid() & 63, wave = otid() >> 6, gw = blockIdx.x * 8 + wave, NGW = gridDim.x * 8;
    LAS float* scr = (LAS float*)(lds + wave * 16384);
    unsigned char* ws = a->ws;
    constexpr int I_IN = 16 * 96, I_OUT = 16 * 32, I_Q = 16 * 32, I_KV = 16 * 64, I_O = 16 * 32, I_UP = 16 * 128, I_DN = 64 * 32;
    constexpr int NIT = I_IN + I_OUT + I_Q + I_KV + I_O + I_UP + I_DN;
    for (int it = gw; it < NIT; it += NGW) {
        int r = it;
        if (r < I_IN) { const int kb = r / 96, nb = r % 96, n0 = nb * 32;
            if (n0 < 1536) transpose_item(a->in[I_WIN] + (size_t)l * 1024 * 3088, 1024, 3088, (bf16_t*)(ws + WS_WHY), n0, kb * 64, n0, a->in[I_NMIX] + l * 1024, 1.f, scr, lane);
            else transpose_item(a->in[I_WIN] + (size_t)l * 1024 * 3088, 1024, 3088, (bf16_t*)(ws + WS_WSSM), n0, kb * 64, n0 - 1536, a->in[I_NMIX] + l * 1024, 1.f, scr, lane);
            continue; } r -= I_IN;
        if (r < I_OUT) { const int kb = r / 32, nb = r % 32; transpose_item(a->in[I_WOUT] + (size_t)l * 1024 * 1024, 1024, 1024, (bf16_t*)(ws + WS_WOUT), nb * 32, kb * 64, nb * 32, nullptr, 1.f, scr, lane); continue; } r -= I_OUT;
        if (r < I_Q) { const int kb = r / 32, nb = r % 32; transpose_item(a->in[I_WQ] + (size_t)l * 1024 * 1024, 1024, 1024, (bf16_t*)(ws + WS_WQ), nb * 32, kb * 64, nb * 32, a->in[I_NXA] + l * 1024, 0.0625f, scr, lane); continue; } r -= I_Q;
        if (r < I_KV) { const int kb = r / 64, nb = r % 64, n0 = nb * 32;
            if (n0 < 1024) transpose_item(a->in[I_WKV] + (size_t)l * 1024 * 2048, 1024, 2048, (bf16_t*)(ws + WS_WK), n0, kb * 64, n0, a->in[I_NMEM] + l * 1024, 1.f, scr, lane);
            else transpose_item(a->in[I_WKV] + (size_t)l * 1024 * 2048, 1024, 2048, (bf16_t*)(ws + WS_WV), n0, kb * 64, n0 - 1024, a->in[I_NMEM] + l * 1024, 1.f, scr, lane);
            continue; } r -= I_KV;
        if (r < I_O) { const int kb = r / 32, nb = r % 32; transpose_item(a->in[I_WO] + (size_t)l * 1024 * 1024, 1024, 1024, (bf16_t*)(ws + WS_WO), nb * 32, kb * 64, nb * 32, nullptr, 1.f, scr, lane); continue; } r -= I_O;
        if (r < I_UP) { const int kb = r / 128, nb = r % 128; transpose_item(a->in[I_WUP] + (size_t)l * 1024 * 4096, 1024, 4096, (bf16_t*)(ws + WS_WUP), nb * 32, kb * 64, nb * 32, a->in[I_NMLP] + l * 1024, 1.f, scr, lane); continue; } r -= I_UP;
        { const int kb = r / 32, nb = r % 32; transpose_item(a->in[I_WDOWN] + (size_t)l * 4096 * 1024, 4096, 1024, (bf16_t*)(ws + WS_WDOWN), nb * 32, kb * 64, nb * 32, nullptr, 1.f, scr, lane); }
    }
    float* wdt = (float*)(ws + WS_WDT);
    for (int i = blockIdx.x * 512 + otid(); i < 16 * 1024; i += gridDim.x * 512) { const int j = i >> 10, k = i & 1023; wdt[i] = a->in[I_NMIX][l * 1024 + k] * a->in[I_WIN][((size_t)l * 1024 + k) * 3088 + 3072 + j]; }
}
__device__ __forceinline__ const float* xin_row(ArgsP a, int t) { return t < TP ? a->in[I_XP] + (size_t)t * DM : a->in[I_XS] + (size_t)(t - TP) * DM; }

__device__ __forceinline__ void phase_prologue(ArgsP a, LAS unsigned char* lds) {
    const int lane = otid() & 63, wave = otid() >> 6, gw = blockIdx.x * 8 + wave, NGW = gridDim.x * 8;
    unsigned char* ws = a->ws;
    float* ssq = (float*)(ws + WS_SSQ);
    for (int i = blockIdx.x * 512 + otid(); i < 6 * T_ALL; i += gridDim.x * 512) ssq[T_ALL + i] = 0.f;
    { f32x2* tw = (f32x2*)(ws + WS_TW); for (int i = blockIdx.x * 512 + otid(); i < 4096; i += gridDim.x * 512) { float s, c; sincospif(-(float)i * (1.0f / 4096.0f), &s, &c); tw[i] = (f32x2){c, s}; } }
    bf16_t* xb = (bf16_t*)(ws + WS_XB);
    for (int t = gw; t < T_ALL; t += NGW) {
        const f32x4* xr = (const f32x4*)xin_row(a, t) + lane; float s = 0.f;
        u32x2* o = (u32x2*)(xb + (size_t)t * DM) + lane;
#pragma unroll
        for (int j = 0; j < 4; ++j) { const f32x4 v = xr[64 * j]; s += (v[0] * v[0] + v[1] * v[1]) + (v[2] * v[2] + v[3] * v[3]); u32x2 w; w.x = pk2(v[0], v[1]); w.y = pk2(v[2], v[3]); o[64 * j] = w; }
        s = wave_sum(s); if (lane == 0) ssq[t] = s;
    }
    bf16_t* memb = (bf16_t*)(ws + WS_MEMB);
    for (int t = gw; t < 3072; t += NGW) {
        const float* mr = t < 2048 ? a->in[I_MP] + (size_t)t * DM : a->in[I_MS] + (size_t)(t - 2048) * DM;
        const f32x4* xr = (const f32x4*)mr + lane; f32x4 v[4]; float s = 0.f;
#pragma unroll
        for (int j = 0; j < 4; ++j) { v[j] = xr[64 * j]; s += (v[j][0] * v[j][0] + v[j][1] * v[j][1]) + (v[j][2] * v[j][2] + v[j][3] * v[j][3]); }
        const float rs = rsqrtf(wave_sum(s) * (1.0f / 1024.0f) + EPS);
        u32x2* o = (u32x2*)(memb + (size_t)t * DM) + lane;
#pragma unroll
        for (int j = 0; j < 4; ++j) { u32x2 w; w.x = pk2(v[j][0] * rs, v[j][1] * rs); w.y = pk2(v[j][2] * rs, v[j][3] * rs); o[64 * j] = w; }
    }
    float* h2 = (float*)(ws + WS_H2);
    for (int idx = gw; idx < 2 * 6144; idx += NGW) {
        const int l = idx / 6144, r = idx % 6144, set = r >= 2048 ? 1 : 0, t = set ? r - 2048 : r, L = set ? 4096 : 2048;
        const float tl = (float)t / (float)(L - 1), w = (6.283185307179586f / (float)L) * (float)t;
        const float fm = 1e-4f + (float)(lane & 15) * ((15.0f - 1e-4f) / 15.0f);
        float sv, cv; sincosf(fm * w, &sv, &cv);
        const float* fw1 = a->in[I_FW1] + l * 33 * 64; const float* fw2 = a->in[I_FW2] + l * 64 * 64;
        float acc = a->in[I_FB1][l * 64 + lane] + tl * fw1[lane];
#pragma unroll
        for (int i = 0; i < 16; ++i) { acc += __shfl(cv, i) * fw1[(1 + i) * 64 + lane]; acc -= __shfl(sv, i) * fw1[(17 + i) * 64 + lane]; }
        const float fr = a->in[I_FREQ][l * 64 + lane];
        const float h1 = sinf(fr * acc);
        float acc2 = a->in[I_FB2][l * 64 + lane];
#pragma unroll 8
        for (int i = 0; i < 64; ++i) acc2 += __shfl(h1, i) * fw2[i * 64 + lane];
        h2[(size_t)idx * 64 + lane] = sinf(fr * acc2);
    }
}
__device__ __forceinline__ void phase_dt(ArgsP a, int l, const float* rin0, const float* rin1) {
    const int lane = otid() & 63, wave = otid() >> 6, gw = blockIdx.x * 8 + wave, NGW = gridDim.x * 8;
    const float* wdt = (const float*)(a->ws + WS_WDT); float* dt = (float*)(a->ws + WS_DT);
    for (int t = gw; t < T_ALL; t += NGW) {
        const float* xr0 = t < TP ? rin0 + (size_t)t * DM : rin1 + (size_t)(t - TP) * DM;
        const f32x4* xr = (const f32x4*)xr0 + lane; f32x4 v[4]; float s = 0.f;
#pragma unroll
        for (int j = 0; j < 4; ++j) { v[j] = xr[64 * j]; s += (v[j][0] * v[j][0] + v[j][1] * v[j][1]) + (v[j][2] * v[j][2] + v[j][3] * v[j][3]); }
        const float rs = rsqrtf(wave_sum(s) * (1.0f / 1024.0f) + EPS);
        float mine = 0.f;
#pragma unroll 4
        for (int o = 0; o < 16; ++o) {
            const f32x4* wr_ = (const f32x4*)(wdt + o * 1024) + lane; float p = 0.f;
#pragma unroll
            for (int j = 0; j < 4; ++j) { const f32x4 w = wr_[64 * j]; p += (v[j][0] * w[0] + v[j][1] * w[1]) + (v[j][2] * w[2] + v[j][3] * w[3]); }
            p = wave_sum(p); if (lane == o) mine = p;
        }
        if (lane < 16) { const float x = mine * rs + a->in[I_DTB][l * 16 + lane]; dt[(size_t)t * 16 + lane] = x > 20.f ? x : log1pf(expf(x)); }
    }
}
__device__ __forceinline__ void phase_final(ArgsP a, const float* ssq) {
    const int lane = otid() & 63, wave = otid() >> 6, gw = blockIdx.x * 8 + wave, NGW = gridDim.x * 8;
    const f32x4* g = (const f32x4*)a->in[I_NFIN] + lane;
    for (int t = gw; t < T_ALL; t += NGW) {
        const float rs = rsqrtf(ssq[t] * (1.0f / 1024.0f) + EPS);
        f32x4* xr = (f32x4*)(a->out + (size_t)t * DM) + lane;
#pragma unroll
        for (int j = 0; j < 4; ++j) { f32x4 v = xr[64 * j]; const f32x4 w = g[64 * j]; v = v * rs * w;
#ifdef DBG_SANITIZE
            for (int e = 0; e < 4; ++e) if (!(fabsf(v[e]) < 1e30f)) v[e] = 0.f;
#endif
            xr[64 * j] = v; }
    }
}
__device__ __forceinline__ void phase_ssm_norm(ArgsP a, int l, bf16_t* buf) {
    const int lane = otid() & 63, wave = otid() >> 6, gw = blockIdx.x * 8 + wave, NGW = gridDim.x * 8;
    const float* gn = a->in[I_SNORM] + l * 512 + lane * 8;
    float g[8];
#pragma unroll
    for (int j = 0; j < 8; ++j) g[j] = gn[j];
    for (int t = gw; t < T_ALL; t += NGW) {
        u32x4* p = (u32x4*)(buf + (size_t)t * 512) + lane; const u32x4 w = *p;
        float v[8] = {bflo(w.x), bfhi(w.x), bflo(w.y), bfhi(w.y), bflo(w.z), bfhi(w.z), bflo(w.w), bfhi(w.w)};
        float s = 0.f;
#pragma unroll
        for (int j = 0; j < 8; ++j) s += v[j] * v[j];
        const float rs = rsqrtf(wave_sum(s) * (1.0f / 512.0f) + EPS);
        u32x4 o; o.x = pk2(v[0] * rs * g[0], v[1] * rs * g[1]); o.y = pk2(v[2] * rs * g[2], v[3] * rs * g[3]); o.z = pk2(v[4] * rs * g[4], v[5] * rs * g[5]); o.w = pk2(v[6] * rs * g[6], v[7] * rs * g[7]);
        *p = o;
    }
}
constexpr int SLD = 136;
__device__ __forceinline__ void seq_bounds(int t0, int& lo, int& hi) { if (t0 < TP) { lo = t0 & ~2047; hi = lo + 2048; } else { lo = TP + ((t0 - TP) & ~4095); hi = lo + 4096; } }
__device__ __forceinline__ float silu_f(float x) { return x / (1.0f + __expf(-x)); }

template <int NC, bool TRANS>
__device__ __forceinline__ void load_conv_tile(const bf16_t* src, int ldsrc, int col0, int t0, int lo, int hi, const float* cw, const float* cbias, int ch0, LAS bf16_t* dst) {
    constexpr int CGS = NC / 8, RUNS = 512 / CGS, R = 128 / RUNS;
    const int tid = otid(), cgi = tid % CGS, run = tid / CGS, c = cgi * 8, r0 = run * R;
    float w[5][8], bb[8];
#pragma unroll
    for (int k = 0; k < 5; ++k) { const f32x4 a0 = *(const f32x4*)(cw + k * 1024 + ch0 + c), a1 = *(const f32x4*)(cw + k * 1024 + ch0 + c + 4);
#pragma unroll
        for (int e = 0; e < 4; ++e) { w[k][e] = a0[e]; w[k][4 + e] = a1[e]; } }
    { const f32x4 a0 = *(const f32x4*)(cbias + ch0 + c), a1 = *(const f32x4*)(cbias + ch0 + c + 4);
#pragma unroll
      for (int e = 0; e < 4; ++e) { bb[e] = a0[e]; bb[4 + e] = a1[e]; } }
    float win[5][8];
    auto ldrow = [&](int t, float (&o)[8]) {
        if (t >= lo && t < hi) { const u32x4 q = *(const u32x4*)(src + (size_t)t * ldsrc + col0 + c);
            o[0] = bflo(q.x); o[1] = bfhi(q.x); o[2] = bflo(q.y); o[3] = bfhi(q.y); o[4] = bflo(q.z); o[5] = bfhi(q.z); o[6] = bflo(q.w); o[7] = bfhi(q.w); }
        else {
#pragma unroll
            for (int e = 0; e < 8; ++e) o[e] = 0.f; }
    };
#pragma unroll
    for (int i = 0; i < 4; ++i) ldrow(t0 + r0 - 2 + i, win[i]);
    unsigned outp[8][R / 2];
#pragma unroll
    for (int rr = 0; rr < R; ++rr) {
        ldrow(t0 + r0 + rr + 2, win[(rr + 4) % 5]);
        float o[8];
#pragma unroll
        for (int e = 0; e < 8; ++e) { float s = bb[e];
#pragma unroll
            for (int k = 0; k < 5; ++k) s += w[k][e] * win[(rr + k) % 5][e];
            o[e] = silu_f(s); }
        if (!TRANS) { u32x4 q; q.x = pk2(o[0], o[1]); q.y = pk2(o[2], o[3]); q.z = pk2(o[4], o[5]); q.w = pk2(o[6], o[7]); *(LAS u32x4*)(dst + (r0 + rr) * SLD + c) = q; }
        else {
#pragma unroll
            for (int e = 0; e < 8; ++e) { if (rr & 1) outp[e][rr >> 1] = (outp[e][rr >> 1] & 0xffffu) | (pk2(0.f, o[e]) & 0xffff0000u); else outp[e][rr >> 1] = pk2(o[e], 0.f) & 0xffffu; } }
    }
    if (TRANS) {
#pragma unroll
        for (int e = 0; e < 8; ++e) {
            if (R == 8) { u32x4 q; q.x = outp[e][0]; q.y = outp[e][1]; q.z = outp[e][2]; q.w = outp[e][R / 2 - 1]; *(LAS u32x4*)(dst + (c + e) * SLD + r0) = q; }
            else { u32x2 q; q.x = outp[e][0]; q.y = outp[e][R / 2 - 1]; *(LAS u32x2*)(dst + (c + e) * SLD + r0) = q; }
        }
    }
}
__device__ __forceinline__ void chunk_scan(const float* dt, int t0, int col, float A, int dir, int lane, float& d0, float& d1, float& c0, float& c1, float& total) {
    d0 = dt[(size_t)(t0 + 2 * lane) * 16 + col]; d1 = dt[(size_t)(t0 + 2 * lane + 1) * 16 + col];
    const float a0 = d0 * A, a1 = d1 * A;
    float v = a0 + a1;
#pragma unroll
    for (int d = 1; d < 64; d <<= 1) { const float tt = __shfl_up(v, d); if (lane >= d) v += tt; }
    total = __shfl(v, 63);
    const float p0 = v - a1, p1 = v;
    if (dir == 0) { c0 = p0; c1 = p1; } else { c0 = total - p0 + a0; c1 = total - p1 + a1; }
}
__device__ __forceinline__ bf16x8 scale_frag8(bf16x8 f, const float (&sc)[8]) {
    union { bf16x8 v; unsigned u[4]; } in, out; in.v = f;
#pragma unroll
    for (int j = 0; j < 4; ++j) out.u[j] = pk2(bflo(in.u[j]) * sc[2 * j], bfhi(in.u[j]) * sc[2 * j + 1]);
    return out.v;
}
__device__ __forceinline__ void phase_s1(ArgsP a, int l, int cbase, LAS unsigned char* lds, const bf16_t* xs_raw, const bf16_t* bc_raw, bf16_t* states) {
    const int tid = otid(), lane = tid & 63, wave = __builtin_amdgcn_readfirstlane(tid >> 6);
    LAS bf16_t* xsT = (LAS bf16_t*)lds;
    LAS bf16_t* BT = (LAS bf16_t*)(lds + 256 * SLD * 2);
    LAS float* sW = (LAS float*)(lds + 384 * SLD * 2);
    const float* dt = (const float*)(a->ws + WS_DT); float* decay = (float*)(a->ws + WS_DECAY);
    const float* cw = a->in[I_SCW] + l * 5 * 1024; const float* cbs = a->in[I_SCB] + l * 1024;
    for (int it = blockIdx.x; it < 256; it += gridDim.x) {
        const int gc = cbase + (it >> 1), g = it & 1, t0 = gc * 128; int lo, hi; seq_bounds(t0, lo, hi);
        const int hh = wave >> 1, dir = wave & 1, h8 = g * 4 + hh;
        { float d0, d1, c0, c1, tot; const float A = -__expf(a->in[I_ALOG][l * 16 + dir * 8 + h8]);
          chunk_scan(dt, t0, dir * 8 + h8, A, dir, lane, d0, d1, c0, c1, tot);
          sW[wave * 128 + 2 * lane] = d0 * __expf(tot - c0); sW[wave * 128 + 2 * lane + 1] = d1 * __expf(tot - c1);
          if (lane == 0) decay[gc * 16 + h8 * 2 + dir] = __expf(tot); }
        load_conv_tile<256, true>(xs_raw, 512, g * 256, t0, lo, hi, cw, cbs, g * 256, xsT);
        load_conv_tile<128, true>(bc_raw, 512, g * 128, t0, lo, hi, cw, cbs, 512 + g * 128, BT);
        __syncthreads();
        f32x4 acc[8][4];
#pragma unroll
        for (int i = 0; i < 8; ++i)
#pragma unroll
            for (int j = 0; j < 4; ++j) acc[i][j] = (f32x4){0.f, 0.f, 0.f, 0.f};
        const int fr = lane & 15, fq = lane >> 4;
#pragma unroll 1
        for (int ks = 0; ks < 4; ++ks) {
            const int s0 = ks * 32 + fq * 8;
            float sc[8]; { const f32x4 q0 = *(const LAS f32x4*)(sW + wave * 128 + s0), q1 = *(const LAS f32x4*)(sW + wave * 128 + s0 + 4);
#pragma unroll
                for (int e = 0; e < 4; ++e) { sc[e] = q0[e]; sc[4 + e] = q1[e]; } }
            bf16x8 xf[4];
#pragma unroll
            for (int pt = 0; pt < 4; ++pt) xf[pt] = scale_frag8(*(const LAS bf16x8*)(xsT + (hh * 64 + pt * 16 + fr) * SLD + s0), sc);
#pragma unroll
            for (int nt = 0; nt < 8; ++nt) { const bf16x8 bf = *(const LAS bf16x8*)(BT + (nt * 16 + fr) * SLD + s0);
#pragma unroll
                for (int pt = 0; pt < 4; ++pt) acc[nt][pt] = __builtin_amdgcn_mfma_f32_16x16x32_bf16(bf, xf[pt], acc[nt][pt], 0, 0, 0); }
        }
        bf16_t* st = states + ((size_t)((gc - cbase) * 8 + h8) * 2 + dir) * 8192;
#pragma unroll
        for (int nt = 0; nt < 8; ++nt)
#pragma unroll
            for (int pt = 0; pt < 4; ++pt) { u32x2 q; q.x = pk2(acc[nt][pt][0], acc[nt][pt][1]); q.y = pk2(acc[nt][pt][2], acc[nt][pt][3]); *(u32x2*)(st + (pt * 16 + fr) * 128 + nt * 16 + fq * 4) = q; }
        __syncthreads();
    }
}
__device__ __forceinline__ void phase_s2(ArgsP a, int cbase, bf16_t* states) {
    const int nseq = cbase == 0 ? 8 : 4, cps = cbase == 0 ? 16 : 32;
    const float* decay = (const float*)(a->ws + WS_DECAY);
    const int total = nseq * 16 * 1024;
    for (int i = blockIdx.x * 512 + otid(); i < total; i += gridDim.x * 512) {
        const int e8 = i & 1023, hd = (i >> 10) & 15, sq = i >> 14, dir = hd & 1;
        float hs[8];
#pragma unroll
        for (int j = 0; j < 8; ++j) hs[j] = 0.f;
        for (int cc = 0; cc < cps; ++cc) {
            const int crel = sq * cps + (dir ? cps - 1 - cc : cc);
            u32x4* p = (u32x4*)(states + ((size_t)crel * 16 + hd) * 8192) + e8; const u32x4 w = *p;
            const float dc = decay[(cbase + crel) * 16 + hd];
            u32x4 o; o.x = pk2(hs[0], hs[1]); o.y = pk2(hs[2], hs[3]); o.z = pk2(hs[4], hs[5]); o.w = pk2(hs[6], hs[7]); *p = o;
            hs[0] = hs[0] * dc + bflo(w.x); hs[1] = hs[1] * dc + bfhi(w.x); hs[2] = hs[2] * dc + bflo(w.y); hs[3] = hs[3] * dc + bfhi(w.y);
            hs[4] = hs[4] * dc + bflo(w.z); hs[5] = hs[5] * dc + bfhi(w.z); hs[6] = hs[6] * dc + bflo(w.w); hs[7] = hs[7] * dc + bfhi(w.w);
        }
    }
}
__device__ __forceinline__ void phase_s3(ArgsP a, int l, int cbase, LAS unsigned char* lds, const bf16_t* xs_raw, const bf16_t* bc_raw, const bf16_t* states, bf16_t* gate) {
    const int tid = otid(), lane = tid & 63, wave = __builtin_amdgcn_readfirstlane(tid >> 6), fr = lane & 15, fq = lane >> 4;
    LAS bf16_t* xsT = (LAS bf16_t*)lds;
    LAS bf16_t* sC = (LAS bf16_t*)(lds + 128 * SLD * 2);
    LAS bf16_t* sB = (LAS bf16_t*)(lds + 256 * SLD * 2);
    LAS float* sDt = (LAS float*)(lds + 384 * SLD * 2);
    LAS float* sCs = sDt + 512;
    const float* dt = (const float*)(a->ws + WS_DT);
    const float* cw = a->in[I_SCW] + l * 5 * 1024; const float* cbs = a->in[I_SCB] + l * 1024;
    for (int it = blockIdx.x; it < 512; it += gridDim.x) {
        const int gc = cbase + (it >> 2), g = (it >> 1) & 1, hp = it & 1, t0 = gc * 128; int lo, hi; seq_bounds(t0, lo, hi);
        { const int w4 = wave & 3, hh2 = w4 >> 1, dir = w4 & 1, h8 = g * 4 + hp * 2 + hh2; float d0, d1, c0, c1, tot; const float A = -__expf(a->in[I_ALOG][l * 16 + dir * 8 + h8]);
          chunk_scan(dt, t0, dir * 8 + h8, A, dir, lane, d0, d1, c0, c1, tot);
          if (wave < 4) { sDt[w4 * 128 + 2 * lane] = d0; sDt[w4 * 128 + 2 * lane + 1] = d1; sCs[w4 * 128 + 2 * lane] = c0; sCs[w4 * 128 + 2 * lane + 1] = c1; } }
        load_conv_tile<128, true>(xs_raw, 512, g * 256 + hp * 128, t0, lo, hi, cw, cbs, g * 256 + hp * 128, xsT);
        load_conv_tile<128, false>(bc_raw, 512, g * 128, t0, lo, hi, cw, cbs, 512 + g * 128, sB);
        load_conv_tile<128, false>(bc_raw, 512, 256 + g * 128, t0, lo, hi, cw, cbs, 768 + g * 128, sC);
        __syncthreads();
#ifdef S3_PROBE
        { int pb = 99; for (int r = wave; r < 128; r += 8) { const unsigned short v0 = xsT[r * SLD + lane], v1 = xsT[r * SLD + 64 + lane]; if ((v0 & 0x7f80) == 0x7f80 || (v1 & 0x7f80) == 0x7f80) pb = 1; const unsigned short c0 = sC[r * SLD + lane], c1 = sC[r * SLD + 64 + lane]; if (!(fabsf(bf2f(c0)) < 1e4f) || !(fabsf(bf2f(c1)) < 1e4f)) pb = min(pb, 2); const unsigned short b0 = sB[r * SLD + lane], b1 = sB[r * SLD + 64 + lane]; if (!(fabsf(bf2f(b0)) < 1e4f) || !(fabsf(bf2f(b1)) < 1e4f)) pb = min(pb, 3); }
          if (pb < 99) atomicMax((int*)(a->ws + 106 * MiB + 262144), 100 - pb); }
#endif
        {
            f32x4 cacc[8];
#pragma unroll
            for (int i = 0; i < 8; ++i) cacc[i] = (f32x4){0.f, 0.f, 0.f, 0.f};
#pragma unroll
            for (int ks = 0; ks < 4; ++ks) { const bf16x8 cf = *(const LAS bf16x8*)(sC + (wave * 16 + fr) * SLD + ks * 32 + fq * 8);
#pragma unroll
                for (int st = 0; st < 8; ++st) { const bf16x8 bf = *(const LAS bf16x8*)(sB + (st * 16 + fr) * SLD + ks * 32 + fq * 8); cacc[st] = __builtin_amdgcn_mfma_f32_16x16x32_bf16(bf, cf, cacc[st], 0, 0, 0); } }
            __syncthreads();
#pragma unroll
            for (int st = 0; st < 8; ++st) { u32x2 q; q.x = pk2(cacc[st][0], cacc[st][1]); q.y = pk2(cacc[st][2], cacc[st][3]); *(LAS u32x2*)(sB + (wave * 16 + fr) * SLD + st * 16 + fq * 4) = q; }
            __syncthreads();
        }
#ifdef S3_PROBE
        { int pb = 99; for (int r = wave; r < 128; r += 8) { const unsigned short v0 = xsT[r * SLD + lane], v1 = xsT[r * SLD + 64 + lane]; if ((v0 & 0x7f80) == 0x7f80 || (v1 & 0x7f80) == 0x7f80) pb = 4; const unsigned short b0 = sB[r * SLD + lane], b1 = sB[r * SLD + 64 + lane]; if (!(fabsf(bf2f(b0)) < 1e8f) || !(fabsf(bf2f(b1)) < 1e8f)) pb = min(pb, 5); }
          for (int i = lane; i < 512; i += 64) { if (!(fabsf(sDt[i]) < 1e30f)) pb = min(pb, 6); if (!(fabsf(sCs[i]) < 1e30f)) pb = min(pb, 7); if (sCs[i] > 0.f) pb = min(pb, 8); }
          if (pb < 99) atomicMax((int*)(a->ws + 106 * MiB + 262144), 100 - pb); }
#endif
        const int hh2 = wave >> 2, lq = wave & 3, h8 = g * 4 + hp * 2 + hh2;
        const float Dh = a->in[I_SD][l * 8 + h8];
        const LAS float* dtf = sDt + (hh2 * 2) * 128; const LAS float* dtb = sDt + (hh2 * 2 + 1) * 128; const LAS float* csf = sCs + (hh2 * 2) * 128; const LAS float* csb = sCs + (hh2 * 2 + 1) * 128;
        int probe = 99; (void)probe;
        f32x4 acc[2][4];
#pragma unroll
        for (int i = 0; i < 2; ++i)
#pragma unroll
            for (int j = 0; j < 4; ++j) acc[i][j] = (f32x4){0.f, 0.f, 0.f, 0.f};
#pragma unroll 1
        for (int ks = 0; ks < 4; ++ks) {
            const int s0 = ks * 32 + fq * 8;
            bf16x8 xf[4];
#pragma unroll
            for (int pt = 0; pt < 4; ++pt) xf[pt] = *(const LAS bf16x8*)(xsT + (hh2 * 64 + pt * 16 + fr) * SLD + s0);
            float vdf[8], vdb[8], vcf[8], vcb[8];
            { const f32x4 q0 = *(const LAS f32x4*)(dtf + s0), q1 = *(const LAS f32x4*)(dtf + s0 + 4), r0 = *(const LAS f32x4*)(dtb + s0), r1 = *(const LAS f32x4*)(dtb + s0 + 4);
              const f32x4 u0 = *(const LAS f32x4*)(csf + s0), u1 = *(const LAS f32x4*)(csf + s0 + 4), w0 = *(const LAS f32x4*)(csb + s0), w1 = *(const LAS f32x4*)(csb + s0 + 4);
#pragma unroll
              for (int e = 0; e < 4; ++e) { vdf[e] = q0[e]; vdf[4 + e] = q1[e]; vdb[e] = r0[e]; vdb[4 + e] = r1[e]; vcf[e] = u0[e]; vcf[4 + e] = u1[e]; vcb[e] = w0[e]; vcb[4 + e] = w1[e]; } }
#pragma unroll
            for (int lt = 0; lt < 2; ++lt) {
                const int lrow = lq * 32 + lt * 16 + fr;
                const float csf_l = csf[lrow], csb_l = csb[lrow];
                const u32x4 cbq = *(const LAS u32x4*)(sB + lrow * SLD + s0);
                const float cbv[8] = {bflo(cbq.x), bfhi(cbq.x), bflo(cbq.y), bfhi(cbq.y), bflo(cbq.z), bfhi(cbq.z), bflo(cbq.w), bfhi(cbq.w)};
                float mv[8];
#pragma unroll
                for (int e = 0; e < 8; ++e) { const int s = s0 + e;
                    const float ex = s < lrow ? csf_l - vcf[e] : csb_l - vcb[e];
                    const float dd = s < lrow ? vdf[e] : vdb[e];
                    float mm = cbv[e] * __expf(ex) * dd;
                    if (s == lrow) mm = cbv[e] * (vdf[e] + vdb[e]) + Dh;
                    mv[e] = mm;
#ifdef S3_PROBE2
                    if (!(fabsf(cbv[e]) < 1e30f)) probe = min(probe, 11); if (ex > 0.f) probe = min(probe, 12); if (!(fabsf(mm) < 1e30f)) probe = min(probe, 13);
#endif
                    }
                union { bf16x8 v; unsigned u[4]; } mf;
#pragma unroll
                for (int j = 0; j < 4; ++j) mf.u[j] = pk2(mv[2 * j], mv[2 * j + 1]);
#pragma unroll
                for (int pt = 0; pt < 4; ++pt) acc[lt][pt] = __builtin_amdgcn_mfma_f32_16x16x32_bf16(xf[pt], mf.v, acc[lt][pt], 0, 0, 0);
            }
        }
#ifdef S3_PROBE2
        for (int i = 0; i < 2; ++i) for (int j = 0; j < 4; ++j) for (int e = 0; e < 4; ++e) if (!(fabsf(acc[i][j][e]) < 1e30f)) probe = min(probe, 14);
#endif
#pragma unroll 1
        for (int dir = 0; dir < 2; ++dir) {
            const bf16_t* pv = states + ((size_t)((gc - cbase) * 8 + h8) * 2 + dir) * 8192;
            const LAS float* cs = dir ? csb : csf;
            float el[2];
#pragma unroll
            for (int lt = 0; lt < 2; ++lt) el[lt] = __expf(cs[lq * 32 + lt * 16 + fr]);
#pragma unroll 1
            for (int ks = 0; ks < 4; ++ks) {
                const int n0 = ks * 32 + fq * 8;
                bf16x8 pf[4];
#pragma unroll
                for (int pt = 0; pt < 4; ++pt) pf[pt] = *(const bf16x8*)(pv + (pt * 16 + fr) * 128 + n0);
#pragma unroll
                for (int lt = 0; lt < 2; ++lt) {
                    const float sc[8] = {el[lt], el[lt], el[lt], el[lt], el[lt], el[lt], el[lt], el[lt]};
                    const bf16x8 cf = scale_frag8(*(const LAS bf16x8*)(sC + (lq * 32 + lt * 16 + fr) * SLD + n0), sc);
#pragma unroll
                    for (int pt = 0; pt < 4; ++pt) acc[lt][pt] = __builtin_amdgcn_mfma_f32_16x16x32_bf16(pf[pt], cf, acc[lt][pt], 0, 0, 0);
                }
            }
        }
#ifdef S3_PROBE2
        for (int i = 0; i < 2; ++i) for (int j = 0; j < 4; ++j) for (int e = 0; e < 4; ++e) if (!(fabsf(acc[i][j][e]) < 1e30f)) probe = min(probe, 15);
#endif
#pragma unroll
        for (int lt = 0; lt < 2; ++lt)
#pragma unroll
            for (int pt = 0; pt < 4; ++pt) {
                u32x2* gp = (u32x2*)(gate + (size_t)(t0 + lq * 32 + lt * 16 + fr) * 512 + g * 256 + (hp * 2 + hh2) * 64 + pt * 16 + fq * 4);
                const u32x2 gq = *gp;
                u32x2 o; o.x = pk2(acc[lt][pt][0] * silu_f(bflo(gq.x)), acc[lt][pt][1] * silu_f(bfhi(gq.x))); o.y = pk2(acc[lt][pt][2] * silu_f(bflo(gq.y)), acc[lt][pt][3] * silu_f(bfhi(gq.y)));
                *gp = o;
#ifdef S3_PROBE2
                if ((gq.x & 0x7f80u) == 0x7f80u || (gq.x & 0x7f800000u) == 0x7f800000u || (gq.y & 0x7f80u) == 0x7f80u || (gq.y & 0x7f800000u) == 0x7f800000u) probe = min(probe, 16);
                if ((o.x & 0x7f80u) == 0x7f80u || (o.x & 0x7f800000u) == 0x7f800000u || (o.y & 0x7f80u) == 0x7f80u || (o.y & 0x7f800000u) == 0x7f800000u) probe = min(probe, 17);
#endif
            }
#ifdef S3_PROBE2
        if (probe < 99) atomicMax((int*)(a->ws + 106 * MiB + 262144), 100 - probe);
#endif
        __syncthreads();
    }
}
__device__ __forceinline__ f32x2 cmul(f32x2 a, f32x2 b) { return (f32x2){a.x * b.x - a.y * b.y, a.x * b.y + a.y * b.x}; }
__device__ __forceinline__ f32x2 cmulc(f32x2 a, f32x2 b) { return (f32x2){a.x * b.x + a.y * b.y, a.y * b.x - a.x * b.y}; }
template <int LOGN> __device__ __forceinline__ void fft_fwd(LAS f32x2* d, const LAS f32x2* tw) {
    constexpr int N = 1 << LOGN;
#pragma unroll 1
    for (int ls = LOGN - 1; ls >= 1; ls -= 2) {
        const int s = 1 << ls, hs = s >> 1;
        for (int q = otid(); q < N / 4; q += 512) {
            const int j = q & (hs - 1), blk = q >> (ls - 1), base = (blk << (ls + 1)) + j;
            const f32x2 x0 = d[base], x1 = d[base + hs], x2 = d[base + s], x3 = d[base + s + hs];
            const f32x2 w1 = tw[j << (12 - ls)], w2 = tw[j << (13 - ls)];
            const f32x2 a0 = x0 + x2, a2 = cmul(x0 - x2, w1), a1 = x1 + x3; f32x2 t = x1 - x3; t = (f32x2){t.y, -t.x}; const f32x2 a3 = cmul(t, w1);
            d[base] = a0 + a1; d[base + hs] = cmul(a0 - a1, w2); d[base + s] = a2 + a3; d[base + s + hs] = cmul(a2 - a3, w2);
        }
        __syncthreads();
    }
    if (LOGN & 1) {
        for (int q = otid(); q < N / 2; q += 512) { const f32x2 x0 = d[2 * q], x1 = d[2 * q + 1]; d[2 * q] = x0 + x1; d[2 * q + 1] = x0 - x1; }
        __syncthreads();
    }
}
template <int LOGN> __device__ __forceinline__ void fft_inv(LAS f32x2* d, const LAS f32x2* tw) {
    constexpr int N = 1 << LOGN;
    if (LOGN & 1) {
        for (int q = otid(); q < N / 2; q += 512) { const f32x2 x0 = d[2 * q], x1 = d[2 * q + 1]; d[2 * q] = x0 + x1; d[2 * q + 1] = x0 - x1; }
        __syncthreads();
    }
#pragma unroll 1
    for (int ls = (LOGN & 1) ? 2 : 1; ls <= LOGN - 1; ls += 2) {
        const int s = 1 << ls, hs = s >> 1;
        for (int q = otid(); q < N / 4; q += 512) {
            const int j = q & (hs - 1), blk = q >> (ls - 1), base = (blk << (ls + 1)) + j;
            const f32x2 b0 = d[base], b1 = d[base + hs], b2 = d[base + s], b3 = d[base + s + hs];
            const f32x2 w1 = tw[j << (12 - ls)], w2 = tw[j << (13 - ls)];
            f32x2 v = cmulc(b1, w2); const f32x2 a0 = b0 + v, a1 = b0 - v; v = cmulc(b3, w2); const f32x2 a2 = b2 + v, a3 = b2 - v;
            v = cmulc(a2, w1); d[base] = a0 + v; d[base + s] = a0 - v;
            v = cmulc(a3, w1); v = (f32x2){-v.y, v.x}; d[base + hs] = a1 + v; d[base + s + hs] = a1 - v;
        }
        __syncthreads();
    }
}
template <int LOGN> __device__ __forceinline__ void hyena_conv_item(ArgsP a, int l, int c, LAS unsigned char* lds, const bf16_t* x1T, bf16_t* vT) {
    constexpr int N = 1 << LOGN, L = N / 2, SET = (LOGN == 13), NB = SET ? 4 : 8, TOK0 = SET ? TP : 0, NJ = L / 512, NK = N / 512;
    LAS f32x2* d = (LAS f32x2*)lds;
    LAS f32x2* tw = (LAS f32x2*)(lds + 65536);
    LAS float* sfw = (LAS float*)(lds + 65536 + 32768);
    const int tid = otid();
    if (tid < 128) sfw[tid] = a->in[I_FW3][(size_t)l * 64 * 1024 + (size_t)(tid & 63) * 1024 + (tid >> 6) * 512 + c];
    __syncthreads();
    const float min_decay = -3.0701134573253944f, max_decay = -15.350567286626972f;
    const float delta = fabsf(min_decay + (float)c * ((max_decay - min_decay) / 511.0f));
    const float b3f = a->in[I_FB3][l * 1024 + c], b3b = a->in[I_FB3][l * 1024 + 512 + c];
    const float* h2 = (const float*)(a->ws + WS_H2) + ((size_t)l * 6144 + (SET ? 2048 : 0)) * 64;
    for (int t = tid; t < L; t += 512) {
        const f32x4* hr = (const f32x4*)(h2 + (size_t)t * 64); float hf = b3f, hb = b3b;
#pragma unroll
        for (int i = 0; i < 16; ++i) { const f32x4 h = hr[i]; const f32x4 wf = *(const LAS f32x4*)(sfw + 4 * i), wb = *(const LAS f32x4*)(sfw + 64 + 4 * i);
            hf += (h[0] * wf[0] + h[1] * wf[1]) + (h[2] * wf[2] + h[3] * wf[3]); hb += (h[0] * wb[0] + h[1] * wb[1]) + (h[2] * wb[2] + h[3] * wb[3]); }
        const float dec = __expf(-((float)t / (float)(L - 1)) * delta);
        d[t] = (f32x2){hf * dec, 0.f};
        if (t >= 1) d[N - t] = (f32x2){hb * dec, 0.f};
    }
    if (tid == 0) d[L] = (f32x2){0.f, 0.f};
    __syncthreads();
    fft_fwd<LOGN>(d, tw);
    f32x2 kf[NK];
#pragma unroll
    for (int j = 0; j < NK; ++j) kf[j] = d[tid + 512 * j] * (1.0f / (float)N);
    __syncthreads();
    const float* cw = a->in[I_HCW] + l * 3 * 1536; const float cb1 = a->in[I_HCB][l * 1536 + 512 + c], cbv = a->in[I_HCB][l * 1536 + 1024 + c];
    const float w10 = cw[512 + c], w11 = cw[1536 + 512 + c], w12 = cw[3072 + 512 + c], wv0 = cw[1024 + c], wv1 = cw[1536 + 1024 + c], wv2 = cw[3072 + 1024 + c];
    const float hbias = a->in[I_HBIAS][l * 512 + c];
#pragma unroll 1
    for (int bp = 0; bp < NB / 2; ++bp) {
        const size_t rowA = (size_t)c * T_ALL + TOK0 + (size_t)(2 * bp) * L, rowB = rowA + L;
        float zA[NJ], zB[NJ];
#pragma unroll
        for (int jj = 0; jj < NJ; ++jj) {
            const int t = tid + 512 * jj;
            const bool hasl = t > 0, hasr = t < L - 1;
            const float a1m = hasl ? bf2f(x1T[rowA + t - 1]) : 0.f, a1c = bf2f(x1T[rowA + t]), a1p = hasr ? bf2f(x1T[rowA + t + 1]) : 0.f;
            const float avm = hasl ? bf2f(vT[rowA + t - 1]) : 0.f, avc = bf2f(vT[rowA + t]), avp = hasr ? bf2f(vT[rowA + t + 1]) : 0.f;
            const float b1m = hasl ? bf2f(x1T[rowB + t - 1]) : 0.f, b1c = bf2f(x1T[rowB + t]), b1p = hasr ? bf2f(x1T[rowB + t + 1]) : 0.f;
            const float bvm = hasl ? bf2f(vT[rowB + t - 1]) : 0.f, bvc = bf2f(vT[rowB + t]), bvp = hasr ? bf2f(vT[rowB + t + 1]) : 0.f;
            zA[jj] = (cb1 + w10 * a1m + w11 * a1c + w12 * a1p) * (cbv + wv0 * avm + wv1 * avc + wv2 * avp);
            zB[jj] = (cb1 + w10 * b1m + w11 * b1c + w12 * b1p) * (cbv + wv0 * bvm + wv1 * bvc + wv2 * bvp);
            d[t] = (f32x2){zA[jj], zB[jj]}; d[L + t] = (f32x2){0.f, 0.f};
        }
        __syncthreads();
        fft_fwd<LOGN>(d, tw);
#pragma unroll
        for (int j = 0; j < NK; ++j) d[tid + 512 * j] = cmul(d[tid + 512 * j], kf[j]);
        __syncthreads();
        fft_inv<LOGN>(d, tw);
#pragma unroll
        for (int jj = 0; jj < NJ; ++jj) {
            const int t = tid + 512 * jj; const f32x2 y = d[t];
            vT[rowA + t] = (bf16_t)(pk2(y.x + zA[jj] * hbias, 0.f) & 0xffffu);
            vT[rowB + t] = (bf16_t)(pk2(y.y + zB[jj] * hbias, 0.f) & 0xffffu);
        }
        __syncthreads();
    }
}
__device__ __forceinline__ void phase_hyena_conv(ArgsP a, int l, LAS unsigned char* lds, const bf16_t* x1T, bf16_t* vT) {
    { LAS f32x2* tw = (LAS f32x2*)(lds + 65536); const f32x2* g = (const f32x2*)(a->ws + WS_TW); for (int i = otid(); i < 4096; i += 512) tw[i] = g[i]; }
    __syncthreads();
    for (int it = blockIdx.x; it < 1024; it += gridDim.x) {
        if (it < 512) hyena_conv_item<13>(a, l, it, lds, x1T, vT);
        else hyena_conv_item<12>(a, l, it - 512, lds, x1T, vT);
    }
}
__device__ __forceinline__ void phase_hyena_norm(ArgsP a, int l, LAS unsigned char* lds, const bf16_t* x0T, const bf16_t* yT, bf16_t* hyn) {
    constexpr int PLD = 513;
    LAS float* P = (LAS float*)lds;
    LAS float* part = (LAS float*)(lds + 32 * PLD * 4);
    const int tid = otid(), lane = tid & 63, wave = tid >> 6, tl0 = lane & 31, cpar = lane >> 5;
    const float* cw = a->in[I_HCW] + l * 3 * 1536; const float* cb = a->in[I_HCB] + l * 1536;
    for (int it = blockIdx.x; it < T_ALL / 32; it += gridDim.x) {
        const int tile0 = it * 32, t = tile0 + tl0; int lo, hi; seq_bounds(tile0, lo, hi);
        const bool hasl = t > lo, hasr = t < hi - 1;
        float ss = 0.f;
#pragma unroll 4
        for (int i = 0; i < 32; ++i) {
            const int c = wave * 64 + 2 * i + cpar; const size_t row = (size_t)c * T_ALL;
            const float xm = hasl ? bf2f(x0T[row + t - 1]) : 0.f, xc = bf2f(x0T[row + t]), xp = hasr ? bf2f(x0T[row + t + 1]) : 0.f;
            const float x0c = cb[c] + cw[c] * xm + cw[1536 + c] * xc + cw[3072 + c] * xp;
            const float p = x0c * bf2f(yT[row + t]);
            P[tl0 * PLD + c] = p; ss += p * p;
        }
        ss += __shfl_xor(ss, 32);
        if (lane < 32) part[wave * 32 + lane] = ss;
        __syncthreads();
#pragma unroll 1
        for (int r = 0; r < 4; ++r) {
            const int tl = wave * 4 + r;
            float s = 0.f;
#pragma unroll
            for (int w = 0; w < 8; ++w) s += part[w * 32 + tl];
            const float rs = rsqrtf(s * (1.0f / 512.0f) + EPS);
            bf16_t* orow = hyn + (size_t)(tile0 + tl) * 512;
#pragma unroll
            for (int j = 0; j < 4; ++j) { const int c = 2 * lane + 128 * j;
                const float v0 = P[tl * PLD + c] * rs * a->in[I_HNORM][l * 512 + c], v1 = P[tl * PLD + c + 1] * rs * a->in[I_HNORM][l * 512 + c + 1];
                *(unsigned*)(orow + c) = pk2(v0, v1); }
        }
        __syncthreads();
    }
}
__device__ __forceinline__ void epi_cfg(int st, int gi, int l, unsigned char* ws, float* out, ArgsP a, Epi& E) {
    float* ssq = (float*)(ws + WS_SSQ); bf16_t* xb = (bf16_t*)(ws + WS_XB);
    bf16_t* r1a = (bf16_t*)(ws + WS_R1A); bf16_t* r1b = (bf16_t*)(ws + WS_R1B); bf16_t* r2 = (bf16_t*)(ws + WS_R2); bf16_t* r3 = (bf16_t*)(ws + WS_R3);
    bf16_t* kmat = (bf16_t*)(ws + WS_R4); bf16_t* vtm = (bf16_t*)(ws + WS_R4 + 6 * MiB);
    float* ssq_in = ssq + (size_t)(3 * l) * T_ALL; float* ssq_a = ssq_in + T_ALL; float* ssq_m = ssq_a + T_ALL; float* ssq_n = ssq_m + T_ALL;
    const int half = (st >= 16) ? ((st - 16) >> 1) : 0;
    E.kind = 0; E.O0 = r1a; E.d1 = 0; E.d2 = 0; E.ldc = 1024; E.csplit = 0; E.rsplit = 0; E.ssq = ssq_in; E.psum = (float*)(ws + WS_PSUM); E.row_off = 0; E.SCALE = 0; E.ACT = 0;
    E.X = out; E.rin0 = out; E.rin1 = out + (size_t)TP * DM; E.xb = xb; E.ssq_out = ssq_a;
    if (st == 1)       { E.O0 = r1b; E.d1 = r2 - r1b; E.d2 = r3 - r2; E.ldc = 512; E.csplit = 2; E.SCALE = 1; }
    else if (st == 8)  { E.O0 = r2; E.d1 = r1a - r2; E.d2 = r3 - r1a; E.ldc = T_ALL; E.rsplit = 2; E.SCALE = 2; }
    else if (st == 11) { E.kind = 1; if (l == 0) { E.rin0 = a->in[I_XP]; E.rin1 = a->in[I_XS]; } }
    else if (st == 12) {
        if (gi == 0)      { E.SCALE = 1; E.ssq = ssq_a; }
        else if (gi == 1) { E.O0 = kmat; }
        else              { E.O0 = vtm; E.ldc = 3072; }
    }
    else if (st == 13) { E.O0 = r2; E.ACT = 2; }
    else if (st == 14) { E.SCALE = 3; }
    else if (st == 15) { E.kind = 1; E.ssq_out = ssq_m; }
    else if (st == 16 || st == 18) { E.ldc = 4096; E.SCALE = 1; E.ACT = 1; E.ssq = ssq_m; E.row_off = half * TP; }
    else               { E.kind = 1; E.ssq_out = ssq_n; E.row_off = half * TP; }
}
template <int KIND> struct EpiT {
    static constexpr bool PERM = true;
    int st, gi, l; unsigned char* ws; float* out; ArgsP a;
    __device__ __forceinline__ void operator()(const f32x4 (&acc)[2][2][4][2], const pg8::Unit& u, int wr, int wc, int fr, int fq) const {
        int st_ = st; asm volatile("" : "+s"(st_));
        Epi E; epi_cfg(st_, gi, l, ws, out, a, E);
        if (KIND == 0) E.bf_path(acc, u, wr, wc, fr, fq); else E.res_path(acc, u, wr, wc, fr, fq);
    }
};
#ifdef DBG_SCAN
constexpr size_t WS_FLAG = 106 * MiB + 262144;
__device__ __forceinline__ void dbg_scan(unsigned char* ws, float* out, int ph) {
    int bad = 0;
    const size_t gt = (size_t)blockIdx.x * 512 + otid(), gs = (size_t)gridDim.x * 512;
    { const u32x4* p = (const u32x4*)(ws + 32 * MiB); const size_t n = (70 * MiB) / 16;
      for (size_t i = gt; i < n; i += gs) { const u32x4 w = p[i];
#pragma unroll
          for (int e = 0; e < 4; ++e) { const unsigned x = w[e]; if ((x & 0x7f80u) == 0x7f80u || (x & 0x7f800000u) == 0x7f800000u) bad = 1; } } }
    { const u32x4* p = (const u32x4*)(ws + 111 * MiB); const size_t n = (140 * MiB) / 16;
      for (size_t i = gt; i < n; i += gs) { const u32x4 w = p[i];
#pragma unroll
          for (int e = 0; e < 4; ++e) { const unsigned x = w[e]; if ((x & 0x7f80u) == 0x7f80u || (x & 0x7f800000u) == 0x7f800000u) bad = 1; } } }
    { const u32x4* p = (const u32x4*)(ws + 102 * MiB); const size_t n = (9 * MiB) / 16;
      for (size_t i = gt; i < n; i += gs) { const u32x4 w = p[i];
#pragma unroll
          for (int e = 0; e < 4; ++e) { const unsigned x = w[e]; if ((x & 0x7f800000u) == 0x7f800000u) bad = 1; } } }
    { const u32x4* p = (const u32x4*)out; const size_t n = (128 * MiB) / 16;
      for (size_t i = gt; i < n; i += gs) { const u32x4 w = p[i];
#pragma unroll
          for (int e = 0; e < 4; ++e) { const unsigned x = w[e]; if ((x & 0x7f800000u) == 0x7f800000u) bad = 1; } } }
    if (bad) atomicMax((int*)(ws + WS_FLAG), 100 - (ph + 1));
}
#endif
__global__ __launch_bounds__(512, 2) void mega_fwd(Args a_by_value) {
    extern __shared__ __attribute__((aligned(16))) unsigned char shm[];
    LAS unsigned char* lds = (LAS unsigned char*)shm;
    cg::grid_group grid = cg::this_grid();
#pragma unroll 1
    for (int ph = 0; ph <= 40; ++ph) {
        ArgsP a = (ArgsP)__builtin_amdgcn_kernarg_segment_ptr(); asm volatile("" : "+s"(a));
        unsigned char* ws = a->ws; float* out = a->out;
        float* ssq = (float*)(ws + WS_SSQ);
        bf16_t* xb = (bf16_t*)(ws + WS_XB);
        bf16_t* r1a = (bf16_t*)(ws + WS_R1A); bf16_t* r1b = (bf16_t*)(ws + WS_R1B); bf16_t* r2 = (bf16_t*)(ws + WS_R2); bf16_t* r3 = (bf16_t*)(ws + WS_R3);
        bf16_t* kmat = (bf16_t*)(ws + WS_R4); bf16_t* vtm = (bf16_t*)(ws + WS_R4 + 6 * MiB);
        float* psum = (float*)(ws + WS_PSUM);
#ifdef DBG_SCAN
        if (ph == 40) { const int fl = *(volatile int*)(ws + WS_FLAG); const float cval = fl < 0 ? 0.f : sqrtf((float)(100 - fl));
            for (size_t i = (size_t)blockIdx.x * 512 + otid(); i < (size_t)T_ALL * DM; i += (size_t)gridDim.x * 512) out[i] = cval; break; }
#else
        if (ph == 40) { phase_final(a, ssq + (size_t)6 * T_ALL); break; }
#endif
        const int l = ph / 20, st = ph % 20;
        const float* rin0 = l == 0 ? a->in[I_XP] : out; const float* rin1 = l == 0 ? a->in[I_XS] : out + (size_t)TP * DM;
        float* ssq_in = ssq + (size_t)(3 * l) * T_ALL; float* ssq_a = ssq_in + T_ALL; float* ssq_m = ssq_a + T_ALL; float* ssq_n = ssq_m + T_ALL;
#ifndef PH_LIMIT
#define PH_LIMIT 100
#endif
        const bool is_gemm = (st == 1 || st == 8 || (st >= 11 && st <= 19));
        if (ph >= PH_LIMIT) {}
        else if (st == 0) { if (l == 0) phase_prologue(a, lds); phase_wconv(a, l, lds); }
        else if (is_gemm) {
            const int ng = (st == 12) ? 3 : 1;
#pragma unroll 1
            for (int gi = 0; gi < ng; ++gi) {
                int nM = 128, nN = 4, mode = 0, lda = 1024, ldb = 1024, K = 1024, ks_shift = 30; size_t seg = 0;
                const void* A = xb; const void* B = ws + WS_WQ;
                const int half = (st >= 16) ? ((st - 16) >> 1) : 0;
                if (st == 1)       { nN = 6; B = ws + WS_WSSM; }
                else if (st == 8)  { nM = 6; nN = 128; A = ws + WS_WHY; B = xb; }
                else if (st == 11) { A = r1a; lda = 512; ks_shift = 3; seg = (size_t)(WS_R1B - WS_R1A); B = ws + WS_WOUT; }
                else if (st == 12) {
                    if (gi == 1)      { nM = 12; A = ws + WS_MEMB; B = ws + WS_WK; }
                    else if (gi == 2) { nM = 4; nN = 12; A = ws + WS_WV; B = ws + WS_MEMB; }
                }
                else if (st == 13) { mode = 1; K = 256; A = r1a; B = kmat; }
                else if (st == 14) { mode = 2; K = 256; A = r2; B = vtm; ldb = 3072; }
                else if (st == 15) { A = r1a; B = ws + WS_WO; }
                else if (st == 16 || st == 18) { nM = 64; nN = 16; A = xb + (size_t)half * TP * DM; B = ws + WS_WUP; }
                else               { nM = 64; A = r1a; lda = 4096; ldb = 4096; K = 4096; B = ws + WS_WDOWN; }
                pg8::Sched S; S.init(nM, nN, mode, A, lda, B, ldb);
                const pg8::Gemm g{lda, ldb, K, ks_shift, seg};
                const bool resid = (st == 11 || st == 15 || st == 17 || st == 19);
                if (!resid) { const EpiT<0> EK{st, gi, l, ws, out, a}; pg8::gemm_phase(lds, g, S, EK); } else { const EpiT<1> EK{st, gi, l, ws, out, a}; pg8::gemm_phase(lds, g, S, EK); }
            }
            if (st == 1) phase_dt(a, l, rin0, rin1);
            if (st == 8) phase_ssm_norm(a, l, r1b);
        }
        else if (st == 2 || st == 5) phase_s1(a, l, st == 2 ? 0 : 128, lds, r2, r3, r1a);
        else if (st == 3 || st == 6) phase_s2(a, st == 3 ? 0 : 128, r1a);
        else if (st == 4 || st == 7) phase_s3(a, l, st == 4 ? 0 : 128, lds, r2, r3, r1a, r1b);
        else if (st == 9) phase_hyena_conv(a, l, lds, r1a, r3);
        else if (st == 10) phase_hyena_norm(a, l, lds, r2, r3, r1a);
        grid.sync();
#ifdef DBG_SCAN
#if !defined(S3_PROBE) && !defined(S3_PROBE2)
        dbg_scan(ws, out, ph); grid.sync();
#endif
#endif
    }
}

#include <cstdio>
extern "C" void kernel_launch(void* const* d_in, const int* in_sizes, int n_in, void* d_out, int out_size, void* d_ws, size_t ws_size, hipStream_t stream) {
    static int grid = 0;
    if (grid == 0) {
        int dev = 0, cus = 0, per_cu = 0;
        if (n_in != 33 || ws_size < WS_END || out_size != T_ALL * DM) { fprintf(stderr, "kernel_launch: unexpected shapes (n_in %d, ws %zu, out %d)\n", n_in, ws_size, out_size); grid = -1; return; }
        (void)hipGetDevice(&dev); (void)hipDeviceGetAttribute(&cus, hipDeviceAttributeMultiprocessorCount, dev);
        if (hipFuncSetAttribute((const void*)mega_fwd, hipFuncAttributeMaxDynamicSharedMemorySize, LDS_BYTES) != hipSuccess) { fprintf(stderr, "kernel_launch: hipFuncSetAttribute failed\n"); grid = -1; return; }
        if (hipOccupancyMaxActiveBlocksPerMultiprocessor(&per_cu, (const void*)mega_fwd, 512, LDS_BYTES) != hipSuccess || per_cu < 1) { fprintf(stderr, "kernel_launch: occupancy query gives %d\n", per_cu); (void)hipGetLastError(); grid = -1; return; }
        grid = cus;
    }
    if (grid < 0) return;
#ifdef DBG_SCAN
    (void)hipMemsetAsync(d_ws, 0xAA, WS_END, stream); (void)hipMemsetAsync(d_out, 0xAA, (size_t)T_ALL * DM * 4, stream);
#endif
    Args a{};
    for (int i = 0; i < 33; ++i) a.in[i] = (const float*)d_in[i];
    a.out = (float*)d_out; a.ws = (unsigned char*)d_ws;
    void* args[] = {&a};
    hipError_t e = hipLaunchCooperativeKernel((const void*)mega_fwd, dim3(grid), dim3(512), args, LDS_BYTES, stream);
    if (e != hipSuccess) fprintf(stderr, "cooperative launch failed: %s (grid %d)\n", hipGetErrorString(e), grid);
}
```

```cpp
#include <hip/hip_runtime.h>
#include <hip/hip_cooperative_groups.h>
namespace cg = cooperative_groups;

#define LAS __attribute__((address_space(3)))
typedef unsigned short bf16_t;
typedef short bf16x8 __attribute__((ext_vector_type(8)));
typedef float f32x4 __attribute__((ext_vector_type(4)));
typedef float f32x2 __attribute__((ext_vector_type(2)));
typedef unsigned u32x4 __attribute__((ext_vector_type(4)));
typedef unsigned u32x2 __attribute__((ext_vector_type(2)));

constexpr int T_ALL = 32768, TP = 16384, DM = 1024;
constexpr float EPS = 1e-5f;
constexpr size_t MiB = 1048576;
constexpr size_t WS_WHY = 0 * MiB, WS_WSSM = 3 * MiB, WS_WOUT = 6 * MiB, WS_WQ = 8 * MiB, WS_WK = 10 * MiB, WS_WV = 12 * MiB, WS_WO = 14 * MiB, WS_WUP = 16 * MiB, WS_WDOWN = 24 * MiB;
constexpr size_t WS_XB = 32 * MiB, WS_MEMB = 96 * MiB, WS_SSQ = 102 * MiB, WS_H2 = 103 * MiB, WS_TW = 106 * MiB, WS_WDT = 106 * MiB + 65536, WS_DECAY = 106 * MiB + 131072;
constexpr size_t WS_DT = 107 * MiB, WS_PSUM = 109 * MiB, WS_R1A = 111 * MiB, WS_R1B = 143 * MiB, WS_R2 = 175 * MiB, WS_R3 = 207 * MiB, WS_R4 = 239 * MiB, WS_END = 251 * MiB;
constexpr int LDS_BYTES = 131072 + 16;

typedef __bf16 bf16x2v __attribute__((ext_vector_type(2)));
__device__ __forceinline__ unsigned pk2(float lo, float hi) { const f32x2 v = {lo, hi}; const bf16x2v b = __builtin_convertvector(v, bf16x2v); return __builtin_bit_cast(unsigned, b); }
__device__ __forceinline__ float bflo(unsigned u) { return __uint_as_float(u << 16); }
__device__ __forceinline__ float bfhi(unsigned u) { return __uint_as_float(u & 0xffff0000u); }
__device__ __forceinline__ float bf2f(bf16_t b) { return __uint_as_float(((unsigned)b) << 16); }
__device__ __forceinline__ float wave_sum(float v) {
#pragma unroll
    for (int o = 32; o >= 1; o >>= 1) v += __shfl_xor(v, o);
    return v;
}
__device__ __forceinline__ int otid() { int t = (int)threadIdx.x; asm volatile("" : "+v"(t)); return t; }
#define LDS_WAIT() asm volatile("s_waitcnt lgkmcnt(0)" ::: "memory")

namespace pg8 {
constexpr int BM = 256, BK = 64, HALF = 128, HTB = HALF * BK * 2, STAGE_BYTES = 8 * HTB, NXCD = 8, WGM = 8;
__host__ __device__ __forceinline__ int lds_byte(int r, int c) { const int st = (r >> 4) * 2 + (c >> 5), rr = r & 15, cc = c & 31, ob = rr * 64 + cc * 2; return st * 1024 + (ob ^ (((ob >> 9) & 1) << 5)); }
__host__ __device__ __forceinline__ void stage_rc(int b, int& R, int& C) { const int st = b / 1024, sb = b % 1024, swz = sb ^ (((sb >> 9) & 1) << 5); R = (st >> 1) * 16 + swz / 64; C = (st & 1) * 32 + (swz % 64) / 2; }
__host__ __device__ __forceinline__ int perm32(int rho) { const int n = rho >> 4, i = rho & 15; return 8 * (i >> 2) + 4 * n + (i & 3); }
struct Unit { int pm, pn; };
struct Gemm { int lda, ldb, K, ks_shift; size_t seg_bytes; };
__device__ __forceinline__ int seq_of_pm(int pm) { return pm < 64 ? (pm >> 3) : 8 + ((pm - 64) >> 4); }
struct Sched {
    int nM, nN, nwg, G, c, mode;
    const char* A; const char* B; int lda, ldb;
    __device__ void init(int nM_, int nN_, int mode_, const void* A_, int lda_, const void* B_, int ldb_) { nM = nM_; nN = nN_; nwg = nM * nN; G = (int)gridDim.x; c = (int)blockIdx.x; mode = mode_; A = (const char*)A_; B = (const char*)B_; lda = lda_; ldb = ldb_; }
    __device__ bool next(int i, Unit& u) const {
        const long L = (long)i * G + c; if (L >= nwg) return false;
        int wgid = (int)L; { const int q = nwg / NXCD, r = nwg % NXCD, xcd = wgid % NXCD, off = wgid / NXCD; wgid = (xcd < r ? xcd * (q + 1) : r * (q + 1) + (xcd - r) * q) + off; }
        const int nig = WGM * nN, gid = wgid / nig, fm = gid * WGM, gsz = (nM - fm) < WGM ? (nM - fm) : WGM;
        u.pm = fm + ((wgid % nig) % gsz); u.pn = (wgid % nig) / gsz; return true;
    }
    __device__ __forceinline__ const char* abase(const Unit& u) const {
        if (mode == 0) return A + (size_t)u.pm * 256 * lda * 2;
        return A + ((size_t)u.pm * 256 * lda + (size_t)u.pn * 256) * 2;
    }
    __device__ __forceinline__ const char* bbase(const Unit& u) const {
        if (mode == 0) return B + (size_t)u.pn * 256 * ldb * 2;
        if (mode == 1) return B + ((size_t)seq_of_pm(u.pm) * 256 * ldb + (size_t)u.pn * 256) * 2;
        return B + ((size_t)u.pn * 256 * ldb + (size_t)seq_of_pm(u.pm) * 256) * 2;
    }
};

template <class Epi>
__device__ __forceinline__ void gemm_phase(LAS unsigned char* lds, const Gemm g, const Sched& S, const Epi& E) {
    const int tid = otid(), wid = __builtin_amdgcn_readfirstlane(tid >> 6), lane = tid & 63, wr = wid >> 2, wc = wid & 3, fr = lane & 15, fq = lane >> 4;
    const int nt = g.K / BK;
    unsigned voffA[2], voffB[2];
#pragma unroll
    for (int i = 0; i < 2; ++i) { int R, C; stage_rc(tid * 16 + i * 8192, R, C); const int Rb = Epi::PERM ? ((R & ~31) + perm32(R & 31)) : R;
        voffA[i] = (unsigned)(R * g.lda + C) * 2u; voffB[i] = (unsigned)(Rb * g.ldb + C) * 2u; }
    const size_t kstep = (size_t)(BK * 2);
    const size_t hstepA = (size_t)HALF * g.lda * 2, hstepB = (size_t)HALF * g.ldb * 2;
    const int ksm = (1 << g.ks_shift) - 1;
#define PG8_AKT(p, t) ((p) + (size_t)((t) >> g.ks_shift) * g.seg_bytes + (size_t)((t) & ksm) * kstep)
    const unsigned ldsw = (unsigned)wid * 1024u;
    const int aoff = lds_byte(wr * 64 + fr, fq * 8), boff = lds_byte(wc * 32 + fr, fq * 8);
#define PG8_SA(b, h) (((b) * 2 + (h)) * HTB)
#define PG8_SB(b, h) ((4 + (b) * 2 + (h)) * HTB)
#define PG8_STAGE(bufoff, gbase, voff) do { _Pragma("unroll") for (int _i = 0; _i < 2; ++_i) \
        __builtin_amdgcn_global_load_lds((const unsigned*)((const char*)(gbase) + (voff)[_i]), (LAS unsigned*)(lds + (bufoff) + ldsw + _i * 8192), 16, 0, 0); } while (0)
#define PG8_LDA(dst, b, h) do { _Pragma("unroll") for (int m = 0; m < 4; ++m) _Pragma("unroll") for (int k = 0; k < 2; ++k) dst[m][k] = *(const LAS bf16x8*)(lds + PG8_SA(b, h) + aoff + m * 2048 + k * 1024); } while (0)
#define PG8_LDB(dst, b, h) do { _Pragma("unroll") for (int n = 0; n < 2; ++n) _Pragma("unroll") for (int k = 0; k < 2; ++k) dst[n][k] = *(const LAS bf16x8*)(lds + PG8_SB(b, h) + boff + n * 2048 + k * 1024); } while (0)
#define PG8_MMA(ai, bj, At, Bt) do { __builtin_amdgcn_s_setprio(1); _Pragma("unroll") for (int m = 0; m < 4; ++m) _Pragma("unroll") for (int n = 0; n < 2; ++n) _Pragma("unroll") for (int k = 0; k < 2; ++k) \
        acc[ai][bj][m][n] = __builtin_amdgcn_mfma_f32_16x16x32_bf16(Bt[n][k], At[m][k], acc[ai][bj][m][n], 0, 0, 0); __builtin_amdgcn_s_setprio(0); } while (0)
#define PG8_WAIT_V(n) asm volatile("s_waitcnt vmcnt(" #n ")" ::: "memory")
#define PG8_WAIT_L(n) asm volatile("s_waitcnt lgkmcnt(" #n ")" ::: "memory")
#define PG8_BAR __builtin_amdgcn_s_barrier()
#define PG8_SCHED __builtin_amdgcn_sched_barrier(0)
    Unit cur, nxt; int ui = 0;
    if (!S.next(0, cur)) return;
    f32x4 acc[2][2][4][2];
#pragma unroll
    for (int a = 0; a < 2; ++a)
#pragma unroll
        for (int b = 0; b < 2; ++b)
#pragma unroll
            for (int m = 0; m < 4; ++m)
#pragma unroll
                for (int n = 0; n < 2; ++n) acc[a][b][m][n] = (f32x4){0.f, 0.f, 0.f, 0.f};
    bf16x8 At[4][2], B0[2][2], B1[2][2];
    const char* cA = S.abase(cur); const char* cB = S.bbase(cur);
    PG8_STAGE(PG8_SB(0, 0), cB, voffB); PG8_STAGE(PG8_SA(0, 0), cA, voffA); PG8_STAGE(PG8_SB(0, 1), cB + hstepB, voffB); PG8_STAGE(PG8_SA(0, 1), cA + hstepA, voffA);
    if (wr == 1) PG8_BAR;
    PG8_WAIT_V(4); PG8_BAR;
    PG8_STAGE(PG8_SB(1, 0), cB + kstep, voffB); PG8_STAGE(PG8_SA(1, 0), PG8_AKT(cA, 1), voffA); PG8_STAGE(PG8_SB(1, 1), cB + hstepB + kstep, voffB);
    PG8_WAIT_V(6); PG8_BAR;
    for (;;) {
        const bool has_next = S.next(ui + 1, nxt);
        const char* nA = has_next ? S.abase(nxt) : cA; const char* nB = has_next ? S.bbase(nxt) : cB;
        for (int t = 0; t < nt; t += 2) {
            const bool last = (t == nt - 2);
            const char* a1 = PG8_AKT(cA, t + 1);
            const char* a2 = last ? nA : PG8_AKT(cA, t + 2); const char* b2 = last ? nB : cB + (size_t)(t + 2) * kstep;
            const char* a3 = last ? PG8_AKT(nA, 1) : PG8_AKT(cA, t + 3); const char* b3 = b2 + kstep;
            PG8_LDB(B0, 0, 0); PG8_SCHED; PG8_LDA(At, 0, 0); PG8_STAGE(PG8_SA(1, 1), a1 + hstepA, voffA);
            PG8_WAIT_L(8); PG8_BAR; PG8_WAIT_L(0); PG8_MMA(0, 0, At, B0); PG8_BAR; PG8_SCHED;
            PG8_LDB(B1, 0, 1); PG8_STAGE(PG8_SB(0, 0), b2, voffB);
            PG8_BAR; PG8_WAIT_L(0); PG8_MMA(0, 1, At, B1); PG8_BAR;
            PG8_LDA(At, 0, 1); PG8_STAGE(PG8_SA(0, 0), a2, voffA);
            PG8_BAR; PG8_WAIT_L(0); PG8_MMA(1, 0, At, B0); PG8_BAR; PG8_SCHED;
            PG8_STAGE(PG8_SB(0, 1), b2 + hstepB, voffB);
            PG8_WAIT_V(6); PG8_BAR; PG8_MMA(1, 1, At, B1); PG8_BAR;
            PG8_LDB(B0, 1, 0); PG8_SCHED; PG8_LDA(At, 1, 0); PG8_STAGE(PG8_SA(0, 1), a2 + hstepA, voffA);
            PG8_WAIT_L(8); PG8_BAR; PG8_WAIT_L(0); PG8_MMA(0, 0, At, B0); PG8_BAR; PG8_SCHED;
            PG8_LDB(B1, 1, 1); PG8_STAGE(PG8_SB(1, 0), b3, voffB);
            PG8_BAR; PG8_WAIT_L(0); PG8_MMA(0, 1, At, B1); PG8_BAR;
            PG8_LDA(At, 1, 1); PG8_STAGE(PG8_SA(1, 0), a3, voffA);
            PG8_BAR; PG8_WAIT_L(0); PG8_MMA(1, 0, At, B0); PG8_BAR; PG8_SCHED;
            PG8_STAGE(PG8_SB(1, 1), b3 + hstepB, voffB);
            PG8_WAIT_V(6); PG8_BAR; PG8_MMA(1, 1, At, B1); PG8_BAR;
        }
        E(acc, cur, wr, wc, fr, fq);
        if (!has_next) break;
#pragma unroll
        for (int a = 0; a < 2; ++a)
#pragma unroll
            for (int b = 0; b < 2; ++b)
#pragma unroll
                for (int m = 0; m < 4; ++m)
#pragma unroll
                    for (int n = 0; n < 2; ++n) acc[a][b][m][n] = (f32x4){0.f, 0.f, 0.f, 0.f};
        cur = nxt; cA = nA; cB = nB; ++ui;
    }
    PG8_WAIT_V(0);
    if (wr == 0) PG8_BAR;
    PG8_BAR;
#undef PG8_AKT
#undef PG8_SA
#undef PG8_SB
#undef PG8_STAGE
#undef PG8_LDA
#undef PG8_LDB
#undef PG8_MMA
#undef PG8_WAIT_V
#undef PG8_WAIT_L
#undef PG8_BAR
#undef PG8_SCHED
}
}
struct Epi {
    int kind;
    static constexpr bool PERM = true;
    bf16_t* O0; long long d1, d2; int ldc; int csplit, rsplit;
    const float* ssq; float* psum; int row_off; int SCALE, ACT;
    __device__ __forceinline__ void bf_path(const f32x4 (&acc)[2][2][4][2], const pg8::Unit& u, int wr, int wc, int fr, int fq) const {
        int pm = u.pm, pn = u.pn, ai_ = 0;
        if (csplit) { ai_ = pn / csplit; pn = pn % csplit; }
        if (rsplit) { ai_ = pm / rsplit; pm = pm % rsplit; }
        bf16_t* base = O0 + (ai_ >= 1 ? d1 : 0ll) + (ai_ >= 2 ? d2 : 0ll);
        const int lrow0 = pm * 256 + wr * 64 + fr, grow0 = u.pm * 256 + wr * 64 + fr, lcol0 = pn * 256 + wc * 32 + 8 * fq, gcol0 = u.pn * 256 + wc * 32 + 8 * fq;
        f32x4 cs[2][2];
        if (SCALE == 2) {
#pragma unroll
            for (int bj = 0; bj < 2; ++bj)
#pragma unroll
                for (int n = 0; n < 2; ++n) { f32x4 q = *(const f32x4*)(ssq + gcol0 + bj * 128 + 4 * n);
#pragma unroll
                    for (int j = 0; j < 4; ++j) q[j] = rsqrtf(q[j] * (1.0f / 1024.0f) + EPS);
                    cs[bj][n] = q; }
        }
#pragma unroll
        for (int ai = 0; ai < 2; ++ai)
#pragma unroll
            for (int m = 0; m < 4; ++m) {
                const int grow = grow0 + ai * 128 + m * 16;
                float rs = 1.0f;
                if (SCALE == 1) rs = rsqrtf(ssq[grow + row_off] * (1.0f / 1024.0f) + EPS);
                if (SCALE == 3) { const f32x4 q = *(const f32x4*)(psum + ((size_t)grow * 4 + u.pn) * 4); rs = 1.0f / ((q[0] + q[1]) + (q[2] + q[3])); }
                bf16_t* rowp = base + (size_t)(lrow0 + ai * 128 + m * 16) * ldc + lcol0;
                float psacc = 0.f;
#pragma unroll
                for (int bj = 0; bj < 2; ++bj) {
                    f32x4 v0 = acc[ai][bj][m][0], v1 = acc[ai][bj][m][1];
                    if (SCALE == 1 || SCALE == 3) { v0 = v0 * rs; v1 = v1 * rs; }
                    if (SCALE == 2) { v0 = v0 * cs[bj][0]; v1 = v1 * cs[bj][1]; }
                    if (ACT == 1) {
#pragma unroll
                        for (int j = 0; j < 4; ++j) { const float a0 = fmaxf(v0[j], 0.f), a1 = fmaxf(v1[j], 0.f); v0[j] = a0 * a0; v1[j] = a1 * a1; } }
                    if (ACT == 2) {
#pragma unroll
                        for (int j = 0; j < 4; ++j) { v0[j] = __expf(v0[j]); v1[j] = __expf(v1[j]); }
                        psacc += ((v0[0] + v0[1]) + (v0[2] + v0[3])) + ((v1[0] + v1[1]) + (v1[2] + v1[3])); }
                    u32x4 w; w.x = pk2(v0[0], v0[1]); w.y = pk2(v0[2], v0[3]); w.z = pk2(v1[0], v1[1]); w.w = pk2(v1[2], v1[3]);
                    *(u32x4*)(rowp + bj * 128) = w;
                }
                if (ACT == 2) { psacc += __shfl_xor(psacc, 16); psacc += __shfl_xor(psacc, 32); if (fq == 0) psum[((size_t)grow * 4 + u.pn) * 4 + wc] = psacc; }
            }
    }
    float* X; const float* rin0; const float* rin1; bf16_t* xb; float* ssq_out;
    __device__ __forceinline__ void operator()(const f32x4 (&acc)[2][2][4][2], const pg8::Unit& u, int wr, int wc, int fr, int fq) const {
        if (kind == 0) bf_path(acc, u, wr, wc, fr, fq); else res_path(acc, u, wr, wc, fr, fq);
    }
    __device__ __forceinline__ void res_path(const f32x4 (&acc)[2][2][4][2], const pg8::Unit& u, int wr, int wc, int fr, int fq) const {
        const int row0 = u.pm * 256 + wr * 64 + fr + row_off, col0 = u.pn * 256 + wc * 32 + 8 * fq;
#pragma unroll
        for (int ai = 0; ai < 2; ++ai)
#pragma unroll
            for (int m = 0; m < 4; ++m) {
                const int row = row0 + ai * 128 + m * 16;
                const float* rp = (row < TP ? rin0 + (size_t)row * DM : rin1 + (size_t)(row - TP) * DM) + col0;
                float* xp = X + (size_t)row * DM + col0; bf16_t* bp = xb + (size_t)row * DM + col0;
                float sq = 0.f;
#pragma unroll
                for (int bj = 0; bj < 2; ++bj) {
                    const f32x4 r0 = *(const f32x4*)(rp + bj * 128), r1 = *(const f32x4*)(rp + bj * 128 + 4);
                    const f32x4 v0 = acc[ai][bj][m][0] + r0, v1 = acc[ai][bj][m][1] + r1;
                    *(f32x4*)(xp + bj * 128) = v0; *(f32x4*)(xp + bj * 128 + 4) = v1;
                    u32x4 w; w.x = pk2(v0[0], v0[1]); w.y = pk2(v0[2], v0[3]); w.z = pk2(v1[0], v1[1]); w.w = pk2(v1[2], v1[3]);
                    *(u32x4*)(bp + bj * 128) = w;
                    sq += ((v0[0] * v0[0] + v0[1] * v0[1]) + (v0[2] * v0[2] + v0[3] * v0[3])) + ((v1[0] * v1[0] + v1[1] * v1[1]) + (v1[2] * v1[2] + v1[3] * v1[3]));
                }
                sq += __shfl_xor(sq, 16); sq += __shfl_xor(sq, 32);
                if (fq == 0) unsafeAtomicAdd(ssq_out + row, sq);
            }
    }
};

struct Args { const float* in[33]; float* out; unsigned char* ws; };
typedef const __attribute__((address_space(4))) Args* ArgsP;
enum { I_XP = 0, I_XS, I_MP, I_MS, I_NMIX, I_WIN, I_HCW, I_HCB, I_FW1, I_FB1, I_FW2, I_FB2, I_FW3, I_FB3, I_FREQ, I_HBIAS, I_HNORM, I_SCW, I_SCB, I_DTB, I_ALOG, I_SD, I_SNORM,
       I_WOUT, I_NXA, I_NMEM, I_WQ, I_WKV, I_WO, I_NMLP, I_WUP, I_WDOWN, I_NFIN };

__device__ __forceinline__ void transpose_item(const float* W, int K, int N, bf16_t* WT, int n0, int k0, int dst_row0, const float* ksc, float gs, LAS float* scr, int lane) {
#pragma unroll 8
    for (int i = 0; i < 32; ++i) { const int kk = 2 * i + (lane >> 5); float v = W[(size_t)(k0 + kk) * N + n0 + (lane & 31)] * gs; if (ksc) v *= ksc[k0 + kk]; scr[kk * 33 + (lane & 31)] = v; }
    LDS_WAIT();
    const int c = lane & 7;
#pragma unroll
    for (int j = 0; j < 4; ++j) { const int n = (lane >> 3) + 8 * j; const LAS float* s = scr + (8 * c) * 33 + n;
        u32x4 o; o.x = pk2(s[0 * 33], s[1 * 33]); o.y = pk2(s[2 * 33], s[3 * 33]); o.z = pk2(s[4 * 33], s[5 * 33]); o.w = pk2(s[6 * 33], s[7 * 33]);
        *(u32x4*)(WT + (size_t)(dst_row0 + n) * K + k0 + 8 * c) = o; }
    LDS_WAIT();
}
__device__ __forceinline__ void phase_wconv(ArgsP a, int l, LAS unsigned char* lds) {
    const int lane = otid() & 63, wave = otid() >> 6, gw = blockIdx.x * 8 + wave, NGW = gridDim.x * 8;
    LAS float* scr = (LAS float*)(lds + wave * 16384);
    unsigned char* ws = a->ws;
    constexpr int I_IN = 16 * 96, I_OUT = 16 * 32, I_Q = 16 * 32, I_KV = 16 * 64, I_O = 16 * 32, I_UP = 16 * 128, I_DN = 64 * 32;
    constexpr int NIT = I_IN + I_OUT + I_Q + I_KV + I_O + I_UP + I_DN;
    for (int it = gw; it < NIT; it += NGW) {
        int r = it;
        if (r < I_IN) { const int kb = r / 96, nb = r % 96, n0 = nb * 32;
            if (n0 < 1536) transpose_item(a->in[I_WIN] + (size_t)l * 1024 * 3088, 1024, 3088, (bf16_t*)(ws + WS_WHY), n0, kb * 64, n0, a->in[I_NMIX] + l * 1024, 1.f, scr, lane);
            else transpose_item(a->in[I_WIN] + (size_t)l * 1024 * 3088, 1024, 3088, (bf16_t*)(ws + WS_WSSM), n0, kb * 64, n0 - 1536, a->in[I_NMIX] + l * 1024, 1.f, scr, lane);
            continue; } r -= I_IN;
        if (r < I_OUT) { const int kb = r / 32, nb = r % 32; transpose_item(a->in[I_WOUT] + (size_t)l * 1024 * 1024, 1024, 1024, (bf16_t*)(ws + WS_WOUT), nb * 32, kb * 64, nb * 32, nullptr, 1.f, scr, lane); continue; } r -= I_OUT;
        if (r < I_Q) { const int kb = r / 32, nb = r % 32; transpose_item(a->in[I_WQ] + (size_t)l * 1024 * 1024, 1024, 1024, (bf16_t*)(ws + WS_WQ), nb * 32, kb * 64, nb * 32, a->in[I_NXA] + l * 1024, 0.0625f, scr, lane); continue; } r -= I_Q;
        if (r < I_KV) { const int kb = r / 64, nb = r % 64, n0 = nb * 32;
            if (n0 < 1024) transpose_item(a->in[I_WKV] + (size_t)l * 1024 * 2048, 1024, 2048, (bf16_t*)(ws + WS_WK), n0, kb * 64, n0, a->in[I_NMEM] + l * 1024, 1.f, scr, lane);
            else transpose_item(a->in[I_WKV] + (size_t)l * 1024 * 2048, 1024, 2048, (bf16_t*)(ws + WS_WV), n0, kb * 64, n0 - 1024, a->in[I_NMEM] + l * 1024, 1.f, scr, lane);
            continue; } r -= I_KV;
        if (r < I_O) { const int kb = r / 32, nb = r % 32; transpose_item(a->in[I_WO] + (size_t)l * 1024 * 1024, 1024, 1024, (bf16_t*)(ws + WS_WO), nb * 32, kb * 64, nb * 32, nullptr, 1.f, scr, lane); continue; } r -= I_O;
        if (r < I_UP) { const int kb = r / 128, nb = r % 128; transpose_item(a->in[I_WUP] + (size_t)l * 1024 * 4096, 1024, 4096, (bf16_t*)(ws + WS_WUP), nb * 32, kb * 64, nb * 32, a->in[I_NMLP] + l * 1024, 1.f, scr, lane); continue; } r -= I_UP;
        { const int kb = r / 32, nb = r % 32; transpose_item(a->in[I_WDOWN] + (size_t)l * 4096 * 1024, 4096, 1024, (bf16_t*)(ws + WS_WDOWN), nb * 32, kb * 64, nb * 32, nullptr, 1.f, scr, lane); }
    }
    float* wdt = (float*)(ws + WS_WDT);
    for (int i = blockIdx.x * 512 + otid(); i < 16 * 1024; i += gridDim.x * 512) { const int j = i >> 10, k = i & 1023; wdt[i] = a->in[I_NMIX][l * 1024 + k] * a->in[I_WIN][((size_t)l * 1024 + k) * 3088 + 3072 + j]; }
}
__device__ __forceinline__ const float* xin_row(ArgsP a, int t) { return t < TP ? a->in[I_XP] + (size_t)t * DM : a->in[I_XS] + (size_t)(t - TP) * DM; }

__device__ __forceinline__ void phase_prologue(ArgsP a, LAS unsigned char* lds) {
    const int lane = otid() & 63, wave = otid() >> 6, gw = blockIdx.x * 8 + wave, NGW = gridDim.x * 8;
    unsigned char* ws = a->ws;
    float* ssq = (float*)(ws + WS_SSQ);
    for (int i = blockIdx.x * 512 + otid(); i < 6 * T_ALL; i += gridDim.x * 512) ssq[T_ALL + i] = 0.f;
    { f32x2* tw = (f32x2*)(ws + WS_TW); for (int i = blockIdx.x * 512 + otid(); i < 4096; i += gridDim.x * 512) { float s, c; sincospif(-(float)i * (1.0f / 4096.0f), &s, &c); tw[i] = (f32x2){c, s}; } }
    bf16_t* xb = (bf16_t*)(ws + WS_XB);
    for (int t = gw; t < T_ALL; t += NGW) {
        const f32x4* xr = (const f32x4*)xin_row(a, t) + lane; float s = 0.f;
        u32x2* o = (u32x2*)(xb + (size_t)t * DM) + lane;
#pragma unroll
        for (int j = 0; j < 4; ++j) { const f32x4 v = xr[64 * j]; s += (v[0] * v[0] + v[1] * v[1]) + (v[2] * v[2] + v[3] * v[3]); u32x2 w; w.x = pk2(v[0], v[1]); w.y = pk2(v[2], v[3]); o[64 * j] = w; }
        s = wave_sum(s); if (lane == 0) ssq[t] = s;
    }
    bf16_t* memb = (bf16_t*)(ws + WS_MEMB);
    for (int t = gw; t < 3072; t += NGW) {
        const float* mr = t < 2048 ? a->in[I_MP] + (size_t)t * DM : a->in[I_MS] + (size_t)(t - 2048) * DM;
        const f32x4* xr = (const f32x4*)mr + lane; f32x4 v[4]; float s = 0.f;
#pragma unroll
        for (int j = 0; j < 4; ++j) { v[j] = xr[64 * j]; s += (v[j][0] * v[j][0] + v[j][1] * v[j][1]) + (v[j][2] * v[j][2] + v[j][3] * v[j][3]); }
        const float rs = rsqrtf(wave_sum(s) * (1.0f / 1024.0f) + EPS);
        u32x2* o = (u32x2*)(memb + (size_t)t * DM) + lane;
#pragma unroll
        for (int j = 0; j < 4; ++j) { u32x2 w; w.x = pk2(v[j][0] * rs, v[j][1] * rs); w.y = pk2(v[j][2] * rs, v[j][3] * rs); o[64 * j] = w; }
    }
    float* h2 = (float*)(ws + WS_H2);
    for (int idx = gw; idx < 2 * 6144; idx += NGW) {
        const int l = idx / 6144, r = idx % 6144, set = r >= 2048 ? 1 : 0, t = set ? r - 2048 : r, L = set ? 4096 : 2048;
        const float tl = (float)t / (float)(L - 1), w = (6.283185307179586f / (float)L) * (float)t;
        const float fm = 1e-4f + (float)(lane & 15) * ((15.0f - 1e-4f) / 15.0f);
        float sv, cv; sincosf(fm * w, &sv, &cv);
        const float* fw1 = a->in[I_FW1] + l * 33 * 64; const float* fw2 = a->in[I_FW2] + l * 64 * 64;
        float acc = a->in[I_FB1][l * 64 + lane] + tl * fw1[lane];
#pragma unroll
        for (int i = 0; i < 16; ++i) { acc += __shfl(cv, i) * fw1[(1 + i) * 64 + lane]; acc -= __shfl(sv, i) * fw1[(17 + i) * 64 + lane]; }
        const float fr = a->in[I_FREQ][l * 64 + lane];
        const float h1 = sinf(fr * acc);
        float acc2 = a->in[I_FB2][l * 64 + lane];
#pragma unroll 8
        for (int i = 0; i < 64; ++i) acc2 += __shfl(h1, i) * fw2[i * 64 + lane];
        h2[(size_t)idx * 64 + lane] = sinf(fr * acc2);
    }
}
__device__ __forceinline__ void phase_dt(ArgsP a, int l, const float* rin0, const float* rin1) {
    const int lane = otid() & 63, wave = otid() >> 6, gw = blockIdx.x * 8 + wave, NGW = gridDim.x * 8;
    const float* wdt = (const float*)(a->ws + WS_WDT); float* dt = (float*)(a->ws + WS_DT);
    for (int t = gw; t < T_ALL; t += NGW) {
        const float* xr0 = t < TP ? rin0 + (size_t)t * DM : rin1 + (size_t)(t - TP) * DM;
        const f32x4* xr = (const f32x4*)xr0 + lane; f32x4 v[4]; float s = 0.f;
#pragma unroll
        for (int j = 0; j < 4; ++j) { v[j] = xr[64 * j]; s += (v[j][0] * v[j][0] + v[j][1] * v[j][1]) + (v[j][2] * v[j][2] + v[j][3] * v[j][3]); }
        const float rs = rsqrtf(wave_sum(s) * (1.0f / 1024.0f) + EPS);
        float mine = 0.f;
#pragma unroll 4
        for (int o = 0; o < 16; ++o) {
            const f32x4* wr_ = (const f32x4*)(wdt + o * 1024) + lane; float p = 0.f;
#pragma unroll
            for (int j = 0; j < 4; ++j) { const f32x4 w = wr_[64 * j]; p += (v[j][0] * w[0] + v[j][1] * w[1]) + (v[j][2] * w[2] + v[j][3] * w[3]); }
            p = wave_sum(p); if (lane == o) mine = p;
        }
        if (lane < 16) { const float x = mine * rs + a->in[I_DTB][l * 16 + lane]; dt[(size_t)t * 16 + lane] = x > 20.f ? x : log1pf(expf(x)); }
    }
}
__device__ __forceinline__ void phase_final(ArgsP a, const float* ssq) {
    const int lane = otid() & 63, wave = otid() >> 6, gw = blockIdx.x * 8 + wave, NGW = gridDim.x * 8;
    const f32x4* g = (const f32x4*)a->in[I_NFIN] + lane;
    for (int t = gw; t < T_ALL; t += NGW) {
        const float rs = rsqrtf(ssq[t] * (1.0f / 1024.0f) + EPS);
        f32x4* xr = (f32x4*)(a->out + (size_t)t * DM) + lane;
#pragma unroll
        for (int j = 0; j < 4; ++j) { f32x4 v = xr[64 * j]; const f32x4 w = g[64 * j]; v = v * rs * w;
#ifdef DBG_SANITIZE
            for (int e = 0; e < 4; ++e) if (!(fabsf(v[e]) < 1e30f)) v[e] = 0.f;
#endif
            xr[64 * j] = v; }
    }
}
__device__ __forceinline__ void phase_ssm_norm(ArgsP a, int l, bf16_t* buf) {
    const int lane = otid() & 63, wave = otid() >> 6, gw = blockIdx.x * 8 + wave, NGW = gridDim.x * 8;
    const float* gn = a->in[I_SNORM] + l * 512 + lane * 8;
    float g[8];
#pragma unroll
    for (int j = 0; j < 8; ++j) g[j] = gn[j];
    for (int t = gw; t < T_ALL; t += NGW) {
        u32x4* p = (u32x4*)(buf + (size_t)t * 512) + lane; const u32x4 w = *p;
        float v[8] = {bflo(w.x), bfhi(w.x), bflo(w.y), bfhi(w.y), bflo(w.z), bfhi(w.z), bflo(w.w), bfhi(w.w)};
        float s = 0.f;
#pragma unroll
        for (int j = 0; j < 8; ++j) s += v[j] * v[j];
        const float rs = rsqrtf(wave_sum(s) * (1.0f / 512.0f) + EPS);
        u32x4 o; o.x = pk2(v[0] * rs * g[0], v[1] * rs * g[1]); o.y = pk2(v[2] * rs * g[2], v[3] * rs * g[3]); o.z = pk2(v[4] * rs * g[4], v[5] * rs * g[5]); o.w = pk2(v[6] * rs * g[6], v[7] * rs * g[7]);
        *p = o;
    }
}
constexpr int SLD = 136;
__device__ __forceinline__ void seq_bounds(int t0, int& lo, int& hi) { if (t0 < TP) { lo = t0 & ~2047; hi = lo + 2048; } else { lo = TP + ((t0 - TP) & ~4095); hi = lo + 4096; } }
__device__ __forceinline__ float silu_f(float x) { return x / (1.0f + __expf(-x)); }

template <int NC, bool TRANS>
__device__ __forceinline__ void load_conv_tile(const bf16_t* src, int ldsrc, int col0, int t0, int lo, int hi, const float* cw, const float* cbias, int ch0, LAS bf16_t* dst) {
    constexpr int CGS = NC / 8, RUNS = 512 / CGS, R = 128 / RUNS;
    const int tid = otid(), cgi = tid % CGS, run = tid / CGS, c = cgi * 8, r0 = run * R;
    float w[5][8], bb[8];
#pragma unroll
    for (int k = 0; k < 5; ++k) { const f32x4 a0 = *(const f32x4*)(cw + k * 1024 + ch0 + c), a1 = *(const f32x4*)(cw + k * 1024 + ch0 + c + 4);
#pragma unroll
        for (int e = 0; e < 4; ++e) { w[k][e] = a0[e]; w[k][4 + e] = a1[e]; } }
    { const f32x4 a0 = *(const f32x4*)(cbias + ch0 + c), a1 = *(const f32x4*)(cbias + ch0 + c + 4);
#pragma unroll
      for (int e = 0; e < 4; ++e) { bb[e] = a0[e]; bb[4 + e] = a1[e]; } }
    float win[5][8];
    auto ldrow = [&](int t, float (&o)[8]) {
        if (t >= lo && t < hi) { const u32x4 q = *(const u32x4*)(src + (size_t)t * ldsrc + col0 + c);
            o[0] = bflo(q.x); o[1] = bfhi(q.x); o[2] = bflo(q.y); o[3] = bfhi(q.y); o[4] = bflo(q.z); o[5] = bfhi(q.z); o[6] = bflo(q.w); o[7] = bfhi(q.w); }
        else {
#pragma unroll
            for (int e = 0; e < 8; ++e) o[e] = 0.f; }
    };
#pragma unroll
    for (int i = 0; i < 4; ++i) ldrow(t0 + r0 - 2 + i, win[i]);
    unsigned outp[8][R / 2];
#pragma unroll
    for (int rr = 0; rr < R; ++rr) {
        ldrow(t0 + r0 + rr + 2, win[(rr + 4) % 5]);
        float o[8];
#pragma unroll
        for (int e = 0; e < 8; ++e) { float s = bb[e];
#pragma unroll
            for (int k = 0; k < 5; ++k) s += w[k][e] * win[(rr + k) % 5][e];
            o[e] = silu_f(s); }
        if (!TRANS) { u32x4 q; q.x = pk2(o[0], o[1]); q.y = pk2(o[2], o[3]); q.z = pk2(o[4], o[5]); q.w = pk2(o[6], o[7]); *(LAS u32x4*)(dst + (r0 + rr) * SLD + c) = q; }
        else {
#pragma unroll
            for (int e = 0; e < 8; ++e) { if (rr & 1) outp[e][rr >> 1] = (outp[e][rr >> 1] & 0xffffu) | (pk2(0.f, o[e]) & 0xffff0000u); else outp[e][rr >> 1] = pk2(o[e], 0.f) & 0xffffu; } }
    }
    if (TRANS) {
#pragma unroll
        for (int e = 0; e < 8; ++e) {
            if (R == 8) { u32x4 q; q.x = outp[e][0]; q.y = outp[e][1]; q.z = outp[e][2]; q.w = outp[e][R / 2 - 1]; *(LAS u32x4*)(dst + (c + e) * SLD + r0) = q; }
            else { u32x2 q; q.x = outp[e][0]; q.y = outp[e][R / 2 - 1]; *(LAS u32x2*)(dst + (c + e) * SLD + r0) = q; }
        }
    }
}
__device__ __forceinline__ void chunk_scan(const float* dt, int t0, int col, float A, int dir, int lane, float& d0, float& d1, float& c0, float& c1, float& total) {
    d0 = dt[(size_t)(t0 + 2 * lane) * 16 + col]; d1 = dt[(size_t)(t0 + 2 * lane + 1) * 16 + col];
    const float a0 = d0 * A, a1 = d1 * A;
    float v = a0 + a1;
#pragma unroll
    for (int d = 1; d < 64; d <<= 1) { const float tt = __shfl_up(v, d); if (lane >= d) v += tt; }
    total = __shfl(v, 63);
    const float p0 = v - a1, p1 = v;
    if (dir == 0) { c0 = p0; c1 = p1; } else { c0 = total - p0 + a0; c1 = total - p1 + a1; }
}
__device__ __forceinline__ bf16x8 scale_frag8(bf16x8 f, const float (&sc)[8]) {
    union { bf16x8 v; unsigned u[4]; } in, out; in.v = f;
#pragma unroll
    for (int j = 0; j < 4; ++j) out.u[j] = pk2(bflo(in.u[j]) * sc[2 * j], bfhi(in.u[j]) * sc[2 * j + 1]);
    return out.v;
}
__device__ __forceinline__ void phase_s1(ArgsP a, int l, int cbase, LAS unsigned char* lds, const bf16_t* xs_raw, const bf16_t* bc_raw, bf16_t* states) {
    const int tid = otid(), lane = tid & 63, wave = __builtin_amdgcn_readfirstlane(tid >> 6);
    LAS bf16_t* xsT = (LAS bf16_t*)lds;
    LAS bf16_t* BT = (LAS bf16_t*)(lds + 256 * SLD * 2);
    LAS float* sW = (LAS float*)(lds + 384 * SLD * 2);
    const float* dt = (const float*)(a->ws + WS_DT); float* decay = (float*)(a->ws + WS_DECAY);
    const float* cw = a->in[I_SCW] + l * 5 * 1024; const float* cbs = a->in[I_SCB] + l * 1024;
    for (int it = blockIdx.x; it < 256; it += gridDim.x) {
        const int gc = cbase + (it >> 1), g = it & 1, t0 = gc * 128; int lo, hi; seq_bounds(t0, lo, hi);
        const int hh = wave >> 1, dir = wave & 1, h8 = g * 4 + hh;
        { float d0, d1, c0, c1, tot; const float A = -__expf(a->in[I_ALOG][l * 16 + dir * 8 + h8]);
          chunk_scan(dt, t0, dir * 8 + h8, A, dir, lane, d0, d1, c0, c1, tot);
          sW[wave * 128 + 2 * lane] = d0 * __expf(tot - c0); sW[wave * 128 + 2 * lane + 1] = d1 * __expf(tot - c1);
          if (lane == 0) decay[gc * 16 + h8 * 2 + dir] = __expf(tot); }
        load_conv_tile<256, true>(xs_raw, 512, g * 256, t0, lo, hi, cw, cbs, g * 256, xsT);
        load_conv_tile<128, true>(bc_raw, 512, g * 128, t0, lo, hi, cw, cbs, 512 + g * 128, BT);
        __syncthreads();
        f32x4 acc[8][4];
#pragma unroll
        for (int i = 0; i < 8; ++i)
#pragma unroll
            for (int j = 0; j < 4; ++j) acc[i][j] = (f32x4){0.f, 0.f, 0.f, 0.f};
        const int fr = lane & 15, fq = lane >> 4;
#pragma unroll 1
        for (int ks = 0; ks < 4; ++ks) {
            const int s0 = ks * 32 + fq * 8;
            float sc[8]; { const f32x4 q0 = *(const LAS f32x4*)(sW + wave * 128 + s0), q1 = *(const LAS f32x4*)(sW + wave * 128 + s0 + 4);
#pragma unroll
                for (int e = 0; e < 4; ++e) { sc[e] = q0[e]; sc[4 + e] = q1[e]; } }
            bf16x8 xf[4];
#pragma unroll
            for (int pt = 0; pt < 4; ++pt) xf[pt] = scale_frag8(*(const LAS bf16x8*)(xsT + (hh * 64 + pt * 16 + fr) * SLD + s0), sc);
#pragma unroll
            for (int nt = 0; nt < 8; ++nt) { const bf16x8 bf = *(const LAS bf16x8*)(BT + (nt * 16 + fr) * SLD + s0);
#pragma unroll
                for (int pt = 0; pt < 4; ++pt) acc[nt][pt] = __builtin_amdgcn_mfma_f32_16x16x32_bf16(bf, xf[pt], acc[nt][pt], 0, 0, 0); }
        }
        bf16_t* st = states + ((size_t)((gc - cbase) * 8 + h8) * 2 + dir) * 8192;
#pragma unroll
        for (int nt = 0; nt < 8; ++nt)
#pragma unroll
            for (int pt = 0; pt < 4; ++pt) { u32x2 q; q.x = pk2(acc[nt][pt][0], acc[nt][pt][1]); q.y = pk2(acc[nt][pt][2], acc[nt][pt][3]); *(u32x2*)(st + (pt * 16 + fr) * 128 + nt * 16 + fq * 4) = q; }
        __syncthreads();
    }
}
__device__ __forceinline__ void phase_s2(ArgsP a, int cbase, bf16_t* states) {
    const int nseq = cbase == 0 ? 8 : 4, cps = cbase == 0 ? 16 : 32;
    const float* decay = (const float*)(a->ws + WS_DECAY);
    const int total = nseq * 16 * 1024;
    for (int i = blockIdx.x * 512 + otid(); i < total; i += gridDim.x * 512) {
        const int e8 = i & 1023, hd = (i >> 10) & 15, sq = i >> 14, dir = hd & 1;
        float hs[8];
#pragma unroll
        for (int j = 0; j < 8; ++j) hs[j] = 0.f;
        for (int cc = 0; cc < cps; ++cc) {
            const int crel = sq * cps + (dir ? cps - 1 - cc : cc);
            u32x4* p = (u32x4*)(states + ((size_t)crel * 16 + hd) * 8192) + e8; const u32x4 w = *p;
            const float dc = decay[(cbase + crel) * 16 + hd];
            u32x4 o; o.x = pk2(hs[0], hs[1]); o.y = pk2(hs[2], hs[3]); o.z = pk2(hs[4], hs[5]); o.w = pk2(hs[6], hs[7]); *p = o;
            hs[0] = hs[0] * dc + bflo(w.x); hs[1] = hs[1] * dc + bfhi(w.x); hs[2] = hs[2] * dc + bflo(w.y); hs[3] = hs[3] * dc + bfhi(w.y);
            hs[4] = hs[4] * dc + bflo(w.z); hs[5] = hs[5] * dc + bfhi(w.z); hs[6] = hs[6] * dc + bflo(w.w); hs[7] = hs[7] * dc + bfhi(w.w);
        }
    }
}
__device__ __forceinline__ void phase_s3(ArgsP a, int l, int cbase, LAS unsigned char* lds, const bf16_t* xs_raw, const bf16_t* bc_raw, const bf16_t* states, bf16_t* gate) {
    const int tid = otid(), lane = tid & 63, wave = __builtin_amdgcn_readfirstlane(tid >> 6), fr = lane & 15, fq = lane >> 4;
    LAS bf16_t* xsT = (LAS bf16_t*)lds;
    LAS bf16_t* sC = (LAS bf16_t*)(lds + 128 * SLD * 2);
    LAS bf16_t* sB = (LAS bf16_t*)(lds + 256 * SLD * 2);
    LAS float* sDt = (LAS float*)(lds + 384 * SLD * 2);
    LAS float* sCs = sDt + 512;
    const float* dt = (const float*)(a->ws + WS_DT);
    const float* cw = a->in[I_SCW] + l * 5 * 1024; const float* cbs = a->in[I_SCB] + l * 1024;
    for (int it = blockIdx.x; it < 512; it += gridDim.x) {
        const int gc = cbase + (it >> 2), g = (it >> 1) & 1, hp = it & 1, t0 = gc * 128; int lo, hi; seq_bounds(t0, lo, hi);
        { const int w4 = wave & 3, hh2 = w4 >> 1, dir = w4 & 1, h8 = g * 4 + hp * 2 + hh2; float d0, d1, c0, c1, tot; const float A = -__expf(a->in[I_ALOG][l * 16 + dir * 8 + h8]);
          chunk_scan(dt, t0, dir * 8 + h8, A, dir, lane, d0, d1, c0, c1, tot);
          if (wave < 4) { sDt[w4 * 128 + 2 * lane] = d0; sDt[w4 * 128 + 2 * lane + 1] = d1; sCs[w4 * 128 + 2 * lane] = c0; sCs[w4 * 128 + 2 * lane + 1] = c1; } }
        load_conv_tile<128, true>(xs_raw, 512, g * 256 + hp * 128, t0, lo, hi, cw, cbs, g * 256 + hp * 128, xsT);
        load_conv_tile<128, false>(bc_raw, 512, g * 128, t0, lo, hi, cw, cbs, 512 + g * 128, sB);
        load_conv_tile<128, false>(bc_raw, 512, 256 + g * 128, t0, lo, hi, cw, cbs, 768 + g * 128, sC);
        __syncthreads();
#ifdef S3_PROBE
        { int pb = 99; for (int r = wave; r < 128; r += 8) { const unsigned short v0 = xsT[r * SLD + lane], v1 = xsT[r * SLD + 64 + lane]; if ((v0 & 0x7f80) == 0x7f80 || (v1 & 0x7f80) == 0x7f80) pb = 1; const unsigned short c0 = sC[r * SLD + lane], c1 = sC[r * SLD + 64 + lane]; if (!(fabsf(bf2f(c0)) < 1e4f) || !(fabsf(bf2f(c1)) < 1e4f)) pb = min(pb, 2); const unsigned short b0 = sB[r * SLD + lane], b1 = sB[r * SLD + 64 + lane]; if (!(fabsf(bf2f(b0)) < 1e4f) || !(fabsf(bf2f(b1)) < 1e4f)) pb = min(pb, 3); }
          if (pb < 99) atomicMax((int*)(a->ws + 106 * MiB + 262144), 100 - pb); }
#endif
        {
            f32x4 cacc[8];
#pragma unroll
            for (int i = 0; i < 8; ++i) cacc[i] = (f32x4){0.f, 0.f, 0.f, 0.f};
#pragma unroll
            for (int ks = 0; ks < 4; ++ks) { const bf16x8 cf = *(const LAS bf16x8*)(sC + (wave * 16 + fr) * SLD + ks * 32 + fq * 8);
#pragma unroll
                for (int st = 0; st < 8; ++st) { const bf16x8 bf = *(const LAS bf16x8*)(sB + (st * 16 + fr) * SLD + ks * 32 + fq * 8); cacc[st] = __builtin_amdgcn_mfma_f32_16x16x32_bf16(bf, cf, cacc[st], 0, 0, 0); } }
            __syncthreads();
#pragma unroll
            for (int st = 0; st < 8; ++st) { u32x2 q; q.x = pk2(cacc[st][0], cacc[st][1]); q.y = pk2(cacc[st][2], cacc[st][3]); *(LAS u32x2*)(sB + (wave * 16 + fr) * SLD + st * 16 + fq * 4) = q; }
            __syncthreads();
        }
#ifdef S3_PROBE
        { int pb = 99; for (int r = wave; r < 128; r += 8) { const unsigned short v0 = xsT[r * SLD + lane], v1 = xsT[r * SLD + 64 + lane]; if ((v0 & 0x7f80) == 0x7f80 || (v1 & 0x7f80) == 0x7f80) pb = 4; const unsigned short b0 = sB[r * SLD + lane], b1 = sB[r * SLD + 64 + lane]; if (!(fabsf(bf2f(b0)) < 1e8f) || !(fabsf(bf2f(b1)) < 1e8f)) pb = min(pb, 5); }
          for (int i = lane; i < 512; i += 64) { if (!(fabsf(sDt[i]) < 1e30f)) pb = min(pb, 6); if (!(fabsf(sCs[i]) < 1e30f)) pb = min(pb, 7); if (sCs[i] > 0.f) pb = min(pb, 8); }
          if (pb < 99) atomicMax((int*)(a->ws + 106 * MiB + 262144), 100 - pb); }
#endif
        const int hh2 = wave >> 2, lq = wave & 3, h8 = g * 4 + hp * 2 + hh2;
        const float Dh = a->in[I_SD][l * 8 + h8];
        const LAS float* dtf = sDt + (hh2 * 2) * 128; const LAS float* dtb = sDt + (hh2 * 2 + 1) * 128; const LAS float* csf = sCs + (hh2 * 2) * 128; const LAS float* csb = sCs + (hh2 * 2 + 1) * 128;
        int probe = 99; (void)probe;
        f32x4 acc[2][4];
#pragma unroll
        for (int i = 0; i < 2; ++i)
#pragma unroll
            for (int j = 0; j < 4; ++j) acc[i][j] = (f32x4){0.f, 0.f, 0.f, 0.f};
#pragma unroll 1
        for (int ks = 0; ks < 4; ++ks) {
            const int s0 = ks * 32 + fq * 8;
            bf16x8 xf[4];
#pragma unroll
            for (int pt = 0; pt < 4; ++pt) xf[pt] = *(const LAS bf16x8*)(xsT + (hh2 * 64 + pt * 16 + fr) * SLD + s0);
            float vdf[8], vdb[8], vcf[8], vcb[8];
            { const f32x4 q0 = *(const LAS f32x4*)(dtf + s0), q1 = *(const LAS f32x4*)(dtf + s0 + 4), r0 = *(const LAS f32x4*)(dtb + s0), r1 = *(const LAS f32x4*)(dtb + s0 + 4);
              const f32x4 u0 = *(const LAS f32x4*)(csf + s0), u1 = *(const LAS f32x4*)(csf + s0 + 4), w0 = *(const LAS f32x4*)(csb + s0), w1 = *(const LAS f32x4*)(csb + s0 + 4);
#pragma unroll
              for (int e = 0; e < 4; ++e) { vdf[e] = q0[e]; vdf[4 + e] = q1[e]; vdb[e] = r0[e]; vdb[4 + e] = r1[e]; vcf[e] = u0[e]; vcf[4 + e] = u1[e]; vcb[e] = w0[e]; vcb[4 + e] = w1[e]; } }
#pragma unroll
            for (int lt = 0; lt < 2; ++lt) {
                const int lrow = lq * 32 + lt * 16 + fr;
                const float csf_l = csf[lrow], csb_l = csb[lrow];
                const u32x4 cbq = *(const LAS u32x4*)(sB + lrow * SLD + s0);
                const float cbv[8] = {bflo(cbq.x), bfhi(cbq.x), bflo(cbq.y), bfhi(cbq.y), bflo(cbq.z), bfhi(cbq.z), bflo(cbq.w), bfhi(cbq.w)};
                float mv[8];
#pragma unroll
                for (int e = 0; e < 8; ++e) { const int s = s0 + e;
                    const float ex = s < lrow ? csf_l - vcf[e] : csb_l - vcb[e];
                    const float dd = s < lrow ? vdf[e] : vdb[e];
                    float mm = cbv[e] * __expf(ex) * dd;
                    if (s == lrow) mm = cbv[e] * (vdf[e] + vdb[e]) + Dh;
                    mv[e] = mm;
#ifdef S3_PROBE2
                    if (!(fabsf(cbv[e]) < 1e30f)) probe = min(probe, 11); if (ex > 0.f) probe = min(probe, 12); if (!(fabsf(mm) < 1e30f)) probe = min(probe, 13);
#endif
                    }
                union { bf16x8 v; unsigned u[4]; } mf;
#pragma unroll
                for (int j = 0; j < 4; ++j) mf.u[j] = pk2(mv[2 * j], mv[2 * j + 1]);
#pragma unroll
                for (int pt = 0; pt < 4; ++pt) acc[lt][pt] = __builtin_amdgcn_mfma_f32_16x16x32_bf16(xf[pt], mf.v, acc[lt][pt], 0, 0, 0);
            }
        }
#ifdef S3_PROBE2
        for (int i = 0; i < 2; ++i) for (int j = 0; j < 4; ++j) for (int e = 0; e < 4; ++e) if (!(fabsf(acc[i][j][e]) < 1e30f)) probe = min(probe, 14);
#endif
#pragma unroll 1
        for (int dir = 0; dir < 2; ++dir) {
            const bf16_t* pv = states + ((size_t)((gc - cbase) * 8 + h8) * 2 + dir) * 8192;
            const LAS float* cs = dir ? csb : csf;
            float el[2];
#pragma unroll
            for (int lt = 0; lt < 2; ++lt) el[lt] = __expf(cs[lq * 32 + lt * 16 + fr]);
#pragma unroll 1
            for (int ks = 0; ks < 4; ++ks) {
                const int n0 = ks * 32 + fq * 8;
                bf16x8 pf[4];
#pragma unroll
                for (int pt = 0; pt < 4; ++pt) pf[pt] = *(const bf16x8*)(pv + (pt * 16 + fr) * 128 + n0);
#pragma unroll
                for (int lt = 0; lt < 2; ++lt) {
                    const float sc[8] = {el[lt], el[lt], el[lt], el[lt], el[lt], el[lt], el[lt], el[lt]};
                    const bf16x8 cf = scale_frag8(*(const LAS bf16x8*)(sC + (lq * 32 + lt * 16 + fr) * SLD + n0), sc);
#pragma unroll
                    for (int pt = 0; pt < 4; ++pt) acc[lt][pt] = __builtin_amdgcn_mfma_f32_16x16x32_bf16(pf[pt], cf, acc[lt][pt], 0, 0, 0);
                }
            }
        }
#ifdef S3_PROBE2
        for (int i = 0; i < 2; ++i) for (int j = 0; j < 4; ++j) for (int e = 0; e < 4; ++e) if (!(fabsf(acc[i][j][e]) < 1e30f)) probe = min(probe, 15);
#endif
#pragma unroll
        for (int lt = 0; lt < 2; ++lt)
#pragma unroll
            for (int pt = 0; pt < 4; ++pt) {
                u32x2* gp = (u32x2*)(gate + (size_t)(t0 + lq * 32 + lt * 16 + fr) * 512 + g * 256 + (hp * 2 + hh2) * 64 + pt * 16 + fq * 4);
                const u32x2 gq = *gp;
                u32x2 o; o.x = pk2(acc[lt][pt][0] * silu_f(bflo(gq.x)), acc[lt][pt][1] * silu_f(bfhi(gq.x))); o.y = pk2(acc[lt][pt][2] * silu_f(bflo(gq.y)), acc[lt][pt][3] * silu_f(bfhi(gq.y)));
                *gp = o;
#ifdef S3_PROBE2
                if ((gq.x & 0x7f80u) == 0x7f80u || (gq.x & 0x7f800000u) == 0x7f800000u || (gq.y & 0x7f80u) == 0x7f80u || (gq.y & 0x7f800000u) == 0x7f800000u) probe = min(probe, 16);
                if ((o.x & 0x7f80u) == 0x7f80u || (o.x & 0x7f800000u) == 0x7f800000u || (o.y & 0x7f80u) == 0x7f80u || (o.y & 0x7f800000u) == 0x7f800000u) probe = min(probe, 17);
#endif
            }
#ifdef S3_PROBE2
        if (probe < 99) atomicMax((int*)(a->ws + 106 * MiB + 262144), 100 - probe);
#endif
        __syncthreads();
    }
}
__device__ __forceinline__ f32x2 cmul(f32x2 a, f32x2 b) { return (f32x2){a.x * b.x - a.y * b.y, a.x * b.y + a.y * b.x}; }
__device__ __forceinline__ f32x2 cmulc(f32x2 a, f32x2 b) { return (f32x2){a.x * b.x + a.y * b.y, a.y * b.x - a.x * b.y}; }
template <int LOGN> __device__ __forceinline__ void fft_fwd(LAS f32x2* d, const LAS f32x2* tw) {
    constexpr int N = 1 << LOGN;
#pragma unroll 1
    for (int ls = LOGN - 1; ls >= 1; ls -= 2) {
        const int s = 1 << ls, hs = s >> 1;
        for (int q = otid(); q < N / 4; q += 512) {
            const int j = q & (hs - 1), blk = q >> (ls - 1), base = (blk << (ls + 1)) + j;
            const f32x2 x0 = d[base], x1 = d[base + hs], x2 = d[base + s], x3 = d[base + s + hs];
            const f32x2 w1 = tw[j << (12 - ls)], w2 = tw[j << (13 - ls)];
            const f32x2 a0 = x0 + x2, a2 = cmul(x0 - x2, w1), a1 = x1 + x3; f32x2 t = x1 - x3; t = (f32x2){t.y, -t.x}; const f32x2 a3 = cmul(t, w1);
            d[base] = a0 + a1; d[base + hs] = cmul(a0 - a1, w2); d[base + s] = a2 + a3; d[base + s + hs] = cmul(a2 - a3, w2);
        }
        __syncthreads();
    }
    if (LOGN & 1) {
        for (int q = otid(); q < N / 2; q += 512) { const f32x2 x0 = d[2 * q], x1 = d[2 * q + 1]; d[2 * q] = x0 + x1; d[2 * q + 1] = x0 - x1; }
        __syncthreads();
    }
}
template <int LOGN> __device__ __forceinline__ void fft_inv(LAS f32x2* d, const LAS f32x2* tw) {
    constexpr int N = 1 << LOGN;
    if (LOGN & 1) {
        for (int q = otid(); q < N / 2; q += 512) { const f32x2 x0 = d[2 * q], x1 = d[2 * q + 1]; d[2 * q] = x0 + x1; d[2 * q + 1] = x0 - x1; }
        __syncthreads();
    }
#pragma unroll 1
    for (int ls = (LOGN & 1) ? 2 : 1; ls <= LOGN - 1; ls += 2) {
        const int s = 1 << ls, hs = s >> 1;
        for (int q = otid(); q < N / 4; q += 512) {
            const int j = q & (hs - 1), blk = q >> (ls - 1), base = (blk << (ls + 1)) + j;
            const f32x2 b0 = d[base], b1 = d[base + hs], b2 = d[base + s], b3 = d[base + s + hs];
            const f32x2 w1 = tw[j << (12 - ls)], w2 = tw[j << (13 - ls)];
            f32x2 v = cmulc(b1, w2); const f32x2 a0 = b0 + v, a1 = b0 - v; v = cmulc(b3, w2); const f32x2 a2 = b2 + v, a3 = b2 - v;
            v = cmulc(a2, w1); d[base] = a0 + v; d[base + s] = a0 - v;
            v = cmulc(a3, w1); v = (f32x2){-v.y, v.x}; d[base + hs] = a1 + v; d[base + s + hs] = a1 - v;
        }
        __syncthreads();
    }
}
template <int LOGN> __device__ __forceinline__ void hyena_conv_item(ArgsP a, int l, int c, LAS unsigned char* lds, const bf16_t* x1T, bf16_t* vT) {
    constexpr int N = 1 << LOGN, L = N / 2, SET = (LOGN == 13), NB = SET ? 4 : 8, TOK0 = SET ? TP : 0, NJ = L / 512, NK = N / 512;
    LAS f32x2* d = (LAS f32x2*)lds;
    LAS f32x2* tw = (LAS f32x2*)(lds + 65536);
    LAS float* sfw = (LAS float*)(lds + 65536 + 32768);
    const int tid = otid();
    if (tid < 128) sfw[tid] = a->in[I_FW3][(size_t)l * 64 * 1024 + (size_t)(tid & 63) * 1024 + (tid >> 6) * 512 + c];
    __syncthreads();
    const float min_decay = -3.0701134573253944f, max_decay = -15.350567286626972f;
    const float delta = fabsf(min_decay + (float)c * ((max_decay - min_decay) / 511.0f));
    const float b3f = a->in[I_FB3][l * 1024 + c], b3b = a->in[I_FB3][l * 1024 + 512 + c];
    const float* h2 = (const float*)(a->ws + WS_H2) + ((size_t)l * 6144 + (SET ? 2048 : 0)) * 64;
    for (int t = tid; t < L; t += 512) {
        const f32x4* hr = (const f32x4*)(h2 + (size_t)t * 64); float hf = b3f, hb = b3b;
#pragma unroll
        for (int i = 0; i < 16; ++i) { const f32x4 h = hr[i]; const f32x4 wf = *(const LAS f32x4*)(sfw + 4 * i), wb = *(const LAS f32x4*)(sfw + 64 + 4 * i);
            hf += (h[0] * wf[0] + h[1] * wf[1]) + (h[2] * wf[2] + h[3] * wf[3]); hb += (h[0] * wb[0] + h[1] * wb[1]) + (h[2] * wb[2] + h[3] * wb[3]); }
        const float dec = __expf(-((float)t / (float)(L - 1)) * delta);
        d[t] = (f32x2){hf * dec, 0.f};
        if (t >= 1) d[N - t] = (f32x2){hb * dec, 0.f};
    }
    if (tid == 0) d[L] = (f32x2){0.f, 0.f};
    __syncthreads();
    fft_fwd<LOGN>(d, tw);
    f32x2 kf[NK];
#pragma unroll
    for (int j = 0; j < NK; ++j) kf[j] = d[tid + 512 * j] * (1.0f / (float)N);
    __syncthreads();
    const float* cw = a->in[I_HCW] + l * 3 * 1536; const float cb1 = a->in[I_HCB][l * 1536 + 512 + c], cbv = a->in[I_HCB][l * 1536 + 1024 + c];
    const float w10 = cw[512 + c], w11 = cw[1536 + 512 + c], w12 = cw[3072 + 512 + c], wv0 = cw[1024 + c], wv1 = cw[1536 + 1024 + c], wv2 = cw[3072 + 1024 + c];
    const float hbias = a->in[I_HBIAS][l * 512 + c];
#pragma unroll 1
    for (int bp = 0; bp < NB / 2; ++bp) {
        const size_t rowA = (size_t)c * T_ALL + TOK0 + (size_t)(2 * bp) * L, rowB = rowA + L;
        float zA[NJ], zB[NJ];
#pragma unroll
        for (int jj = 0; jj < NJ; ++jj) {
            const int t = tid + 512 * jj;
            const bool hasl = t > 0, hasr = t < L - 1;
            const float a1m = hasl ? bf2f(x1T[rowA + t - 1]) : 0.f, a1c = bf2f(x1T[rowA + t]), a1p = hasr ? bf2f(x1T[rowA + t + 1]) : 0.f;
            const float avm = hasl ? bf2f(vT[rowA + t - 1]) : 0.f, avc = bf2f(vT[rowA + t]), avp = hasr ? bf2f(vT[rowA + t + 1]) : 0.f;
            const float b1m = hasl ? bf2f(x1T[rowB + t - 1]) : 0.f, b1c = bf2f(x1T[rowB + t]), b1p = hasr ? bf2f(x1T[rowB + t + 1]) : 0.f;
            const float bvm = hasl ? bf2f(vT[rowB + t - 1]) : 0.f, bvc = bf2f(vT[rowB + t]), bvp = hasr ? bf2f(vT[rowB + t + 1]) : 0.f;
            zA[jj] = (cb1 + w10 * a1m + w11 * a1c + w12 * a1p) * (cbv + wv0 * avm + wv1 * avc + wv2 * avp);
            zB[jj] = (cb1 + w10 * b1m + w11 * b1c + w12 * b1p) * (cbv + wv0 * bvm + wv1 * bvc + wv2 * bvp);
            d[t] = (f32x2){zA[jj], zB[jj]}; d[L + t] = (f32x2){0.f, 0.f};
        }
        __syncthreads();
        fft_fwd<LOGN>(d, tw);
#pragma unroll
        for (int j = 0; j < NK; ++j) d[tid + 512 * j] = cmul(d[tid + 512 * j], kf[j]);
        __syncthreads();
        fft_inv<LOGN>(d, tw);
#pragma unroll
        for (int jj = 0; jj < NJ; ++jj) {
            const int t = tid + 512 * jj; const f32x2 y = d[t];
            vT[rowA + t] = (bf16_t)(pk2(y.x + zA[jj] * hbias, 0.f) & 0xffffu);
            vT[rowB + t] = (bf16_t)(pk2(y.y + zB[jj] * hbias, 0.f) & 0xffffu);
        }
        __syncthreads();
    }
}
__device__ __forceinline__ void phase_hyena_conv(ArgsP a, int l, LAS unsigned char* lds, const bf16_t* x1T, bf16_t* vT) {
    { LAS f32x2* tw = (LAS f32x2*)(lds + 65536); const f32x2* g = (const f32x2*)(a->ws + WS_TW); for (int i = otid(); i < 4096; i += 512) tw[i] = g[i]; }
    __syncthreads();
    for (int it = blockIdx.x; it < 1024; it += gridDim.x) {
        if (it < 512) hyena_conv_item<13>(a, l, it, lds, x1T, vT);
        else hyena_conv_item<12>(a, l, it - 512, lds, x1T, vT);
    }
}
__device__ __forceinline__ void phase_hyena_norm(ArgsP a, int l, LAS unsigned char* lds, const bf16_t* x0T, const bf16_t* yT, bf16_t* hyn) {
    constexpr int PLD = 513;
    LAS float* P = (LAS float*)lds;
    LAS float* part = (LAS float*)(lds + 32 * PLD * 4);
    const int tid = otid(), lane = tid & 63, wave = tid >> 6, tl0 = lane & 31, cpar = lane >> 5;
    const float* cw = a->in[I_HCW] + l * 3 * 1536; const float* cb = a->in[I_HCB] + l * 1536;
    for (int it = blockIdx.x; it < T_ALL / 32; it += gridDim.x) {
        const int tile0 = it * 32, t = tile0 + tl0; int lo, hi; seq_bounds(tile0, lo, hi);
        const bool hasl = t > lo, hasr = t < hi - 1;
        float ss = 0.f;
#pragma unroll 4
        for (int i = 0; i < 32; ++i) {
            const int c = wave * 64 + 2 * i + cpar; const size_t row = (size_t)c * T_ALL;
            const float xm = hasl ? bf2f(x0T[row + t - 1]) : 0.f, xc = bf2f(x0T[row + t]), xp = hasr ? bf2f(x0T[row + t + 1]) : 0.f;
            const float x0c = cb[c] + cw[c] * xm + cw[1536 + c] * xc + cw[3072 + c] * xp;
            const float p = x0c * bf2f(yT[row + t]);
            P[tl0 * PLD + c] = p; ss += p * p;
        }
        ss += __shfl_xor(ss, 32);
        if (lane < 32) part[wave * 32 + lane] = ss;
        __syncthreads();
#pragma unroll 1
        for (int r = 0; r < 4; ++r) {
            const int tl = wave * 4 + r;
            float s = 0.f;
#pragma unroll
            for (int w = 0; w < 8; ++w) s += part[w * 32 + tl];
            const float rs = rsqrtf(s * (1.0f / 512.0f) + EPS);
            bf16_t* orow = hyn + (size_t)(tile0 + tl) * 512;
#pragma unroll
            for (int j = 0; j < 4; ++j) { const int c = 2 * lane + 128 * j;
                const float v0 = P[tl * PLD + c] * rs * a->in[I_HNORM][l * 512 + c], v1 = P[tl * PLD + c + 1] * rs * a->in[I_HNORM][l * 512 + c + 1];
                *(unsigned*)(orow + c) = pk2(v0, v1); }
        }
        __syncthreads();
    }
}
#define XB_TMO      128
#define XB_XCNT(j)  (256  + 64 * (j))
#define XB_XSUB(j)  (1280 + 64 * (j))
#define XB_XGEN(j)  (2304 + 64 * (j))
#define XB_TOP      3328
#define XB_TOPGEN   3392
#define XCD_BAR_WORDS 3456
#define XB_SPIN_CAP (1u << 22)
constexpr size_t WS_BAR = 106 * MiB + 524288;
__device__ __forceinline__ unsigned xb_ld(unsigned* p)              { return __hip_atomic_load(p, __ATOMIC_RELAXED, __HIP_MEMORY_SCOPE_AGENT); }
__device__ __forceinline__ unsigned xb_add(unsigned* p, unsigned v) { return __hip_atomic_fetch_add(p, v, __ATOMIC_RELAXED, __HIP_MEMORY_SCOPE_AGENT); }
__device__ __forceinline__ unsigned xb_xcc_id() { return (unsigned)__builtin_amdgcn_s_getreg((3 << 11) | 20) & 0xFu; }
#define XB_SPIN(cond, bar) do { unsigned _sp = 0; while (cond) { __builtin_amdgcn_s_sleep(1); \
    if ((++_sp & 255u) == 0u) { if (xb_ld(&(bar)[XB_TMO])) break; if (_sp > XB_SPIN_CAP) { atomicAdd(&(bar)[XB_TMO], 1u); break; } } } } while (0)
__device__ __forceinline__ void xcd_barrier_complete(unsigned* bar, unsigned x, unsigned& nloc, unsigned& nx) {
    const unsigned G = gridDim.x;
    unsigned sum, cnt, mine, sp = 0u;
    for (;;) {
        sum = 0u; cnt = 0u; mine = 0u;
#pragma unroll
        for (unsigned j = 0; j < 16; ++j) { const unsigned c = xb_ld(&bar[XB_XCNT(j)]); sum += c; cnt += (c > 0u) ? 1u : 0u; mine = (j == x) ? c : mine; }
        if (sum == G) break;
        __builtin_amdgcn_s_sleep(1);
        if ((++sp & 255u) == 0u) { if (xb_ld(&bar[XB_TMO])) break; if (sp > XB_SPIN_CAP) { atomicAdd(&bar[XB_TMO], 1u); break; } }
    }
    nloc = mine > 0u ? mine : 1u; nx = cnt > 0u ? cnt : 1u;
}
__device__ __forceinline__ void xcd_barrier(unsigned* bar, volatile LAS unsigned* st) {
    asm volatile("s_waitcnt vmcnt(0)" ::: "memory");
    __syncthreads();
    if (threadIdx.x == 0) {
        const unsigned x = xb_xcc_id();
        __builtin_amdgcn_s_waitcnt(0);
        unsigned nloc = st[0], nx = st[1];
        if (nloc == 0u) { xcd_barrier_complete(bar, x, nloc, nx); st[0] = nloc; st[1] = nx; }
        const unsigned old = xb_add(&bar[XB_XSUB(x)], 1u);
        const unsigned gen = old / nloc;
        if (old + 1u == (gen + 1u) * nloc) {
            __builtin_amdgcn_fence(__ATOMIC_RELEASE, "agent");
            asm volatile("s_waitcnt vmcnt(0)" ::: "memory");
            const unsigned og = xb_add(&bar[XB_TOP], 1u);
            const unsigned tg = og / nx;
            if (og + 1u == (tg + 1u) * nx) xb_add(&bar[XB_TOPGEN], 1u);
            else XB_SPIN(xb_ld(&bar[XB_TOPGEN]) == tg, bar);
            __builtin_amdgcn_fence(__ATOMIC_ACQUIRE, "agent");
            xb_add(&bar[XB_XGEN(x)], 1u);
            asm volatile("s_waitcnt vmcnt(0)" ::: "memory");
        } else {
            XB_SPIN(xb_ld(&bar[XB_XGEN(x)]) == gen, bar);
            __builtin_amdgcn_fence(__ATOMIC_ACQUIRE, "agent");
            asm volatile("s_waitcnt vmcnt(0)" ::: "memory");
        }
    }
    __syncthreads();
}
__device__ __forceinline__ void epi_cfg(int st, int gi, int l, unsigned char* ws, float* out, ArgsP a, Epi& E) {
    float* ssq = (float*)(ws + WS_SSQ); bf16_t* xb = (bf16_t*)(ws + WS_XB);
    bf16_t* r1a = (bf16_t*)(ws + WS_R1A); bf16_t* r1b = (bf16_t*)(ws + WS_R1B); bf16_t* r2 = (bf16_t*)(ws + WS_R2); bf16_t* r3 = (bf16_t*)(ws + WS_R3);
    bf16_t* kmat = (bf16_t*)(ws + WS_R4); bf16_t* vtm = (bf16_t*)(ws + WS_R4 + 6 * MiB);
    float* ssq_in = ssq + (size_t)(3 * l) * T_ALL; float* ssq_a = ssq_in + T_ALL; float* ssq_m = ssq_a + T_ALL; float* ssq_n = ssq_m + T_ALL;
    const int half = (st >= 16) ? ((st - 16) >> 1) : 0;
    E.kind = 0; E.O0 = r1a; E.d1 = 0; E.d2 = 0; E.ldc = 1024; E.csplit = 0; E.rsplit = 0; E.ssq = ssq_in; E.psum = (float*)(ws + WS_PSUM); E.row_off = 0; E.SCALE = 0; E.ACT = 0;
    E.X = out; E.rin0 = out; E.rin1 = out + (size_t)TP * DM; E.xb = xb; E.ssq_out = ssq_a;
    if (st == 1)       { E.O0 = r1b; E.d1 = r2 - r1b; E.d2 = r3 - r2; E.ldc = 512; E.csplit = 2; E.SCALE = 1; }
    else if (st == 8)  { E.O0 = r2; E.d1 = r1a - r2; E.d2 = r3 - r1a; E.ldc = T_ALL; E.rsplit = 2; E.SCALE = 2; }
    else if (st == 11) { E.kind = 1; if (l == 0) { E.rin0 = a->in[I_XP]; E.rin1 = a->in[I_XS]; } }
    else if (st == 12) {
        if (gi == 0)      { E.SCALE = 1; E.ssq = ssq_a; }
        else if (gi == 1) { E.O0 = kmat; }
        else              { E.O0 = vtm; E.ldc = 3072; }
    }
    else if (st == 13) { E.O0 = r2; E.ACT = 2; }
    else if (st == 14) { E.SCALE = 3; }
    else if (st == 15) { E.kind = 1; E.ssq_out = ssq_m; }
    else if (st == 16 || st == 18) { E.ldc = 4096; E.SCALE = 1; E.ACT = 1; E.ssq = ssq_m; E.row_off = half * TP; }
    else               { E.kind = 1; E.ssq_out = ssq_n; E.row_off = half * TP; }
}
template <int KIND> struct EpiT {
    static constexpr bool PERM = true;
    int st, gi, l; unsigned char* ws; float* out; ArgsP a;
    __device__ __forceinline__ void operator()(const f32x4 (&acc)[2][2][4][2], const pg8::Unit& u, int wr, int wc, int fr, int fq) const {
        int st_ = st; asm volatile("" : "+s"(st_));
        Epi E; epi_cfg(st_, gi, l, ws, out, a, E);
        if (KIND == 0) E.bf_path(acc, u, wr, wc, fr, fq); else E.res_path(acc, u, wr, wc, fr, fq);
    }
};
#ifdef DBG_SCAN
constexpr size_t WS_FLAG = 106 * MiB + 262144;
__device__ __forceinline__ void dbg_scan(unsigned char* ws, float* out, int ph) {
    int bad = 0;
    const size_t gt = (size_t)blockIdx.x * 512 + otid(), gs = (size_t)gridDim.x * 512;
    { const u32x4* p = (const u32x4*)(ws + 32 * MiB); const size_t n = (70 * MiB) / 16;
      for (size_t i = gt; i < n; i += gs) { const u32x4 w = p[i];
#pragma unroll
          for (int e = 0; e < 4; ++e) { const unsigned x = w[e]; if ((x & 0x7f80u) == 0x7f80u || (x & 0x7f800000u) == 0x7f800000u) bad = 1; } } }
    { const u32x4* p = (const u32x4*)(ws + 111 * MiB); const size_t n = (140 * MiB) / 16;
      for (size_t i = gt; i < n; i += gs) { const u32x4 w = p[i];
#pragma unroll
          for (int e = 0; e < 4; ++e) { const unsigned x = w[e]; if ((x & 0x7f80u) == 0x7f80u || (x & 0x7f800000u) == 0x7f800000u) bad = 1; } } }
    { const u32x4* p = (const u32x4*)(ws + 102 * MiB); const size_t n = (9 * MiB) / 16;
      for (size_t i = gt; i < n; i += gs) { const u32x4 w = p[i];
#pragma unroll
          for (int e = 0; e < 4; ++e) { const unsigned x = w[e]; if ((x & 0x7f800000u) == 0x7f800000u) bad = 1; } } }
    { const u32x4* p = (const u32x4*)out; const size_t n = (128 * MiB) / 16;
      for (size_t i = gt; i < n; i += gs) { const u32x4 w = p[i];
#pragma unroll
          for (int e = 0; e < 4; ++e) { const unsigned x = w[e]; if ((x & 0x7f800000u) == 0x7f800000u) bad = 1; } } }
    if (bad) atomicMax((int*)(ws + WS_FLAG), 100 - (ph + 1));
}
#endif
__global__ __launch_bounds__(512, 2) void mega_fwd(Args a_by_value) {
    extern __shared__ __attribute__((aligned(16))) unsigned char shm[];
    LAS unsigned char* lds = (LAS unsigned char*)shm;
    cg::grid_group grid = cg::this_grid();
    volatile LAS unsigned* xst = (volatile LAS unsigned*)(lds + 131072);
    if (threadIdx.x == 0) { xst[0] = 0u; xst[1] = 0u; xst[2] = 0u; xst[3] = 0u; (void)xb_add(&((unsigned*)(a_by_value.ws + WS_BAR))[XB_XCNT(xb_xcc_id())], 1u); }
    __syncthreads();
#pragma unroll 1
    for (int ph = 0; ph <= 40; ++ph) {
        ArgsP a = (ArgsP)__builtin_amdgcn_kernarg_segment_ptr(); asm volatile("" : "+s"(a));
        unsigned char* ws = a->ws; float* out = a->out;
        float* ssq = (float*)(ws + WS_SSQ);
        bf16_t* xb = (bf16_t*)(ws + WS_XB);
        bf16_t* r1a = (bf16_t*)(ws + WS_R1A); bf16_t* r1b = (bf16_t*)(ws + WS_R1B); bf16_t* r2 = (bf16_t*)(ws + WS_R2); bf16_t* r3 = (bf16_t*)(ws + WS_R3);
        bf16_t* kmat = (bf16_t*)(ws + WS_R4); bf16_t* vtm = (bf16_t*)(ws + WS_R4 + 6 * MiB);
        float* psum = (float*)(ws + WS_PSUM);
#ifdef DBG_SCAN
        if (ph == 40) { const int fl = *(volatile int*)(ws + WS_FLAG); const float cval = fl < 0 ? 0.f : sqrtf((float)(100 - fl));
            for (size_t i = (size_t)blockIdx.x * 512 + otid(); i < (size_t)T_ALL * DM; i += (size_t)gridDim.x * 512) out[i] = cval; break; }
#else
        if (ph == 40) { phase_final(a, ssq + (size_t)6 * T_ALL); break; }
#endif
        const int l = ph / 20, st = ph % 20;
        const float* rin0 = l == 0 ? a->in[I_XP] : out; const float* rin1 = l == 0 ? a->in[I_XS] : out + (size_t)TP * DM;
        float* ssq_in = ssq + (size_t)(3 * l) * T_ALL; float* ssq_a = ssq_in + T_ALL; float* ssq_m = ssq_a + T_ALL; float* ssq_n = ssq_m + T_ALL;
#ifndef PH_LIMIT
#define PH_LIMIT 100
#endif
        const bool is_gemm = (st == 1 || st == 8 || (st >= 11 && st <= 19));
        if (ph >= PH_LIMIT) {}
        else if (st == 0) { if (l == 0) phase_prologue(a, lds); phase_wconv(a, l, lds); }
        else if (is_gemm) {
            const int ng = (st == 12) ? 3 : 1;
#pragma unroll 1
            for (int gi = 0; gi < ng; ++gi) {
                int nM = 128, nN = 4, mode = 0, lda = 1024, ldb = 1024, K = 1024, ks_shift = 30; size_t seg = 0;
                const void* A = xb; const void* B = ws + WS_WQ;
                const int half = (st >= 16) ? ((st - 16) >> 1) : 0;
                if (st == 1)       { nN = 6; B = ws + WS_WSSM; }
                else if (st == 8)  { nM = 6; nN = 128; A = ws + WS_WHY; B = xb; }
                else if (st == 11) { A = r1a; lda = 512; ks_shift = 3; seg = (size_t)(WS_R1B - WS_R1A); B = ws + WS_WOUT; }
                else if (st == 12) {
                    if (gi == 1)      { nM = 12; A = ws + WS_MEMB; B = ws + WS_WK; }
                    else if (gi == 2) { nM = 4; nN = 12; A = ws + WS_WV; B = ws + WS_MEMB; }
                }
                else if (st == 13) { mode = 1; K = 256; A = r1a; B = kmat; }
                else if (st == 14) { mode = 2; K = 256; A = r2; B = vtm; ldb = 3072; }
                else if (st == 15) { A = r1a; B = ws + WS_WO; }
                else if (st == 16 || st == 18) { nM = 64; nN = 16; A = xb + (size_t)half * TP * DM; B = ws + WS_WUP; }
                else               { nM = 64; A = r1a; lda = 4096; ldb = 4096; K = 4096; B = ws + WS_WDOWN; }
                pg8::Sched S; S.init(nM, nN, mode, A, lda, B, ldb);
                const pg8::Gemm g{lda, ldb, K, ks_shift, seg};
                const bool resid = (st == 11 || st == 15 || st == 17 || st == 19);
                if (!resid) { const EpiT<0> EK{st, gi, l, ws, out, a}; pg8::gemm_phase(lds, g, S, EK); } else { const EpiT<1> EK{st, gi, l, ws, out, a}; pg8::gemm_phase(lds, g, S, EK); }
            }
            if (st == 1) phase_dt(a, l, rin0, rin1);
            if (st == 8) phase_ssm_norm(a, l, r1b);
        }
        else if (st == 2 || st == 5) phase_s1(a, l, st == 2 ? 0 : 128, lds, r2, r3, r1a);
        else if (st == 3 || st == 6) phase_s2(a, st == 3 ? 0 : 128, r1a);
        else if (st == 4 || st == 7) phase_s3(a, l, st == 4 ? 0 : 128, lds, r2, r3, r1a, r1b);
        else if (st == 9) phase_hyena_conv(a, l, lds, r1a, r3);
        else if (st == 10) phase_hyena_norm(a, l, lds, r2, r3, r1a);
        if (ph == 0) grid.sync(); else xcd_barrier((unsigned*)(ws + WS_BAR), xst);
#ifdef DBG_SCAN
#if !defined(S3_PROBE) && !defined(S3_PROBE2)
        dbg_scan(ws, out, ph); grid.sync();
#endif
#endif
    }
}

#include <cstdio>
extern "C" void kernel_launch(void* const* d_in, const int* in_sizes, int n_in, void* d_out, int out_size, void* d_ws, size_t ws_size, hipStream_t stream) {
    static int grid = 0;
    if (grid == 0) {
        int dev = 0, cus = 0, per_cu = 0;
        if (n_in != 33 || ws_size < WS_END || out_size != T_ALL * DM) { fprintf(stderr, "kernel_launch: unexpected shapes (n_in %d, ws %zu, out %d)\n", n_in, ws_size, out_size); grid = -1; return; }
        (void)hipGetDevice(&dev); (void)hipDeviceGetAttribute(&cus, hipDeviceAttributeMultiprocessorCount, dev);
        if (hipFuncSetAttribute((const void*)mega_fwd, hipFuncAttributeMaxDynamicSharedMemorySize, LDS_BYTES) != hipSuccess) { fprintf(stderr, "kernel_launch: hipFuncSetAttribute failed\n"); grid = -1; return; }
        if (hipOccupancyMaxActiveBlocksPerMultiprocessor(&per_cu, (const void*)mega_fwd, 512, LDS_BYTES) != hipSuccess || per_cu < 1) { fprintf(stderr, "kernel_launch: occupancy query gives %d\n", per_cu); (void)hipGetLastError(); grid = -1; return; }
        grid = cus;
    }
    if (grid < 0) return;
#ifdef DBG_SCAN
    (void)hipMemsetAsync(d_ws, 0xAA, WS_END, stream); (void)hipMemsetAsync(d_out, 0xAA, (size_t)T_ALL * DM * 4, stream);
#endif
    (void)hipMemsetAsync((unsigned char*)d_ws + WS_BAR, 0, XCD_BAR_WORDS * 4, stream);
    Args a{};
    for (int i = 0; i < 33; ++i) a.in[i] = (const float*)d_in[i];
    a.out = (float*)d_out; a.ws = (unsigned char*)d_ws;
    void* args[] = {&a};
    hipError_t e = hipLaunchCooperativeKernel((const void*)mega_fwd, dim3(grid), dim3(512), args, LDS_BYTES, stream);
    if (e != hipSuccess) fprintf(stderr, "cooperative launch failed: %s (grid %d)\n", hipGetErrorString(e), grid);
}
```

```cpp
#include <hip/hip_runtime.h>
#include <hip/hip_cooperative_groups.h>
namespace cg = cooperative_groups;

#define LAS __attribute__((address_space(3)))
typedef unsigned short bf16_t;
typedef short bf16x8 __attribute__((ext_vector_type(8)));
typedef float f32x4 __attribute__((ext_vector_type(4)));
typedef float f32x2 __attribute__((ext_vector_type(2)));
typedef unsigned u32x4 __attribute__((ext_vector_type(4)));
typedef unsigned u32x2 __attribute__((ext_vector_type(2)));

constexpr int T_ALL = 32768, TP = 16384, DM = 1024;
constexpr float EPS = 1e-5f;
constexpr size_t MiB = 1048576;
constexpr size_t WS_WHY = 0 * MiB, WS_WSSM = 3 * MiB, WS_WOUT = 6 * MiB, WS_WQ = 8 * MiB, WS_WK = 10 * MiB, WS_WV = 12 * MiB, WS_WO = 14 * MiB, WS_WUP = 16 * MiB, WS_WDOWN = 24 * MiB;
constexpr size_t WS_XB = 32 * MiB, WS_MEMB = 96 * MiB, WS_SSQ = 102 * MiB, WS_H2 = 103 * MiB, WS_TW = 106 * MiB, WS_WDT = 106 * MiB + 65536, WS_DECAY = 106 * MiB + 131072;
constexpr size_t WS_DT = 107 * MiB, WS_PSUM = 109 * MiB, WS_R1A = 111 * MiB, WS_R1B = 143 * MiB, WS_R2 = 175 * MiB, WS_R3 = 207 * MiB, WS_R4 = 239 * MiB, WS_END = 263 * MiB;
constexpr int LDS_BYTES = 153600;

typedef __bf16 bf16x2v __attribute__((ext_vector_type(2)));
__device__ __forceinline__ unsigned pk2(float lo, float hi) { const f32x2 v = {lo, hi}; const bf16x2v b = __builtin_convertvector(v, bf16x2v); return __builtin_bit_cast(unsigned, b); }
__device__ __forceinline__ float bflo(unsigned u) { return __uint_as_float(u << 16); }
__device__ __forceinline__ float bfhi(unsigned u) { return __uint_as_float(u & 0xffff0000u); }
__device__ __forceinline__ float bf2f(bf16_t b) { return __uint_as_float(((unsigned)b) << 16); }
__device__ __forceinline__ float wave_sum(float v) {
#pragma unroll
    for (int o = 32; o >= 1; o >>= 1) v += __shfl_xor(v, o);
    return v;
}
__device__ __forceinline__ int otid() { int t = (int)threadIdx.x; asm volatile("" : "+v"(t)); return t; }
constexpr float SSQ_SCALE = 4096.0f;
__device__ __forceinline__ float ssq_ld(const float* p) { return (float)__float_as_uint(*p) * (1.0f / SSQ_SCALE); }
__device__ __forceinline__ unsigned ssq_fx(float s) { return (unsigned)(s * SSQ_SCALE + 0.5f); }
#define LDS_WAIT() asm volatile("s_waitcnt lgkmcnt(0)" ::: "memory")

namespace pg8 {
constexpr int BM = 256, BK = 64, HALF = 128, HTB = HALF * BK * 2, STAGE_BYTES = 8 * HTB, NXCD = 8, WGM = 8;
__host__ __device__ __forceinline__ int lds_byte(int r, int c) { const int st = (r >> 4) * 2 + (c >> 5), rr = r & 15, cc = c & 31, ob = rr * 64 + cc * 2; return st * 1024 + (ob ^ (((ob >> 9) & 1) << 5)); }
__host__ __device__ __forceinline__ void stage_rc(int b, int& R, int& C) { const int st = b / 1024, sb = b % 1024, swz = sb ^ (((sb >> 9) & 1) << 5); R = (st >> 1) * 16 + swz / 64; C = (st & 1) * 32 + (swz % 64) / 2; }
__host__ __device__ __forceinline__ int perm32(int rho) { const int n = rho >> 4, i = rho & 15; return 8 * (i >> 2) + 4 * n + (i & 3); }
struct Unit { int pm, pn; };
struct Gemm { int lda, ldb, K, ks_shift; size_t seg_bytes; };
__device__ __forceinline__ int seq_of_pm(int pm) { return pm < 64 ? (pm >> 3) : 8 + ((pm - 64) >> 4); }
struct Sched {
    int nM, nN, nwg, G, c, mode;
    const char* A; const char* B; const char* A2; const char* B2; int lda, ldb;
    __device__ void init(int nM_, int nN_, int mode_, const void* A_, int lda_, const void* B_, int ldb_) { nM = nM_; nN = nN_; nwg = nM * nN; G = (int)gridDim.x; c = (int)blockIdx.x; mode = mode_; A = (const char*)A_; B = (const char*)B_; A2 = A; B2 = B; lda = lda_; ldb = ldb_; }
    __device__ bool next(int i, Unit& u) const {
        const long L = (long)i * G + c; if (L >= nwg) return false;
        if (mode == 3) { if (L < 48) { u.pm = (int)(L % 12); u.pn = (int)(L / 12); } else { const int r = (int)L - 48; u.pm = 64 + (r & 3); u.pn = r >> 2; } return true; }
        int wgid = (int)L; { const int q = nwg / NXCD, r = nwg % NXCD, xcd = wgid % NXCD, off = wgid / NXCD; wgid = (xcd < r ? xcd * (q + 1) : r * (q + 1) + (xcd - r) * q) + off; }
        const int nig = WGM * nN, gid = wgid / nig, fm = gid * WGM, gsz = (nM - fm) < WGM ? (nM - fm) : WGM;
        u.pm = fm + ((wgid % nig) % gsz); u.pn = (wgid % nig) / gsz; return true;
    }
    __device__ __forceinline__ const char* abase(const Unit& u) const {
        if (mode == 0) return A + (size_t)u.pm * 256 * lda * 2;
        if (mode == 3) return (u.pm < 64 ? A : A2) + (size_t)(u.pm & 63) * 256 * lda * 2;
        return A + ((size_t)u.pm * 256 * lda + (size_t)u.pn * 256) * 2;
    }
    __device__ __forceinline__ const char* bbase(const Unit& u) const {
        if (mode == 0) return B + (size_t)u.pn * 256 * ldb * 2;
        if (mode == 3) return (u.pm < 64 ? B : B2) + (size_t)u.pn * 256 * ldb * 2;
        if (mode == 1) return B + ((size_t)seq_of_pm(u.pm) * 256 * ldb + (size_t)u.pn * 256) * 2;
        return B + ((size_t)u.pn * 256 * ldb + (size_t)seq_of_pm(u.pm) * 256) * 2;
    }
};

template <class Epi>
__device__ __forceinline__ void gemm_phase(LAS unsigned char* lds, const Gemm g, const Sched& S, const Epi& E) {
    const int tid = otid(), wid = __builtin_amdgcn_readfirstlane(tid >> 6), lane = tid & 63, wr = wid >> 2, wc = wid & 3, fr = lane & 15, fq = lane >> 4;
    const int nt = g.K / BK;
    unsigned voffA[2], voffB[2];
#pragma unroll
    for (int i = 0; i < 2; ++i) { int R, C; stage_rc(tid * 16 + i * 8192, R, C); const int Rb = Epi::PERM ? ((R & ~31) + perm32(R & 31)) : R;
        voffA[i] = (unsigned)(R * g.lda + C) * 2u; voffB[i] = (unsigned)(Rb * g.ldb + C) * 2u; }
    const size_t kstep = (size_t)(BK * 2);
    const size_t hstepA = (size_t)HALF * g.lda * 2, hstepB = (size_t)HALF * g.ldb * 2;
    const int ksm = (1 << g.ks_shift) - 1;
#define PG8_AKT(p, t) ((p) + (size_t)((t) >> g.ks_shift) * g.seg_bytes + (size_t)((t) & ksm) * kstep)
    const unsigned ldsw = (unsigned)wid * 1024u;
    const int aoff = lds_byte(wr * 64 + fr, fq * 8), boff = lds_byte(wc * 32 + fr, fq * 8);
#define PG8_SA(b, h) (((b) * 2 + (h)) * HTB)
#define PG8_SB(b, h) ((4 + (b) * 2 + (h)) * HTB)
#define PG8_STAGE(bufoff, gbase, voff) do { _Pragma("unroll") for (int _i = 0; _i < 2; ++_i) \
        __builtin_amdgcn_global_load_lds((const unsigned*)((const char*)(gbase) + (voff)[_i]), (LAS unsigned*)(lds + (bufoff) + ldsw + _i * 8192), 16, 0, 0); } while (0)
#define PG8_LDA(dst, b, h) do { _Pragma("unroll") for (int m = 0; m < 4; ++m) _Pragma("unroll") for (int k = 0; k < 2; ++k) dst[m][k] = *(const LAS bf16x8*)(lds + PG8_SA(b, h) + aoff + m * 2048 + k * 1024); } while (0)
#define PG8_LDB(dst, b, h) do { _Pragma("unroll") for (int n = 0; n < 2; ++n) _Pragma("unroll") for (int k = 0; k < 2; ++k) dst[n][k] = *(const LAS bf16x8*)(lds + PG8_SB(b, h) + boff + n * 2048 + k * 1024); } while (0)
#define PG8_MMA(ai, bj, At, Bt) do { __builtin_amdgcn_s_setprio(1); _Pragma("unroll") for (int m = 0; m < 4; ++m) _Pragma("unroll") for (int n = 0; n < 2; ++n) _Pragma("unroll") for (int k = 0; k < 2; ++k) \
        acc[ai][bj][m][n] = __builtin_amdgcn_mfma_f32_16x16x32_bf16(Bt[n][k], At[m][k], acc[ai][bj][m][n], 0, 0, 0); __builtin_amdgcn_s_setprio(0); } while (0)
#define PG8_WAIT_V(n) asm volatile("s_waitcnt vmcnt(" #n ")" ::: "memory")
#define PG8_WAIT_L(n) asm volatile("s_waitcnt lgkmcnt(" #n ")" ::: "memory")
#define PG8_BAR __builtin_amdgcn_s_barrier()
#define PG8_SCHED __builtin_amdgcn_sched_barrier(0)
    Unit cur, nxt; int ui = 0;
    if (!S.next(0, cur)) return;
    f32x4 acc[2][2][4][2];
#pragma unroll
    for (int a = 0; a < 2; ++a)
#pragma unroll
        for (int b = 0; b < 2; ++b)
#pragma unroll
            for (int m = 0; m < 4; ++m)
#pragma unroll
                for (int n = 0; n < 2; ++n) acc[a][b][m][n] = (f32x4){0.f, 0.f, 0.f, 0.f};
    bf16x8 At[4][2], B0[2][2], B1[2][2];
    const char* cA = S.abase(cur); const char* cB = S.bbase(cur);
    PG8_STAGE(PG8_SB(0, 0), cB, voffB); PG8_STAGE(PG8_SA(0, 0), cA, voffA); PG8_STAGE(PG8_SB(0, 1), cB + hstepB, voffB); PG8_STAGE(PG8_SA(0, 1), cA + hstepA, voffA);
    if (wr == 1) PG8_BAR;
    PG8_WAIT_V(4); PG8_BAR;
    PG8_STAGE(PG8_SB(1, 0), cB + kstep, voffB); PG8_STAGE(PG8_SA(1, 0), PG8_AKT(cA, 1), voffA); PG8_STAGE(PG8_SB(1, 1), cB + hstepB + kstep, voffB);
    PG8_WAIT_V(6); PG8_BAR;
    for (;;) {
        const bool has_next = S.next(ui + 1, nxt);
        const char* nA = has_next ? S.abase(nxt) : cA; const char* nB = has_next ? S.bbase(nxt) : cB;
        for (int t = 0; t < nt; t += 2) {
            const bool last = (t == nt - 2);
            const char* a1 = PG8_AKT(cA, t + 1);
            const char* a2 = last ? nA : PG8_AKT(cA, t + 2); const char* b2 = last ? nB : cB + (size_t)(t + 2) * kstep;
            const char* a3 = last ? PG8_AKT(nA, 1) : PG8_AKT(cA, t + 3); const char* b3 = b2 + kstep;
            PG8_LDB(B0, 0, 0); PG8_SCHED; PG8_LDA(At, 0, 0); PG8_STAGE(PG8_SA(1, 1), a1 + hstepA, voffA);
            PG8_WAIT_L(8); PG8_BAR; PG8_WAIT_L(0); PG8_MMA(0, 0, At, B0); PG8_BAR; PG8_SCHED;
            PG8_LDB(B1, 0, 1); PG8_STAGE(PG8_SB(0, 0), b2, voffB);
            PG8_BAR; PG8_WAIT_L(0); PG8_MMA(0, 1, At, B1); PG8_BAR;
            PG8_LDA(At, 0, 1); PG8_STAGE(PG8_SA(0, 0), a2, voffA);
            PG8_BAR; PG8_WAIT_L(0); PG8_MMA(1, 0, At, B0); PG8_BAR; PG8_SCHED;
            PG8_STAGE(PG8_SB(0, 1), b2 + hstepB, voffB);
            PG8_WAIT_V(6); PG8_BAR; PG8_MMA(1, 1, At, B1); PG8_BAR;
            PG8_LDB(B0, 1, 0); PG8_SCHED; PG8_LDA(At, 1, 0); PG8_STAGE(PG8_SA(0, 1), a2 + hstepA, voffA);
            PG8_WAIT_L(8); PG8_BAR; PG8_WAIT_L(0); PG8_MMA(0, 0, At, B0); PG8_BAR; PG8_SCHED;
            PG8_LDB(B1, 1, 1); PG8_STAGE(PG8_SB(1, 0), b3, voffB);
            PG8_BAR; PG8_WAIT_L(0); PG8_MMA(0, 1, At, B1); PG8_BAR;
            PG8_LDA(At, 1, 1); PG8_STAGE(PG8_SA(1, 0), a3, voffA);
            PG8_BAR; PG8_WAIT_L(0); PG8_MMA(1, 0, At, B0); PG8_BAR; PG8_SCHED;
            PG8_STAGE(PG8_SB(1, 1), b3 + hstepB, voffB);
            PG8_WAIT_V(6); PG8_BAR; PG8_MMA(1, 1, At, B1); PG8_BAR;
        }
        E(acc, cur, wr, wc, fr, fq);
        if (!has_next) break;
#pragma unroll
        for (int a = 0; a < 2; ++a)
#pragma unroll
            for (int b = 0; b < 2; ++b)
#pragma unroll
                for (int m = 0; m < 4; ++m)
#pragma unroll
                    for (int n = 0; n < 2; ++n) acc[a][b][m][n] = (f32x4){0.f, 0.f, 0.f, 0.f};
        cur = nxt; cA = nA; cB = nB; ++ui;
    }
    PG8_WAIT_V(0);
    if (wr == 0) PG8_BAR;
    PG8_BAR;
#undef PG8_AKT
#undef PG8_SA
#undef PG8_SB
#undef PG8_STAGE
#undef PG8_LDA
#undef PG8_LDB
#undef PG8_MMA
#undef PG8_WAIT_V
#undef PG8_WAIT_L
#undef PG8_BAR
#undef PG8_SCHED
}
}
struct Epi {
    int kind;
    static constexpr bool PERM = true;
    bf16_t* O0; long long d1, d2; int ldc; int csplit, rsplit;
    const float* ssq; float* psum; int row_off; int SCALE, ACT;
    __device__ __forceinline__ void bf_path(const f32x4 (&acc)[2][2][4][2], const pg8::Unit& u, int wr, int wc, int fr, int fq) const {
        int pm = u.pm, pn = u.pn, ai_ = 0;
        if (csplit) { ai_ = pn / csplit; pn = pn % csplit; }
        if (rsplit) { ai_ = pm / rsplit; pm = pm % rsplit; }
        bf16_t* base = O0 + (ai_ >= 1 ? d1 : 0ll) + (ai_ >= 2 ? d2 : 0ll);
        const int lrow0 = pm * 256 + wr * 64 + fr, grow0 = u.pm * 256 + wr * 64 + fr, lcol0 = pn * 256 + wc * 32 + 8 * fq, gcol0 = u.pn * 256 + wc * 32 + 8 * fq;
        f32x4 cs[2][2];
        if (SCALE == 2) {
#pragma unroll
            for (int bj = 0; bj < 2; ++bj)
#pragma unroll
                for (int n = 0; n < 2; ++n) { const u32x4 qu = *(const u32x4*)(ssq + gcol0 + bj * 128 + 4 * n); f32x4 q;
#pragma unroll
                    for (int j = 0; j < 4; ++j) q[j] = rsqrtf((float)qu[j] * (1.0f / SSQ_SCALE) * (1.0f / 1024.0f) + EPS);
                    cs[bj][n] = q; }
        }
        float rsv[2][4];
#pragma unroll
        for (int ai = 0; ai < 2; ++ai)
#pragma unroll
            for (int m = 0; m < 4; ++m) { const int grow = grow0 + ai * 128 + m * 16; float rs = 1.0f;
                if (SCALE == 1) rs = rsqrtf(ssq_ld(ssq + grow + row_off) * (1.0f / 1024.0f) + EPS);
                if (SCALE == 3) { const f32x4 q = *(const f32x4*)(psum + ((size_t)grow * 4 + u.pn) * 4); rs = __builtin_amdgcn_rcpf((q[0] + q[1]) + (q[2] + q[3])); }
                rsv[ai][m] = rs; }
#pragma unroll
        for (int ai = 0; ai < 2; ++ai)
#pragma unroll
            for (int m = 0; m < 4; ++m) {
                const int grow = grow0 + ai * 128 + m * 16;
                const float rs = rsv[ai][m];
                bf16_t* rowp = base + (size_t)(lrow0 + ai * 128 + m * 16) * ldc + lcol0;
                float psacc = 0.f;
#pragma unroll
                for (int bj = 0; bj < 2; ++bj) {
                    f32x4 v0 = acc[ai][bj][m][0], v1 = acc[ai][bj][m][1];
                    if (SCALE == 1 || SCALE == 3) { v0 = v0 * rs; v1 = v1 * rs; }
                    if (SCALE == 2) { v0 = v0 * cs[bj][0]; v1 = v1 * cs[bj][1]; }
                    if (ACT == 1) {
#pragma unroll
                        for (int j = 0; j < 4; ++j) { const float a0 = fmaxf(v0[j], 0.f), a1 = fmaxf(v1[j], 0.f); v0[j] = a0 * a0; v1[j] = a1 * a1; } }
                    if (ACT == 2) {
#pragma unroll
                        for (int j = 0; j < 4; ++j) { v0[j] = __expf(v0[j]); v1[j] = __expf(v1[j]); }
                        psacc += ((v0[0] + v0[1]) + (v0[2] + v0[3])) + ((v1[0] + v1[1]) + (v1[2] + v1[3])); }
                    u32x4 w; w.x = pk2(v0[0], v0[1]); w.y = pk2(v0[2], v0[3]); w.z = pk2(v1[0], v1[1]); w.w = pk2(v1[2], v1[3]);
                    *(u32x4*)(rowp + bj * 128) = w;
                }
                if (ACT == 2) { psacc += __shfl_xor(psacc, 16); psacc += __shfl_xor(psacc, 32); if (fq == 0) psum[((size_t)grow * 4 + u.pn) * 4 + wc] = psacc; }
            }
    }
    float* X; const float* rin0; const float* rin1; bf16_t* xb; float* ssq_out; int rin_bf16, write_x, write_xb;
    __device__ __forceinline__ void operator()(const f32x4 (&acc)[2][2][4][2], const pg8::Unit& u, int wr, int wc, int fr, int fq) const {
        if (kind == 0) bf_path(acc, u, wr, wc, fr, fq); else res_path(acc, u, wr, wc, fr, fq);
    }
    __device__ __forceinline__ void res_path(const f32x4 (&acc)[2][2][4][2], const pg8::Unit& u, int wr, int wc, int fr, int fq) const {
        const int row0 = u.pm * 256 + wr * 64 + fr + row_off, col0 = u.pn * 256 + wc * 32 + 8 * fq;
#pragma unroll
        for (int ai = 0; ai < 2; ++ai) {
            f32x4 rr[4][2][2];
#pragma unroll
            for (int m = 0; m < 4; ++m) { const int row = row0 + ai * 128 + m * 16;
                if (rin_bf16) {
                    const bf16_t* bq = xb + (size_t)row * DM + col0;
#pragma unroll
                    for (int bj = 0; bj < 2; ++bj) { const u32x4 q = *(const u32x4*)(bq + bj * 128);
                        rr[m][bj][0] = (f32x4){bflo(q.x), bfhi(q.x), bflo(q.y), bfhi(q.y)}; rr[m][bj][1] = (f32x4){bflo(q.z), bfhi(q.z), bflo(q.w), bfhi(q.w)}; }
                } else {
                    const float* rp = (row < TP ? rin0 + (size_t)row * DM : rin1 + (size_t)(row - TP) * DM) + col0;
#pragma unroll
                    for (int bj = 0; bj < 2; ++bj) { rr[m][bj][0] = *(const f32x4*)(rp + bj * 128); rr[m][bj][1] = *(const f32x4*)(rp + bj * 128 + 4); } } }
#pragma unroll
            for (int m = 0; m < 4; ++m) {
                const int row = row0 + ai * 128 + m * 16;
                float* xp = X + (size_t)row * DM + col0; bf16_t* bp = xb + (size_t)row * DM + col0;
                float sq = 0.f;
#pragma unroll
                for (int bj = 0; bj < 2; ++bj) {
                    const f32x4 v0 = acc[ai][bj][m][0] + rr[m][bj][0], v1 = acc[ai][bj][m][1] + rr[m][bj][1];
                    if (write_x) { *(f32x4*)(xp + bj * 128) = v0; *(f32x4*)(xp + bj * 128 + 4) = v1; }
                    u32x4 w; w.x = pk2(v0[0], v0[1]); w.y = pk2(v0[2], v0[3]); w.z = pk2(v1[0], v1[1]); w.w = pk2(v1[2], v1[3]);
                    if (write_xb) *(u32x4*)(bp + bj * 128) = w;
                    sq += ((v0[0] * v0[0] + v0[1] * v0[1]) + (v0[2] * v0[2] + v0[3] * v0[3])) + ((v1[0] * v1[0] + v1[1] * v1[1]) + (v1[2] * v1[2] + v1[3] * v1[3]));
                }
                sq += __shfl_xor(sq, 16); sq += __shfl_xor(sq, 32);
                if (fq == 0) atomicAdd((unsigned*)(ssq_out + row), ssq_fx(sq));
            }
        }
    }
};

struct Args { const float* in[33]; float* out; unsigned char* ws; };
typedef const __attribute__((address_space(4))) Args* ArgsP;
enum { I_XP = 0, I_XS, I_MP, I_MS, I_NMIX, I_WIN, I_HCW, I_HCB, I_FW1, I_FB1, I_FW2, I_FB2, I_FW3, I_FB3, I_FREQ, I_HBIAS, I_HNORM, I_SCW, I_SCB, I_DTB, I_ALOG, I_SD, I_SNORM,
       I_WOUT, I_NXA, I_NMEM, I_WQ, I_WKV, I_WO, I_NMLP, I_WUP, I_WDOWN, I_NFIN };

__device__ __forceinline__ void transpose_item(const float* W, int K, int N, bf16_t* WT, int n0, int k0, int dst_row0, const float* ksc, float gs, LAS float* scr, int lane) {
#pragma unroll 32
    for (int kk = 0; kk < 64; ++kk) { float v = W[(size_t)(k0 + kk) * N + n0 + lane] * gs; if (ksc) v *= ksc[k0 + kk]; scr[kk * 65 + lane] = v; }
    LDS_WAIT();
    const int c = lane & 7;
#pragma unroll
    for (int j = 0; j < 8; ++j) { const int n = (lane >> 3) + 8 * j; const LAS float* sp = scr + (8 * c) * 65 + n;
        u32x4 o; o.x = pk2(sp[0 * 65], sp[1 * 65]); o.y = pk2(sp[2 * 65], sp[3 * 65]); o.z = pk2(sp[4 * 65], sp[5 * 65]); o.w = pk2(sp[6 * 65], sp[7 * 65]);
        *(u32x4*)(WT + (size_t)(dst_row0 + n) * K + k0 + 8 * c) = o; }
    LDS_WAIT();
}
__device__ __forceinline__ void phase_wconv(ArgsP a, int l, LAS unsigned char* lds) {
    const int lane = otid() & 63, wave = otid() >> 6, gw = blockIdx.x * 8 + wave, NGW = gridDim.x * 8;
    LAS float* scr = (LAS float*)(lds + wave * 16896);
    unsigned char* ws = a->ws;
    constexpr int I_IN = 16 * 48, I_OUT = 16 * 16, I_Q = 16 * 16, I_KV = 16 * 32, I_O = 16 * 16, I_UP = 16 * 64, I_DN = 64 * 16;
    constexpr int NIT = I_IN + I_OUT + I_Q + I_KV + I_O + I_UP + I_DN;
    for (int it = gw; it < NIT; it += NGW) {
        int r = it;
        if (r < I_IN) { const int kb = r / 48, nb = r % 48, n0 = nb * 64;
            if (n0 < 1536) transpose_item(a->in[I_WIN] + (size_t)l * 1024 * 3088, 1024, 3088, (bf16_t*)(ws + WS_WHY), n0, kb * 64, n0, a->in[I_NMIX] + l * 1024, 1.f, scr, lane);
            else transpose_item(a->in[I_WIN] + (size_t)l * 1024 * 3088, 1024, 3088, (bf16_t*)(ws + WS_WSSM), n0, kb * 64, n0 - 1536, a->in[I_NMIX] + l * 1024, 1.f, scr, lane);
            continue; } r -= I_IN;
        if (r < I_OUT) { const int kb = r / 16, nb = r % 16; transpose_item(a->in[I_WOUT] + (size_t)l * 1024 * 1024, 1024, 1024, (bf16_t*)(ws + WS_WOUT), nb * 64, kb * 64, nb * 64, nullptr, 1.f, scr, lane); continue; } r -= I_OUT;
        if (r < I_Q) { const int kb = r / 16, nb = r % 16; transpose_item(a->in[I_WQ] + (size_t)l * 1024 * 1024, 1024, 1024, (bf16_t*)(ws + WS_WQ), nb * 64, kb * 64, nb * 64, a->in[I_NXA] + l * 1024, 0.0625f, scr, lane); continue; } r -= I_Q;
        if (r < I_KV) { const int kb = r / 32, nb = r % 32, n0 = nb * 64;
            if (n0 < 1024) transpose_item(a->in[I_WKV] + (size_t)l * 1024 * 2048, 1024, 2048, (bf16_t*)(ws + WS_WK), n0, kb * 64, n0, a->in[I_NMEM] + l * 1024, 1.f, scr, lane);
            else transpose_item(a->in[I_WKV] + (size_t)l * 1024 * 2048, 1024, 2048, (bf16_t*)(ws + WS_WV), n0, kb * 64, n0 - 1024, a->in[I_NMEM] + l * 1024, 1.f, scr, lane);
            continue; } r -= I_KV;
        if (r < I_O) { const int kb = r / 16, nb = r % 16; transpose_item(a->in[I_WO] + (size_t)l * 1024 * 1024, 1024, 1024, (bf16_t*)(ws + WS_WO), nb * 64, kb * 64, nb * 64, nullptr, 1.f, scr, lane); continue; } r -= I_O;
        if (r < I_UP) { const int kb = r / 64, nb = r % 64; transpose_item(a->in[I_WUP] + (size_t)l * 1024 * 4096, 1024, 4096, (bf16_t*)(ws + WS_WUP), nb * 64, kb * 64, nb * 64, a->in[I_NMLP] + l * 1024, 1.f, scr, lane); continue; } r -= I_UP;
        { const int kb = r / 16, nb = r % 16; transpose_item(a->in[I_WDOWN] + (size_t)l * 4096 * 1024, 4096, 1024, (bf16_t*)(ws + WS_WDOWN), nb * 64, kb * 64, nb * 64, nullptr, 1.f, scr, lane); }
    }
    bf16_t* wdt = (bf16_t*)(ws + WS_WDT);
    for (int i = blockIdx.x * 512 + otid(); i < 16 * 512; i += gridDim.x * 512) { const int j = i >> 9, k = (i & 511) * 2;
        const float v0 = a->in[I_NMIX][l * 1024 + k] * a->in[I_WIN][((size_t)l * 1024 + k) * 3088 + 3072 + j], v1 = a->in[I_NMIX][l * 1024 + k + 1] * a->in[I_WIN][((size_t)l * 1024 + k + 1) * 3088 + 3072 + j];
        *(unsigned*)(wdt + j * 1024 + k) = pk2(v0, v1); }
}
__device__ __forceinline__ const float* xin_row(ArgsP a, int t) { return t < TP ? a->in[I_XP] + (size_t)t * DM : a->in[I_XS] + (size_t)(t - TP) * DM; }

__device__ __forceinline__ void phase_prologue(ArgsP a, LAS unsigned char* lds) {
    const int lane = otid() & 63, wave = otid() >> 6, gw = blockIdx.x * 8 + wave, NGW = gridDim.x * 8;
    unsigned char* ws = a->ws;
    float* ssq = (float*)(ws + WS_SSQ);
    for (int i = blockIdx.x * 512 + otid(); i < 6 * T_ALL; i += gridDim.x * 512) ssq[T_ALL + i] = 0.f;
    { f32x2* tw = (f32x2*)(ws + WS_TW); for (int i = blockIdx.x * 512 + otid(); i < 4096; i += gridDim.x * 512) { float s, c; sincospif(-(float)i * (1.0f / 4096.0f), &s, &c); tw[i] = (f32x2){c, s}; } }
    bf16_t* xb = (bf16_t*)(ws + WS_XB);
    for (int t = gw; t < T_ALL; t += 2 * NGW) {
        f32x4 v[2][4];
#pragma unroll
        for (int r = 0; r < 2; ++r) { const f32x4* xr = (const f32x4*)xin_row(a, t + r * NGW) + lane;
#pragma unroll
            for (int j = 0; j < 4; ++j) v[r][j] = xr[64 * j]; }
#pragma unroll
        for (int r = 0; r < 2; ++r) { float s = 0.f; u32x2* o = (u32x2*)(xb + (size_t)(t + r * NGW) * DM) + lane;
#pragma unroll
            for (int j = 0; j < 4; ++j) { const f32x4 x = v[r][j]; s += (x[0] * x[0] + x[1] * x[1]) + (x[2] * x[2] + x[3] * x[3]); u32x2 w; w.x = pk2(x[0], x[1]); w.y = pk2(x[2], x[3]); o[64 * j] = w; }
            s = wave_sum(s); if (lane == 0) ssq[t + r * NGW] = __uint_as_float(ssq_fx(s)); }
    }
    bf16_t* memb = (bf16_t*)(ws + WS_MEMB);
    for (int t = gw; t < 3072; t += NGW) {
        const float* mr = t < 2048 ? a->in[I_MP] + (size_t)t * DM : a->in[I_MS] + (size_t)(t - 2048) * DM;
        const f32x4* xr = (const f32x4*)mr + lane; f32x4 v[4]; float s = 0.f;
#pragma unroll
        for (int j = 0; j < 4; ++j) { v[j] = xr[64 * j]; s += (v[j][0] * v[j][0] + v[j][1] * v[j][1]) + (v[j][2] * v[j][2] + v[j][3] * v[j][3]); }
        const float rs = rsqrtf(wave_sum(s) * (1.0f / 1024.0f) + EPS);
        u32x2* o = (u32x2*)(memb + (size_t)t * DM) + lane;
#pragma unroll
        for (int j = 0; j < 4; ++j) { u32x2 w; w.x = pk2(v[j][0] * rs, v[j][1] * rs); w.y = pk2(v[j][2] * rs, v[j][3] * rs); o[64 * j] = w; }
    }
    float* h2 = (float*)(ws + WS_H2);
    for (int idx = gw; idx < 2 * 6144; idx += NGW) {
        const int l = idx / 6144, r = idx % 6144, set = r >= 2048 ? 1 : 0, t = set ? r - 2048 : r, L = set ? 4096 : 2048;
        const float tl = (float)t / (float)(L - 1), w = (6.283185307179586f / (float)L) * (float)t;
        const float fm = 1e-4f + (float)(lane & 15) * ((15.0f - 1e-4f) / 15.0f);
        float sv, cv; sincosf(fm * w, &sv, &cv);
        const float* fw1 = a->in[I_FW1] + l * 33 * 64; const float* fw2 = a->in[I_FW2] + l * 64 * 64;
        float acc = a->in[I_FB1][l * 64 + lane] + tl * fw1[lane];
#pragma unroll
        for (int i = 0; i < 16; ++i) { acc += __shfl(cv, i) * fw1[(1 + i) * 64 + lane]; acc -= __shfl(sv, i) * fw1[(17 + i) * 64 + lane]; }
        const float fr = a->in[I_FREQ][l * 64 + lane];
        const float h1 = sinf(fr * acc);
        float acc2 = a->in[I_FB2][l * 64 + lane];
#pragma unroll 8
        for (int i = 0; i < 64; ++i) acc2 += __shfl(h1, i) * fw2[i * 64 + lane];
        h2[(size_t)idx * 64 + lane] = sinf(fr * acc2);
    }
}
__device__ __forceinline__ void phase_dt(ArgsP a, int l, const bf16_t* xb, const float* ssq_in) {
    const int tid = otid(), lane = tid & 63, wave = tid >> 6, gw = blockIdx.x * 8 + wave, NGW = gridDim.x * 8, fr = lane & 15, fq = lane >> 4;
    const bf16_t* wdt = (const bf16_t*)(a->ws + WS_WDT); float* dt = (float*)(a->ws + WS_DT);
    for (int tile = gw; tile < T_ALL / 16; tile += NGW) {
        const int t0 = tile * 16;
        const bf16_t* ap = xb + (size_t)(t0 + fr) * DM + fq * 8; const bf16_t* bp = wdt + fr * 1024 + fq * 8;
        f32x4 acc = {0.f, 0.f, 0.f, 0.f};
#pragma unroll 16
        for (int ks = 0; ks < 32; ++ks) acc = __builtin_amdgcn_mfma_f32_16x16x32_bf16(*(const bf16x8*)(ap + ks * 32), *(const bf16x8*)(bp + ks * 32), acc, 0, 0, 0);
        const float bias = a->in[I_DTB][l * 16 + fr];
#pragma unroll
        for (int r = 0; r < 4; ++r) { const int t = t0 + fq * 4 + r; const float x = acc[r] * rsqrtf(ssq_ld(ssq_in + t) * (1.0f / 1024.0f) + EPS) + bias; dt[(size_t)t * 16 + fr] = x > 20.f ? x : log1pf(expf(x)); }
    }
}
__device__ __forceinline__ void phase_final(ArgsP a, const float* ssq, const bf16_t* xb) {
    const int lane = otid() & 63, wave = otid() >> 6, gw = blockIdx.x * 8 + wave, NGW = gridDim.x * 8;
    f32x4 g[4];
#pragma unroll
    for (int j = 0; j < 4; ++j) g[j] = *((const f32x4*)(a->in[I_NFIN] + lane * 16) + j);
    for (int t = gw; t < T_ALL; t += 4 * NGW) {
        u32x4 q0[4], q1[4]; float rs[4];
#pragma unroll
        for (int r = 0; r < 4; ++r) { const int tr = t + r * NGW; rs[r] = rsqrtf(ssq_ld(ssq + tr) * (1.0f / 1024.0f) + EPS);
            const u32x4* xr = (const u32x4*)(xb + (size_t)tr * DM + lane * 16); q0[r] = xr[0]; q1[r] = xr[1]; }
#pragma unroll
        for (int r = 0; r < 4; ++r) { f32x4* orow = (f32x4*)(a->out + (size_t)(t + r * NGW) * DM + lane * 16);
            orow[0] = (f32x4){bflo(q0[r].x), bfhi(q0[r].x), bflo(q0[r].y), bfhi(q0[r].y)} * rs[r] * g[0];
            orow[1] = (f32x4){bflo(q0[r].z), bfhi(q0[r].z), bflo(q0[r].w), bfhi(q0[r].w)} * rs[r] * g[1];
            orow[2] = (f32x4){bflo(q1[r].x), bfhi(q1[r].x), bflo(q1[r].y), bfhi(q1[r].y)} * rs[r] * g[2];
            orow[3] = (f32x4){bflo(q1[r].z), bfhi(q1[r].z), bflo(q1[r].w), bfhi(q1[r].w)} * rs[r] * g[3]; }
    }
}
__device__ __forceinline__ void phase_ssm_norm(ArgsP a, int l, bf16_t* buf) {
    const int lane = otid() & 63, wave = otid() >> 6, gw = blockIdx.x * 8 + wave, NGW = gridDim.x * 8;
    const float* gn = a->in[I_SNORM] + l * 512 + lane * 8;
    float g[8];
#pragma unroll
    for (int j = 0; j < 8; ++j) g[j] = gn[j];
    for (int t = gw; t < T_ALL; t += 4 * NGW) {
        u32x4 wv[4];
#pragma unroll
        for (int q = 0; q < 4; ++q) wv[q] = *((const u32x4*)(buf + (size_t)(t + q * NGW) * 512) + lane);
#pragma unroll
        for (int q = 0; q < 4; ++q) { const u32x4 w = wv[q];
            float v[8] = {bflo(w.x), bfhi(w.x), bflo(w.y), bfhi(w.y), bflo(w.z), bfhi(w.z), bflo(w.w), bfhi(w.w)};
            float s = 0.f;
#pragma unroll
            for (int j = 0; j < 8; ++j) s += v[j] * v[j];
            const float rs = rsqrtf(wave_sum(s) * (1.0f / 512.0f) + EPS);
            u32x4 o; o.x = pk2(v[0] * rs * g[0], v[1] * rs * g[1]); o.y = pk2(v[2] * rs * g[2], v[3] * rs * g[3]); o.z = pk2(v[4] * rs * g[4], v[5] * rs * g[5]); o.w = pk2(v[6] * rs * g[6], v[7] * rs * g[7]);
            *((u32x4*)(buf + (size_t)(t + q * NGW) * 512) + lane) = o; }
    }
}
constexpr int SLD = 136;
__device__ __forceinline__ void seq_bounds(int t0, int& lo, int& hi) { if (t0 < TP) { lo = t0 & ~2047; hi = lo + 2048; } else { lo = TP + ((t0 - TP) & ~4095); hi = lo + 4096; } }
__device__ __forceinline__ float silu_f(float x) { return x * __builtin_amdgcn_rcpf(1.0f + __expf(-x)); }

template <int NC, bool TRANS>
__device__ __forceinline__ void load_conv_tile(const bf16_t* src, int ldsrc, int col0, int t0, int lo, int hi, const float* cw, const float* cbias, int ch0, LAS bf16_t* dst) {
    constexpr int CGS = NC / 8, RUNS = 512 / CGS, R = 128 / RUNS;
    const int tid = otid(), cgi = tid % CGS, run = tid / CGS, c = cgi * 8, r0 = run * R;
    float w[5][8], bb[8];
#pragma unroll
    for (int k = 0; k < 5; ++k) { const f32x4 a0 = *(const f32x4*)(cw + k * 1024 + ch0 + c), a1 = *(const f32x4*)(cw + k * 1024 + ch0 + c + 4);
#pragma unroll
        for (int e = 0; e < 4; ++e) { w[k][e] = a0[e]; w[k][4 + e] = a1[e]; } }
    { const f32x4 a0 = *(const f32x4*)(cbias + ch0 + c), a1 = *(const f32x4*)(cbias + ch0 + c + 4);
#pragma unroll
      for (int e = 0; e < 4; ++e) { bb[e] = a0[e]; bb[4 + e] = a1[e]; } }
    u32x4 raw[R + 4];
#pragma unroll
    for (int i = 0; i < R + 4; ++i) { const int t = t0 + r0 - 2 + i, tc = t < lo ? lo : (t >= hi ? hi - 1 : t);
        u32x4 q = *(const u32x4*)(src + (size_t)tc * ldsrc + col0 + c);
        if (t < lo || t >= hi) q = (u32x4){0u, 0u, 0u, 0u};
        raw[i] = q; }
    float win[5][8];
    auto cvrow = [&](const u32x4 q, float (&o)[8]) { o[0] = bflo(q.x); o[1] = bfhi(q.x); o[2] = bflo(q.y); o[3] = bfhi(q.y); o[4] = bflo(q.z); o[5] = bfhi(q.z); o[6] = bflo(q.w); o[7] = bfhi(q.w); };
#pragma unroll
    for (int i = 0; i < 4; ++i) cvrow(raw[i], win[i]);
    unsigned outp[8][R / 2];
#pragma unroll
    for (int rr = 0; rr < R; ++rr) {
        cvrow(raw[rr + 4], win[(rr + 4) % 5]);
        float o[8];
#pragma unroll
        for (int e = 0; e < 8; ++e) { float s = bb[e];
#pragma unroll
            for (int k = 0; k < 5; ++k) s += w[k][e] * win[(rr + k) % 5][e];
            o[e] = silu_f(s); }
        if (!TRANS) { u32x4 q; q.x = pk2(o[0], o[1]); q.y = pk2(o[2], o[3]); q.z = pk2(o[4], o[5]); q.w = pk2(o[6], o[7]); *(LAS u32x4*)(dst + (r0 + rr) * SLD + c) = q; }
        else {
#pragma unroll
            for (int e = 0; e < 8; ++e) { if (rr & 1) outp[e][rr >> 1] = (outp[e][rr >> 1] & 0xffffu) | (pk2(0.f, o[e]) & 0xffff0000u); else outp[e][rr >> 1] = pk2(o[e], 0.f) & 0xffffu; } }
    }
    if (TRANS) {
#pragma unroll
        for (int e = 0; e < 8; ++e) {
            if (R == 8) { u32x4 q; q.x = outp[e][0]; q.y = outp[e][1]; q.z = outp[e][2]; q.w = outp[e][R / 2 - 1]; *(LAS u32x4*)(dst + (c + e) * SLD + r0) = q; }
            else { u32x2 q; q.x = outp[e][0]; q.y = outp[e][R / 2 - 1]; *(LAS u32x2*)(dst + (c + e) * SLD + r0) = q; }
        }
    }
}
__device__ __forceinline__ void chunk_scan(const float* dt, int t0, int col, float A, int dir, int lane, float& d0, float& d1, float& c0, float& c1, float& total) {
    d0 = dt[(size_t)(t0 + 2 * lane) * 16 + col]; d1 = dt[(size_t)(t0 + 2 * lane + 1) * 16 + col];
    const float a0 = d0 * A, a1 = d1 * A;
    float v = a0 + a1;
#pragma unroll
    for (int d = 1; d < 64; d <<= 1) { const float tt = __shfl_up(v, d); if (lane >= d) v += tt; }
    total = __shfl(v, 63);
    const float p0 = v - a1, p1 = v;
    if (dir == 0) { c0 = p0; c1 = p1; } else { c0 = total - p0 + a0; c1 = total - p1 + a1; }
}
__device__ __forceinline__ bf16x8 scale_frag8(bf16x8 f, const float (&sc)[8]) {
    union { bf16x8 v; unsigned u[4]; } in, out; in.v = f;
#pragma unroll
    for (int j = 0; j < 4; ++j) out.u[j] = pk2(bflo(in.u[j]) * sc[2 * j], bfhi(in.u[j]) * sc[2 * j + 1]);
    return out.v;
}
__device__ __forceinline__ void phase_s1(ArgsP a, int l, int cbase, LAS unsigned char* lds, const bf16_t* xs_raw, const bf16_t* bc_raw, bf16_t* states) {
    const int tid = otid(), lane = tid & 63, wave = __builtin_amdgcn_readfirstlane(tid >> 6);
    LAS bf16_t* xsT = (LAS bf16_t*)lds;
    LAS bf16_t* BT = (LAS bf16_t*)(lds + 256 * SLD * 2);
    LAS float* sW = (LAS float*)(lds + 384 * SLD * 2);
    const float* dt = (const float*)(a->ws + WS_DT); float* decay = (float*)(a->ws + WS_DECAY);
    const float* cw = a->in[I_SCW] + l * 5 * 1024; const float* cbs = a->in[I_SCB] + l * 1024;
    for (int it = blockIdx.x; it < 256; it += gridDim.x) {
        const int gc = cbase + (it >> 1), g = it & 1, t0 = gc * 128; int lo, hi; seq_bounds(t0, lo, hi);
        const int hh = wave >> 1, dir = wave & 1, h8 = g * 4 + hh;
        { float d0, d1, c0, c1, tot; const float A = -__expf(a->in[I_ALOG][l * 16 + dir * 8 + h8]);
          chunk_scan(dt, t0, dir * 8 + h8, A, dir, lane, d0, d1, c0, c1, tot);
          sW[wave * 128 + 2 * lane] = d0 * __expf(tot - c0); sW[wave * 128 + 2 * lane + 1] = d1 * __expf(tot - c1);
          if (lane == 0) decay[gc * 16 + h8 * 2 + dir] = __expf(tot); }
        load_conv_tile<256, true>(xs_raw, 512, g * 256, t0, lo, hi, cw, cbs, g * 256, xsT);
        load_conv_tile<128, true>(bc_raw, 512, g * 128, t0, lo, hi, cw, cbs, 512 + g * 128, BT);
        __syncthreads();
        f32x4 acc[8][4];
#pragma unroll
        for (int i = 0; i < 8; ++i)
#pragma unroll
            for (int j = 0; j < 4; ++j) acc[i][j] = (f32x4){0.f, 0.f, 0.f, 0.f};
        const int fr = lane & 15, fq = lane >> 4;
#pragma unroll 1
        for (int ks = 0; ks < 4; ++ks) {
            const int s0 = ks * 32 + fq * 8;
            float sc[8]; { const f32x4 q0 = *(const LAS f32x4*)(sW + wave * 128 + s0), q1 = *(const LAS f32x4*)(sW + wave * 128 + s0 + 4);
#pragma unroll
                for (int e = 0; e < 4; ++e) { sc[e] = q0[e]; sc[4 + e] = q1[e]; } }
            bf16x8 xf[4];
#pragma unroll
            for (int pt = 0; pt < 4; ++pt) xf[pt] = scale_frag8(*(const LAS bf16x8*)(xsT + (hh * 64 + pt * 16 + fr) * SLD + s0), sc);
#pragma unroll
            for (int nt = 0; nt < 8; ++nt) { const bf16x8 bf = *(const LAS bf16x8*)(BT + (nt * 16 + fr) * SLD + s0);
#pragma unroll
                for (int pt = 0; pt < 4; ++pt) acc[nt][pt] = __builtin_amdgcn_mfma_f32_16x16x32_bf16(bf, xf[pt], acc[nt][pt], 0, 0, 0); }
        }
        bf16_t* st = states + ((size_t)((gc - cbase) * 8 + h8) * 2 + dir) * 8192;
#pragma unroll
        for (int nt = 0; nt < 8; ++nt)
#pragma unroll
            for (int pt = 0; pt < 4; ++pt) { u32x2 q; q.x = pk2(acc[nt][pt][0], acc[nt][pt][1]); q.y = pk2(acc[nt][pt][2], acc[nt][pt][3]); *(u32x2*)(st + (pt * 16 + fr) * 128 + nt * 16 + fq * 4) = q; }
        __syncthreads();
    }
}
__device__ __forceinline__ void phase_s2(ArgsP a, int cbase, bf16_t* states, int dry) {
    const int nseq = cbase == 0 ? 8 : 4, cps = cbase == 0 ? 16 : 32;
    const float* decay = (const float*)(a->ws + WS_DECAY);
    const int total = nseq * 16 * 1024;
    for (int i = blockIdx.x * 512 + otid(); i < total; i += gridDim.x * 512) {
        const int e8 = i & 1023, hd = (i >> 10) & 15, sq = i >> 14, dir = hd & 1;
        float hs[8];
#pragma unroll
        for (int j = 0; j < 8; ++j) hs[j] = 0.f;
#pragma unroll 1
        for (int cc0 = 0; cc0 < cps; cc0 += 8) {
            u32x4 w[8]; float dcv[8]; u32x4* pp[8];
#pragma unroll
            for (int u = 0; u < 8; ++u) { const int cc = cc0 + u, crel = sq * cps + (dir ? cps - 1 - cc : cc);
                pp[u] = (u32x4*)(states + ((size_t)crel * 16 + hd) * 8192) + e8; w[u] = *pp[u]; dcv[u] = decay[(cbase + crel) * 16 + hd]; }
#pragma unroll
            for (int u = 0; u < 8; ++u) { const float dc = dcv[u];
                u32x4 o; o.x = pk2(hs[0], hs[1]); o.y = pk2(hs[2], hs[3]); o.z = pk2(hs[4], hs[5]); o.w = pk2(hs[6], hs[7]); if (!dry) *pp[u] = o;
                hs[0] = hs[0] * dc + bflo(w[u].x); hs[1] = hs[1] * dc + bfhi(w[u].x); hs[2] = hs[2] * dc + bflo(w[u].y); hs[3] = hs[3] * dc + bfhi(w[u].y);
                hs[4] = hs[4] * dc + bflo(w[u].z); hs[5] = hs[5] * dc + bfhi(w[u].z); hs[6] = hs[6] * dc + bflo(w[u].w); hs[7] = hs[7] * dc + bfhi(w[u].w); }
        }
    }
}
__device__ __forceinline__ void phase_s3(ArgsP a, int l, int cbase, LAS unsigned char* lds, const bf16_t* xs_raw, const bf16_t* bc_raw, const bf16_t* states, bf16_t* gate, int dry) {
    const int tid = otid(), lane = tid & 63, wave = __builtin_amdgcn_readfirstlane(tid >> 6), fr = lane & 15, fq = lane >> 4;
    LAS bf16_t* xsT = (LAS bf16_t*)lds;
    LAS bf16_t* sC = (LAS bf16_t*)(lds + 128 * SLD * 2);
    LAS bf16_t* sB = (LAS bf16_t*)(lds + 256 * SLD * 2);
    LAS float* sDt = (LAS float*)(lds + 384 * SLD * 2);
    LAS float* sCs = sDt + 1024;
    const float* dt = (const float*)(a->ws + WS_DT);
    const float* cw = a->in[I_SCW] + l * 5 * 1024; const float* cbs = a->in[I_SCB] + l * 1024;
    for (int it = blockIdx.x; it < 256; it += gridDim.x) {
        const int gc = cbase + (it >> 1), g = it & 1, t0 = gc * 128; int lo, hi; seq_bounds(t0, lo, hi);
        { const int w4 = wave, hh4 = w4 >> 1, dir = w4 & 1, h8 = g * 4 + hh4; float d0, d1, c0, c1, tot; const float A = -__expf(a->in[I_ALOG][l * 16 + dir * 8 + h8]);
          chunk_scan(dt, t0, dir * 8 + h8, A, dir, lane, d0, d1, c0, c1, tot);
          { sDt[w4 * 128 + 2 * lane] = d0; sDt[w4 * 128 + 2 * lane + 1] = d1; sCs[w4 * 128 + 2 * lane] = c0; sCs[w4 * 128 + 2 * lane + 1] = c1; } }
        load_conv_tile<128, false>(bc_raw, 512, g * 128, t0, lo, hi, cw, cbs, 512 + g * 128, sB);
        load_conv_tile<128, false>(bc_raw, 512, 256 + g * 128, t0, lo, hi, cw, cbs, 768 + g * 128, sC);
        __syncthreads();
        {
            f32x4 cacc[8];
#pragma unroll
            for (int i = 0; i < 8; ++i) cacc[i] = (f32x4){0.f, 0.f, 0.f, 0.f};
#pragma unroll
            for (int ks = 0; ks < 4; ++ks) { const bf16x8 cf = *(const LAS bf16x8*)(sC + (wave * 16 + fr) * SLD + ks * 32 + fq * 8);
#pragma unroll
                for (int st = 0; st < 8; ++st) { const bf16x8 bf = *(const LAS bf16x8*)(sB + (st * 16 + fr) * SLD + ks * 32 + fq * 8); cacc[st] = __builtin_amdgcn_mfma_f32_16x16x32_bf16(bf, cf, cacc[st], 0, 0, 0); } }
            __syncthreads();
#pragma unroll
            for (int st = 0; st < 8; ++st) { u32x2 q; q.x = pk2(cacc[st][0], cacc[st][1]); q.y = pk2(cacc[st][2], cacc[st][3]); *(LAS u32x2*)(sB + (wave * 16 + fr) * SLD + st * 16 + fq * 4) = q; }
            __syncthreads();
        }
#pragma unroll 1
        for (int hp = 0; hp < 2; ++hp) {
        load_conv_tile<128, true>(xs_raw, 512, g * 256 + hp * 128, t0, lo, hi, cw, cbs, g * 256 + hp * 128, xsT);
        __syncthreads();
        const int hh2 = wave >> 2, lq = wave & 3, h8 = g * 4 + hp * 2 + hh2;
        const float Dh = a->in[I_SD][l * 8 + h8];
        const int hq = hp * 2 + hh2; const LAS float* dtf = sDt + (hq * 2) * 128; const LAS float* dtb = sDt + (hq * 2 + 1) * 128; const LAS float* csf = sCs + (hq * 2) * 128; const LAS float* csb = sCs + (hq * 2 + 1) * 128;
        f32x4 acc[2][4];
#pragma unroll
        for (int i = 0; i < 2; ++i)
#pragma unroll
            for (int j = 0; j < 4; ++j) acc[i][j] = (f32x4){0.f, 0.f, 0.f, 0.f};
#pragma unroll 1
        for (int ks = 0; ks < 4; ++ks) {
            const int s0 = ks * 32 + fq * 8;
            bf16x8 xf[4];
#pragma unroll
            for (int pt = 0; pt < 4; ++pt) xf[pt] = *(const LAS bf16x8*)(xsT + (hh2 * 64 + pt * 16 + fr) * SLD + s0);
            float vdf[8], vdb[8], vcf[8], vcb[8];
            { const f32x4 q0 = *(const LAS f32x4*)(dtf + s0), q1 = *(const LAS f32x4*)(dtf + s0 + 4), r0 = *(const LAS f32x4*)(dtb + s0), r1 = *(const LAS f32x4*)(dtb + s0 + 4);
              const f32x4 u0 = *(const LAS f32x4*)(csf + s0), u1 = *(const LAS f32x4*)(csf + s0 + 4), w0 = *(const LAS f32x4*)(csb + s0), w1 = *(const LAS f32x4*)(csb + s0 + 4);
#pragma unroll
              for (int e = 0; e < 4; ++e) { vdf[e] = q0[e]; vdf[4 + e] = q1[e]; vdb[e] = r0[e]; vdb[4 + e] = r1[e]; vcf[e] = u0[e]; vcf[4 + e] = u1[e]; vcb[e] = w0[e]; vcb[4 + e] = w1[e]; } }
#pragma unroll
            for (int lt = 0; lt < 2; ++lt) {
                const int lrow = lq * 32 + lt * 16 + fr;
                const float csf_l = csf[lrow], csb_l = csb[lrow];
                const u32x4 cbq = *(const LAS u32x4*)(sB + lrow * SLD + s0);
                const float cbv[8] = {bflo(cbq.x), bfhi(cbq.x), bflo(cbq.y), bfhi(cbq.y), bflo(cbq.z), bfhi(cbq.z), bflo(cbq.w), bfhi(cbq.w)};
                float mv[8];
#pragma unroll
                for (int e = 0; e < 8; ++e) { const int s = s0 + e;
                    const float ex = s < lrow ? csf_l - vcf[e] : csb_l - vcb[e];
                    const float dd = s < lrow ? vdf[e] : vdb[e];
                    float mm = cbv[e] * __expf(ex) * dd;
                    if (s == lrow) mm = cbv[e] * (vdf[e] + vdb[e]) + Dh;
                    mv[e] = mm;
                    }
                union { bf16x8 v; unsigned u[4]; } mf;
#pragma unroll
                for (int j = 0; j < 4; ++j) mf.u[j] = pk2(mv[2 * j], mv[2 * j + 1]);
#pragma unroll
                for (int pt = 0; pt < 4; ++pt) acc[lt][pt] = __builtin_amdgcn_mfma_f32_16x16x32_bf16(xf[pt], mf.v, acc[lt][pt], 0, 0, 0);
            }
        }
#pragma unroll 1
        for (int dir = 0; dir < 2; ++dir) {
            const bf16_t* pv = states + ((size_t)((gc - cbase) * 8 + h8) * 2 + dir) * 8192;
            const LAS float* cs = dir ? csb : csf;
            float el[2];
#pragma unroll
            for (int lt = 0; lt < 2; ++lt) el[lt] = __expf(cs[lq * 32 + lt * 16 + fr]);
#pragma unroll
            for (int ks = 0; ks < 4; ++ks) {
                const int n0 = ks * 32 + fq * 8;
                bf16x8 pf[4];
#pragma unroll
                for (int pt = 0; pt < 4; ++pt) pf[pt] = *(const bf16x8*)(pv + (pt * 16 + fr) * 128 + n0);
#pragma unroll
                for (int lt = 0; lt < 2; ++lt) {
                    const float sc[8] = {el[lt], el[lt], el[lt], el[lt], el[lt], el[lt], el[lt], el[lt]};
                    const bf16x8 cf = scale_frag8(*(const LAS bf16x8*)(sC + (lq * 32 + lt * 16 + fr) * SLD + n0), sc);
#pragma unroll
                    for (int pt = 0; pt < 4; ++pt) acc[lt][pt] = __builtin_amdgcn_mfma_f32_16x16x32_bf16(pf[pt], cf, acc[lt][pt], 0, 0, 0);
                }
            }
        }
        u32x2 gqv[2][4];
#pragma unroll
        for (int lt = 0; lt < 2; ++lt)
#pragma unroll
            for (int pt = 0; pt < 4; ++pt) gqv[lt][pt] = *(const u32x2*)(gate + (size_t)(t0 + lq * 32 + lt * 16 + fr) * 512 + g * 256 + (hp * 2 + hh2) * 64 + pt * 16 + fq * 4);
#pragma unroll
        for (int lt = 0; lt < 2; ++lt)
#pragma unroll
            for (int pt = 0; pt < 4; ++pt) {
                u32x2* gp = (u32x2*)(gate + (size_t)(t0 + lq * 32 + lt * 16 + fr) * 512 + g * 256 + (hp * 2 + hh2) * 64 + pt * 16 + fq * 4);
                const u32x2 gq = gqv[lt][pt];
                u32x2 o; o.x = pk2(acc[lt][pt][0] * silu_f(bflo(gq.x)), acc[lt][pt][1] * silu_f(bfhi(gq.x))); o.y = pk2(acc[lt][pt][2] * silu_f(bflo(gq.y)), acc[lt][pt][3] * silu_f(bfhi(gq.y)));
                if (!dry) *gp = o;
            }
        __syncthreads();
        }
    }
}
__device__ __forceinline__ f32x2 cmul(f32x2 a, f32x2 b) { const f32x2 bx = {b.x, b.x}, by = {b.y, b.y}, ar = {-a.y, a.x}; return a * bx + ar * by; }
__device__ __forceinline__ f32x2 cmulc(f32x2 a, f32x2 b) { const f32x2 bx = {b.x, b.x}, by = {b.y, b.y}, ar = {a.y, -a.x}; return a * bx + ar * by; }
#define DP(e) d[(e) + ((e) >> 4)]
__device__ __forceinline__ f32x2 w16(int k) {
    constexpr float C[8] = {1.f, 0.9238795325112867f, 0.7071067811865476f, 0.3826834323650898f, 0.f, -0.3826834323650898f, -0.7071067811865476f, -0.9238795325112867f};
    constexpr float S[8] = {0.f, 0.3826834323650898f, 0.7071067811865476f, 0.9238795325112867f, 1.f, 0.9238795325112867f, 0.7071067811865476f, 0.3826834323650898f};
    return (f32x2){C[k], -S[k]};
}
__device__ __forceinline__ f32x2 mulw16(f32x2 v, int k) { if (k == 0) return v; if (k == 4) return (f32x2){v.y, -v.x}; return cmul(v, w16(k)); }
__device__ __forceinline__ f32x2 mulw16c(f32x2 v, int k) { if (k == 0) return v; if (k == 4) return (f32x2){-v.y, v.x}; return cmulc(v, w16(k)); }
template <int LOGN, bool FOLD = false, int TPA = 512> __device__ __forceinline__ void fft_fwd(LAS f32x2* d, const LAS f32x2* tw, const int tq) {
    constexpr int N = 1 << LOGN;
    if (LOGN == 13 && !FOLD) {
#pragma unroll
        for (int qi = 0; qi < 8; ++qi) { const int q = tq + 512 * qi; const f32x2 x0 = DP(q), x1 = DP(q + 4096); DP(q) = x0 + x1; DP(q + 4096) = cmul(x0 - x1, tw[q]); }
        __syncthreads();
    }
#pragma unroll 1
    for (int ls = 11; ls >= 7; ls -= 4) {
        const int st = 1 << (ls - 3);
#pragma unroll
        for (int gi = 0; gi < (N / 16 + TPA - 1) / TPA; ++gi) { const int g = tq + TPA * gi;
            if (g < N / 16) {
                const int j = g & (st - 1), blk = g >> (ls - 3), base = (blk << (ls + 1)) + j;
                const f32x2 W1 = tw[j << (12 - ls)], W2 = tw[j << (13 - ls)], W3 = tw[j << (14 - ls)], W4 = tw[j << (15 - ls)];
                f32x2 x[16];
#pragma unroll
                for (int k = 0; k < 16; ++k) x[k] = DP(base + k * st);
#pragma unroll
                for (int k = 0; k < 8; ++k) { const f32x2 a = x[k], b = x[k + 8]; x[k] = a + b; x[k + 8] = cmul(mulw16(a - b, k), W1); }
#pragma unroll
                for (int k = 0; k < 16; ++k) if ((k & 7) < 4) { const f32x2 a = x[k], b = x[k + 4]; x[k] = a + b; x[k + 4] = cmul(mulw16(a - b, 2 * (k & 3)), W2); }
#pragma unroll
                for (int k = 0; k < 16; ++k) if ((k & 3) < 2) { const f32x2 a = x[k], b = x[k + 2]; x[k] = a + b; x[k + 2] = cmul(mulw16(a - b, 4 * (k & 1)), W3); }
#pragma unroll
                for (int k = 0; k < 16; k += 2) { const f32x2 a = x[k], b = x[k + 1]; x[k] = a + b; x[k + 1] = cmul(a - b, W4); }
#pragma unroll
                for (int k = 0; k < 16; ++k) DP(base + k * st) = x[k];
            }
        }
        __syncthreads();
    }
#pragma unroll
    for (int gi = 0; gi < (N / 16 + TPA - 1) / TPA; ++gi) { const int g = tq + TPA * gi;
        if (g < N / 16) {
            f32x2 x[16];
#pragma unroll
            for (int i = 0; i < 16; ++i) x[i] = d[17 * g + i];
#pragma unroll
            for (int i = 0; i < 8; ++i) { const f32x2 a = x[i], b = x[i + 8]; x[i] = a + b; x[i + 8] = mulw16(a - b, i); }
#pragma unroll
            for (int i = 0; i < 16; ++i) if ((i & 7) < 4) { const f32x2 a = x[i], b = x[i + 4]; x[i] = a + b; x[i + 4] = mulw16(a - b, 2 * (i & 3)); }
#pragma unroll
            for (int i = 0; i < 16; ++i) if ((i & 3) < 2) { const f32x2 a = x[i], b = x[i + 2]; x[i] = a + b; x[i + 2] = mulw16(a - b, 4 * (i & 1)); }
#pragma unroll
            for (int i = 0; i < 16; i += 2) { const f32x2 a = x[i], b = x[i + 1]; x[i] = a + b; x[i + 1] = a - b; }
#pragma unroll
            for (int i = 0; i < 16; ++i) d[17 * g + i] = x[i];
        }
    }
    __syncthreads();
}
template <int LOGN, bool FOLD = false, int TPA = 512> __device__ __forceinline__ void fft_inv(LAS f32x2* d, const LAS f32x2* tw, const int tq) {
    constexpr int N = 1 << LOGN;
#pragma unroll
    for (int gi = 0; gi < (N / 16 + TPA - 1) / TPA; ++gi) { const int g = tq + TPA * gi;
        if (g < N / 16) {
            f32x2 x[16];
#pragma unroll
            for (int i = 0; i < 16; ++i) x[i] = d[17 * g + i];
#pragma unroll
            for (int i = 0; i < 16; i += 2) { const f32x2 a = x[i], b = x[i + 1]; x[i] = a + b; x[i + 1] = a - b; }
#pragma unroll
            for (int i = 0; i < 16; ++i) if ((i & 3) < 2) { const f32x2 a = x[i], b = mulw16c(x[i + 2], 4 * (i & 1)); x[i] = a + b; x[i + 2] = a - b; }
#pragma unroll
            for (int i = 0; i < 16; ++i) if ((i & 7) < 4) { const f32x2 a = x[i], b = mulw16c(x[i + 4], 2 * (i & 3)); x[i] = a + b; x[i + 4] = a - b; }
#pragma unroll
            for (int i = 0; i < 8; ++i) { const f32x2 a = x[i], b = mulw16c(x[i + 8], i); x[i] = a + b; x[i + 8] = a - b; }
#pragma unroll
            for (int i = 0; i < 16; ++i) d[17 * g + i] = x[i];
        }
    }
    __syncthreads();
#pragma unroll 1
    for (int ls = 7; ls <= 11; ls += 4) {
        const int st = 1 << (ls - 3);
#pragma unroll
        for (int gi = 0; gi < (N / 16 + TPA - 1) / TPA; ++gi) { const int g = tq + TPA * gi;
            if (g < N / 16) {
                const int j = g & (st - 1), blk = g >> (ls - 3), base = (blk << (ls + 1)) + j;
                const f32x2 W1 = tw[j << (12 - ls)], W2 = tw[j << (13 - ls)], W3 = tw[j << (14 - ls)], W4 = tw[j << (15 - ls)];
                f32x2 x[16];
#pragma unroll
                for (int k = 0; k < 16; ++k) x[k] = DP(base + k * st);
#pragma unroll
                for (int k = 0; k < 16; k += 2) { const f32x2 a = x[k], b = cmulc(x[k + 1], W4); x[k] = a + b; x[k + 1] = a - b; }
#pragma unroll
                for (int k = 0; k < 16; ++k) if ((k & 3) < 2) { const f32x2 a = x[k], b = cmulc(mulw16c(x[k + 2], 4 * (k & 1)), W3); x[k] = a + b; x[k + 2] = a - b; }
#pragma unroll
                for (int k = 0; k < 16; ++k) if ((k & 7) < 4) { const f32x2 a = x[k], b = cmulc(mulw16c(x[k + 4], 2 * (k & 3)), W2); x[k] = a + b; x[k + 4] = a - b; }
#pragma unroll
                for (int k = 0; k < 8; ++k) { const f32x2 a = x[k], b = cmulc(mulw16c(x[k + 8], k), W1); x[k] = a + b; x[k + 8] = a - b; }
#pragma unroll
                for (int k = 0; k < 16; ++k) DP(base + k * st) = x[k];
            }
        }
        __syncthreads();
    }
    if (LOGN == 13 && !FOLD) {
#pragma unroll
        for (int qi = 0; qi < 8; ++qi) { const int q = tq + 512 * qi; const f32x2 u = DP(q), v = cmulc(DP(q + 4096), tw[q]); DP(q) = u + v; DP(q + 4096) = u - v; }
        __syncthreads();
    }
}
constexpr size_t FT_SET0_OFF = (size_t)2 * 512 * 4096;
__device__ __forceinline__ void phase_filter(ArgsP a, int l, LAS unsigned char* lds, float* FT) {
    LAS float* sh = (LAS float*)lds;
    LAS float* sw = (LAS float*)(lds + 64 * 65 * 4);
    const int tid = otid(), lane = tid & 63, wave = tid >> 6;
    const float min_decay = -3.0701134573253944f, max_decay = -15.350567286626972f;
    for (int it = blockIdx.x; it < 1536; it += gridDim.x) {
        const int set = it < 1024 ? 1 : 0, r = set ? it : it - 1024, L = set ? 4096 : 2048, tt0 = (r >> 4) * 64, cc0 = (r & 15) * 64;
        const float* h2 = (const float*)(a->ws + WS_H2) + ((size_t)l * 6144 + (set ? 2048 : 0) + tt0) * 64;
        const float* fw3 = a->in[I_FW3] + (size_t)l * 64 * 1024 + cc0;
        { const int rr = tid >> 3, c8 = (tid & 7) * 8;
          const f32x4 h0 = *(const f32x4*)(h2 + rr * 64 + c8), h1 = *(const f32x4*)(h2 + rr * 64 + c8 + 4);
          const f32x4 w0 = *(const f32x4*)(fw3 + (size_t)rr * 1024 + c8), w1 = *(const f32x4*)(fw3 + (size_t)rr * 1024 + c8 + 4);
#pragma unroll
          for (int e = 0; e < 4; ++e) { sh[rr * 65 + c8 + e] = h0[e]; sh[rr * 65 + c8 + 4 + e] = h1[e]; }
          *(LAS f32x4*)(sw + rr * 64 + c8) = w0; *(LAS f32x4*)(sw + rr * 64 + c8 + 4) = w1; }
        __syncthreads();
        float o[8];
#pragma unroll
        for (int k = 0; k < 8; ++k) o[k] = 0.f;
#pragma unroll 8
        for (int i = 0; i < 64; ++i) { const float hv = sh[lane * 65 + i]; const f32x4 w0 = *(const LAS f32x4*)(sw + i * 64 + wave * 8), w1 = *(const LAS f32x4*)(sw + i * 64 + wave * 8 + 4);
#pragma unroll
            for (int e = 0; e < 4; ++e) { o[e] += hv * w0[e]; o[4 + e] += hv * w1[e]; } }
        const int t = tt0 + lane; const float tl = (float)t / (float)(L - 1);
        float fb[8];
#pragma unroll
        for (int k = 0; k < 8; ++k) fb[k] = a->in[I_FB3][l * 1024 + cc0 + wave * 8 + k];
#pragma unroll
        for (int k = 0; k < 8; ++k) { const int cp = cc0 + wave * 8 + k, dir = cp >> 9, c = cp & 511;
            const float delta = fabsf(min_decay + (float)c * ((max_decay - min_decay) / 511.0f));
            FT[(set ? 0 : FT_SET0_OFF) + ((size_t)dir * 512 + c) * L + t] = (o[k] + fb[k]) * __expf(-tl * delta); }
        __syncthreads();
    }
}
template <int LOGN> __device__ __forceinline__ void hyena_conv_item(ArgsP a, int l, int c, LAS unsigned char* lds, const bf16_t* x1T, bf16_t* vT, const float* FT, int dry) {
    constexpr int N = 1 << LOGN, L = N / 2, SET = (LOGN == 13), NB = SET ? 4 : 8, TOK0 = SET ? TP : 0, TPA = SET ? 512 : 256, NPAR = 512 / TPA, NJ = L / TPA, NK = N / TPA;
    static_assert(NJ == 8 && NK == 16, "shape");
    LAS f32x2* d = (LAS f32x2*)lds;
    LAS f32x2* tw = (LAS f32x2*)(lds + 69632);
    const int tid = otid(), tl = tid % TPA;
    const float* hfT = FT + (SET ? 0 : FT_SET0_OFF) + (size_t)c * L; const float* hbT = hfT + (size_t)512 * L;
#pragma unroll
    for (int j = 0; j < L / 512; ++j) { const int t = tid + 512 * j;
        DP(t) = (f32x2){hfT[t], 0.f};
        if (t >= 1) DP(N - t) = (f32x2){hbT[t], 0.f};
    }
    if (tid == 0) DP(L) = (f32x2){0.f, 0.f};
    __syncthreads();
    fft_fwd<LOGN>(d, tw, tid);
    f32x2 kf[NK];
#pragma unroll
    for (int j = 0; j < NK; ++j) kf[j] = DP(tl + TPA * j) * (1.0f / (float)N);
    __syncthreads();
    const float* cw = a->in[I_HCW] + l * 3 * 1536; const float cb1 = a->in[I_HCB][l * 1536 + 512 + c], cbv = a->in[I_HCB][l * 1536 + 1024 + c];
    const float w10 = cw[512 + c], w11 = cw[1536 + 512 + c], w12 = cw[3072 + 512 + c], wv0 = cw[1024 + c], wv1 = cw[1536 + 1024 + c], wv2 = cw[3072 + 1024 + c];
    const float hbias = a->in[I_HBIAS][l * 512 + c];
    LAS f32x2* const d0 = d; d = d0 + (tid / TPA) * (N + N / 16);
#pragma unroll 1
    for (int bp0 = 0; bp0 < NB / 2; bp0 += NPAR) {
        const int bp = bp0 + tid / TPA;
        const size_t rowA = (size_t)c * T_ALL + TOK0 + (size_t)(2 * bp) * L, rowB = rowA + L;
        float zA[NJ], zB[NJ];
        {
            const int tb = tl * NJ;
            float x1a[NJ + 2], va[NJ + 2], x1b[NJ + 2], vb[NJ + 2];
            auto ldrow = [&](const bf16_t* p, float (&o)[NJ + 2]) {
                const u32x4 q = *(const u32x4*)(p + tb); o[1] = bflo(q.x); o[2] = bfhi(q.x); o[3] = bflo(q.y); o[4] = bfhi(q.y); o[5] = bflo(q.z); o[6] = bfhi(q.z); o[7] = bflo(q.w); o[8] = bfhi(q.w);
                o[0] = tb > 0 ? bf2f(p[tb - 1]) : 0.f; o[NJ + 1] = tb + NJ < L ? bf2f(p[tb + NJ]) : 0.f;
            };
            ldrow(x1T + rowA, x1a); ldrow(vT + rowA, va); ldrow(x1T + rowB, x1b); ldrow(vT + rowB, vb);
#pragma unroll
            for (int jj = 0; jj < NJ; ++jj) {
                zA[jj] = (cb1 + w10 * x1a[jj] + w11 * x1a[jj + 1] + w12 * x1a[jj + 2]) * (cbv + wv0 * va[jj] + wv1 * va[jj + 1] + wv2 * va[jj + 2]);
                zB[jj] = (cb1 + w10 * x1b[jj] + w11 * x1b[jj + 1] + w12 * x1b[jj + 2]) * (cbv + wv0 * vb[jj] + wv1 * vb[jj + 1] + wv2 * vb[jj + 2]);
                const f32x2 zz = {zA[jj], zB[jj]}; DP(tb + jj) = zz; DP(L + tb + jj) = (LOGN == 13) ? cmul(zz, tw[tb + jj]) : (f32x2){0.f, 0.f};
            }
        }
        __syncthreads();
        fft_fwd<LOGN, true, TPA>(d, tw, tl);
#pragma unroll
        for (int j = 0; j < NK; ++j) DP(tl + TPA * j) = cmul(DP(tl + TPA * j), kf[j]);
        __syncthreads();
        fft_inv<LOGN, true, TPA>(d, tw, tl);
        {   const int tb = tl * NJ; unsigned oa[NJ / 2], ob[NJ / 2];
#pragma unroll
            for (int jj = 0; jj < NJ; jj += 2) { f32x2 y0 = DP(tb + jj), y1 = DP(tb + jj + 1);
                if (LOGN == 13) { y0 = y0 + cmulc(DP(L + tb + jj), tw[tb + jj]); y1 = y1 + cmulc(DP(L + tb + jj + 1), tw[tb + jj + 1]); }
                oa[jj / 2] = pk2(y0.x + zA[jj] * hbias, y1.x + zA[jj + 1] * hbias); ob[jj / 2] = pk2(y0.y + zB[jj] * hbias, y1.y + zB[jj + 1] * hbias); }
            if (!dry) { u32x4 qa, qb; qa.x = oa[0]; qa.y = oa[1]; qa.z = oa[2]; qa.w = oa[3]; qb.x = ob[0]; qb.y = ob[1]; qb.z = ob[2]; qb.w = ob[3]; *(u32x4*)(vT + rowA + tb) = qa; *(u32x4*)(vT + rowB + tb) = qb; }
        }
        __syncthreads();
    }
}
__device__ __forceinline__ void phase_hyena_conv(ArgsP a, int l, LAS unsigned char* lds, const bf16_t* x1T, bf16_t* vT, const float* FT, int dry) {
    { LAS f32x2* tw = (LAS f32x2*)(lds + 69632); const f32x2* g = (const f32x2*)(a->ws + WS_TW); for (int i = otid(); i < 4096; i += 512) tw[i] = g[i]; }
    __syncthreads();
    for (int it = blockIdx.x; it < 1024; it += gridDim.x) {
        if (it < 512) hyena_conv_item<13>(a, l, it, lds, x1T, vT, FT, dry);
        else hyena_conv_item<12>(a, l, it - 512, lds, x1T, vT, FT, dry);
    }
}
__device__ __forceinline__ void phase_hyena_norm(ArgsP a, int l, LAS unsigned char* lds, const bf16_t* x0T, const bf16_t* yT, bf16_t* hyn) {
    constexpr int PLD = 513;
    LAS float* P = (LAS float*)lds;
    LAS float* part = (LAS float*)(lds + 64 * PLD * 4);
    const int tid = otid(), lane = tid & 63, wave = tid >> 6, tp = lane & 15, cq = lane >> 4;
    const float* cw = a->in[I_HCW] + l * 3 * 1536; const float* cb = a->in[I_HCB] + l * 1536;
    float hg[8];
#pragma unroll
    for (int j = 0; j < 4; ++j) { hg[2 * j] = a->in[I_HNORM][l * 512 + 2 * lane + 128 * j]; hg[2 * j + 1] = a->in[I_HNORM][l * 512 + 2 * lane + 128 * j + 1]; }
    for (int it = blockIdx.x; it < T_ALL / 64; it += gridDim.x) {
        const int tile0 = it * 64, t = tile0 + 4 * tp; int lo, hi; seq_bounds(tile0, lo, hi);
        const bool hasl = t > lo, hasr = t + 4 < hi;
        float ss0 = 0.f, ss1 = 0.f, ss2 = 0.f, ss3 = 0.f;
#pragma unroll 8
        for (int i = 0; i < 16; ++i) {
            const int c = wave * 64 + 4 * i + cq; const size_t row = (size_t)c * T_ALL;
            const u32x2 xc = *(const u32x2*)(x0T + row + t), yc = *(const u32x2*)(yT + row + t);
            const float xm = hasl ? bf2f(x0T[row + t - 1]) : 0.f, xp = hasr ? bf2f(x0T[row + t + 4]) : 0.f;
            const float x0 = bflo(xc.x), x1 = bfhi(xc.x), x2 = bflo(xc.y), x3 = bfhi(xc.y), w0 = cw[c], w1 = cw[1536 + c], w2 = cw[3072 + c], bb = cb[c];
            const float p0 = (bb + w0 * xm + w1 * x0 + w2 * x1) * bflo(yc.x), p1 = (bb + w0 * x0 + w1 * x1 + w2 * x2) * bfhi(yc.x);
            const float p2 = (bb + w0 * x1 + w1 * x2 + w2 * x3) * bflo(yc.y), p3 = (bb + w0 * x2 + w1 * x3 + w2 * xp) * bfhi(yc.y);
            P[(4 * tp) * PLD + c] = p0; P[(4 * tp + 1) * PLD + c] = p1; P[(4 * tp + 2) * PLD + c] = p2; P[(4 * tp + 3) * PLD + c] = p3;
            ss0 += p0 * p0; ss1 += p1 * p1; ss2 += p2 * p2; ss3 += p3 * p3;
        }
        ss0 += __shfl_xor(ss0, 16); ss1 += __shfl_xor(ss1, 16); ss2 += __shfl_xor(ss2, 16); ss3 += __shfl_xor(ss3, 16);
        ss0 += __shfl_xor(ss0, 32); ss1 += __shfl_xor(ss1, 32); ss2 += __shfl_xor(ss2, 32); ss3 += __shfl_xor(ss3, 32);
        if (lane < 16) { part[wave * 64 + 4 * lane] = ss0; part[wave * 64 + 4 * lane + 1] = ss1; part[wave * 64 + 4 * lane + 2] = ss2; part[wave * 64 + 4 * lane + 3] = ss3; }
        __syncthreads();
#pragma unroll 1
        for (int r = 0; r < 8; ++r) {
            const int tl = wave * 8 + r;
            float s = 0.f;
#pragma unroll
            for (int w = 0; w < 8; ++w) s += part[w * 64 + tl];
            const float rs = rsqrtf(s * (1.0f / 512.0f) + EPS);
            bf16_t* orow = hyn + (size_t)(tile0 + tl) * 512;
#pragma unroll
            for (int j = 0; j < 4; ++j) { const int c = 2 * lane + 128 * j;
                const float v0 = P[tl * PLD + c] * rs * hg[2 * j], v1 = P[tl * PLD + c + 1] * rs * hg[2 * j + 1];
                *(unsigned*)(orow + c) = pk2(v0, v1); }
        }
        __syncthreads();
    }
}
#define XB_TMO      128
#define XB_XCNT(j)  (256  + 64 * (j))
#define XB_XSUB(j)  (1280 + 64 * (j))
#define XB_XGEN(j)  (2304 + 64 * (j))
#define XB_TOP      3328
#define XB_TOPGEN   3392
#define XCD_BAR_WORDS 3456
#define XB_SPIN_CAP (1u << 22)
constexpr size_t WS_BAR = 106 * MiB + 524288;
__device__ __forceinline__ unsigned xb_ld(unsigned* p)              { return __hip_atomic_load(p, __ATOMIC_RELAXED, __HIP_MEMORY_SCOPE_AGENT); }
__device__ __forceinline__ unsigned xb_add(unsigned* p, unsigned v) { return __hip_atomic_fetch_add(p, v, __ATOMIC_RELAXED, __HIP_MEMORY_SCOPE_AGENT); }
__device__ __forceinline__ unsigned xb_xcc_id() { return (unsigned)__builtin_amdgcn_s_getreg((3 << 11) | 20) & 0xFu; }
#define XB_SPIN(cond, bar) do { unsigned _sp = 0; while (cond) { __builtin_amdgcn_s_sleep(1); \
    if ((++_sp & 255u) == 0u) { if (xb_ld(&(bar)[XB_TMO])) break; if (_sp > XB_SPIN_CAP) { atomicAdd(&(bar)[XB_TMO], 1u); break; } } } } while (0)
__device__ __forceinline__ void xcd_barrier_complete(unsigned* bar, unsigned x, unsigned& nloc, unsigned& nx) {
    const unsigned G = gridDim.x;
    unsigned sum, cnt, mine, sp = 0u;
    for (;;) {
        sum = 0u; cnt = 0u; mine = 0u;
#pragma unroll
        for (unsigned j = 0; j < 16; ++j) { const unsigned c = xb_ld(&bar[XB_XCNT(j)]); sum += c; cnt += (c > 0u) ? 1u : 0u; mine = (j == x) ? c : mine; }
        if (sum == G) break;
        __builtin_amdgcn_s_sleep(1);
        if ((++sp & 255u) == 0u) { if (xb_ld(&bar[XB_TMO])) break; if (sp > XB_SPIN_CAP) { atomicAdd(&bar[XB_TMO], 1u); break; } }
    }
    nloc = mine > 0u ? mine : 1u; nx = cnt > 0u ? cnt : 1u;
}
__device__ __forceinline__ void xcd_barrier(unsigned* bar, volatile LAS unsigned* st) {
    asm volatile("s_waitcnt vmcnt(0)" ::: "memory");
    __syncthreads();
    if (threadIdx.x == 0) {
        const unsigned x = xb_xcc_id();
        __builtin_amdgcn_s_waitcnt(0);
        unsigned nloc = st[0], nx = st[1];
        if (nloc == 0u) { xcd_barrier_complete(bar, x, nloc, nx); st[0] = nloc; st[1] = nx; }
        const unsigned old = xb_add(&bar[XB_XSUB(x)], 1u);
        const unsigned gen = old / nloc;
        if (old + 1u == (gen + 1u) * nloc) {
            __builtin_amdgcn_fence(__ATOMIC_RELEASE, "agent");
            asm volatile("s_waitcnt vmcnt(0)" ::: "memory");
            const unsigned og = xb_add(&bar[XB_TOP], 1u);
            const unsigned tg = og / nx;
            if (og + 1u == (tg + 1u) * nx) xb_add(&bar[XB_TOPGEN], 1u);
            else XB_SPIN(xb_ld(&bar[XB_TOPGEN]) == tg, bar);
            __builtin_amdgcn_fence(__ATOMIC_ACQUIRE, "agent");
            xb_add(&bar[XB_XGEN(x)], 1u);
            asm volatile("s_waitcnt vmcnt(0)" ::: "memory");
        } else {
            XB_SPIN(xb_ld(&bar[XB_XGEN(x)]) == gen, bar);
            __builtin_amdgcn_fence(__ATOMIC_ACQUIRE, "agent");
            asm volatile("s_waitcnt vmcnt(0)" ::: "memory");
        }
    }
    __syncthreads();
}
__device__ __forceinline__ void epi_cfg(int st, int gi, int l, unsigned char* ws, float* out, ArgsP a, Epi& E) {
    float* ssq = (float*)(ws + WS_SSQ); bf16_t* xb = (bf16_t*)(ws + WS_XB);
    bf16_t* r1a = (bf16_t*)(ws + WS_R1A); bf16_t* r1b = (bf16_t*)(ws + WS_R1B); bf16_t* r2 = (bf16_t*)(ws + WS_R2); bf16_t* r3 = (bf16_t*)(ws + WS_R3);
    bf16_t* kmat = (bf16_t*)(ws + WS_R4); bf16_t* vtm = (bf16_t*)(ws + WS_R4 + 6 * MiB);
    float* ssq_in = ssq + (size_t)(3 * l) * T_ALL; float* ssq_a = ssq_in + T_ALL; float* ssq_m = ssq_a + T_ALL; float* ssq_n = ssq_m + T_ALL;
    const int half = (st >= 16) ? ((st - 16) >> 1) : 0;
    E.kind = 0; E.O0 = r1a; E.d1 = 0; E.d2 = 0; E.ldc = 1024; E.csplit = 0; E.rsplit = 0; E.ssq = ssq_in; E.psum = (float*)(ws + WS_PSUM); E.row_off = 0; E.SCALE = 0; E.ACT = 0;
    E.X = out; E.rin0 = out; E.rin1 = out + (size_t)TP * DM; E.xb = xb; E.ssq_out = ssq_a; E.rin_bf16 = 0; E.write_x = 1; E.write_xb = 1;
    if (st == 1)       { E.O0 = r1b; E.d1 = r2 - r1b; E.d2 = r3 - r2; E.ldc = 512; E.csplit = 2; E.SCALE = 1; }
    else if (st == 8)  { E.O0 = r2; E.d1 = r1a - r2; E.d2 = r3 - r1a; E.ldc = T_ALL; E.rsplit = 2; E.SCALE = 2; }
    else if (st == 11) { E.kind = 1; E.write_x = 0; E.rin_bf16 = 1; }
    else if (st == 12) {
        if (gi == 0)      { E.SCALE = 1; E.ssq = ssq_a; }
        else              { E.O0 = kmat; }
    }
    else if (st == 13) { E.O0 = r2; E.ACT = 2; }
    else if (st == 14) { E.SCALE = 3; }
    else if (st == 15) { E.kind = 1; E.ssq_out = ssq_m; E.rin_bf16 = 1; E.write_x = 0; }
    else if (st == 16 || st == 18) { E.ldc = 4096; E.SCALE = 1; E.ACT = 1; E.ssq = ssq_m; E.row_off = half * TP; }
    else               { E.kind = 1; E.ssq_out = ssq_n; E.row_off = half * TP; E.rin_bf16 = 1; E.write_x = 0; E.write_xb = 1; }
}
template <int KIND> struct EpiT {
    static constexpr bool PERM = true;
    int st, gi, l; unsigned char* ws; float* out; ArgsP a;
    __device__ __forceinline__ void operator()(const f32x4 (&acc)[2][2][4][2], const pg8::Unit& u, int wr, int wc, int fr, int fq) const {
        int st_ = st; asm volatile("" : "+s"(st_));
        Epi E; epi_cfg(st_, gi, l, ws, out, a, E);
        pg8::Unit uu = u;
        if (st_ == 12 && gi == 1 && u.pm >= 64) { uu.pm = u.pm - 64; E.O0 = (bf16_t*)(ws + WS_R4 + 6 * MiB); E.ldc = 3072; }
        if (KIND == 0) E.bf_path(acc, uu, wr, wc, fr, fq); else E.res_path(acc, uu, wr, wc, fr, fq);
    }
};
#ifdef DBG_SCAN
constexpr size_t WS_FLAG = 106 * MiB + 262144;
__device__ __forceinline__ void dbg_scan(unsigned char* ws, float* out, int ph) {
    int bad = 0;
    const size_t gt = (size_t)blockIdx.x * 512 + otid(), gs = (size_t)gridDim.x * 512;
    { const u32x4* p = (const u32x4*)(ws + 32 * MiB); const size_t n = (70 * MiB) / 16;
      for (size_t i = gt; i < n; i += gs) { const u32x4 w = p[i];
#pragma unroll
          for (int e = 0; e < 4; ++e) { const unsigned x = w[e]; if ((x & 0x7f80u) == 0x7f80u || (x & 0x7f800000u) == 0x7f800000u) bad = 1; } } }
    { const u32x4* p = (const u32x4*)(ws + 111 * MiB); const size_t n = (140 * MiB) / 16;
      for (size_t i = gt; i < n; i += gs) { const u32x4 w = p[i];
#pragma unroll
          for (int e = 0; e < 4; ++e) { const unsigned x = w[e]; if ((x & 0x7f80u) == 0x7f80u || (x & 0x7f800000u) == 0x7f800000u) bad = 1; } } }
    { const u32x4* p = (const u32x4*)(ws + 102 * MiB); const size_t n = (9 * MiB) / 16;
      for (size_t i = gt; i < n; i += gs) { const u32x4 w = p[i];
#pragma unroll
          for (int e = 0; e < 4; ++e) { const unsigned x = w[e]; if ((x & 0x7f800000u) == 0x7f800000u) bad = 1; } } }
    { const u32x4* p = (const u32x4*)out; const size_t n = (128 * MiB) / 16;
      for (size_t i = gt; i < n; i += gs) { const u32x4 w = p[i];
#pragma unroll
          for (int e = 0; e < 4; ++e) { const unsigned x = w[e]; if ((x & 0x7f800000u) == 0x7f800000u) bad = 1; } } }
    if (bad) atomicMax((int*)(ws + WS_FLAG), 100 - (ph + 1));
}
#endif
__global__ __launch_bounds__(512, 2) void mega_fwd(Args a_by_value) {
    extern __shared__ __attribute__((aligned(16))) unsigned char shm[];
    LAS unsigned char* lds = (LAS unsigned char*)shm;
    cg::grid_group grid = cg::this_grid();
    volatile LAS unsigned* xst = (volatile LAS unsigned*)(lds + LDS_BYTES - 16);
    if (threadIdx.x == 0) { xst[0] = 0u; xst[1] = 0u; xst[2] = 0u; xst[3] = 0u; (void)xb_add(&((unsigned*)(a_by_value.ws + WS_BAR))[XB_XCNT(xb_xcc_id())], 1u); }
    __syncthreads();
#ifdef DBG_TIME
    unsigned long long t_sel = 0, t_all = 0;
#endif
#pragma unroll 1
    for (int ph = 0; ph <= 40; ++ph) {
#ifdef DBG_TIME
        const unsigned long long t_begin = __builtin_amdgcn_s_memrealtime();
#endif
        ArgsP a = (ArgsP)__builtin_amdgcn_kernarg_segment_ptr(); asm volatile("" : "+s"(a));
        unsigned char* ws = a->ws; float* out = a->out;
        float* ssq = (float*)(ws + WS_SSQ);
        bf16_t* xb = (bf16_t*)(ws + WS_XB);
        bf16_t* r1a = (bf16_t*)(ws + WS_R1A); bf16_t* r1b = (bf16_t*)(ws + WS_R1B); bf16_t* r2 = (bf16_t*)(ws + WS_R2); bf16_t* r3 = (bf16_t*)(ws + WS_R3);
        bf16_t* kmat = (bf16_t*)(ws + WS_R4); bf16_t* vtm = (bf16_t*)(ws + WS_R4 + 6 * MiB);
        float* psum = (float*)(ws + WS_PSUM);
#ifdef DBG_TIME
        if (ph == 40) { if (blockIdx.x == 0 && threadIdx.x == 0) { *(volatile float*)(ws + 106 * MiB + 262144) = 2.0f * sqrtf((float)t_sel / (float)t_all); __threadfence(); }
            xcd_barrier((unsigned*)(ws + WS_BAR), xst);
            const float cval = *(volatile float*)(ws + 106 * MiB + 262144);
            for (size_t i = (size_t)blockIdx.x * 512 + otid(); i < (size_t)T_ALL * DM; i += (size_t)gridDim.x * 512) out[i] = cval; break; }
#elif defined(DBG_SCAN)
        if (ph == 40) { const int fl = *(volatile int*)(ws + WS_FLAG); const float cval = fl < 0 ? 0.f : sqrtf((float)(100 - fl));
            for (size_t i = (size_t)blockIdx.x * 512 + otid(); i < (size_t)T_ALL * DM; i += (size_t)gridDim.x * 512) out[i] = cval; break; }
#else
        if (ph == 40) { phase_final(a, ssq + (size_t)6 * T_ALL, xb); break; }
#endif
        const int l = ph / 20, st = ph % 20;
        const float* rin0 = l == 0 ? a->in[I_XP] : out; const float* rin1 = l == 0 ? a->in[I_XS] : out + (size_t)TP * DM;
        float* ssq_in = ssq + (size_t)(3 * l) * T_ALL; float* ssq_a = ssq_in + T_ALL; float* ssq_m = ssq_a + T_ALL; float* ssq_n = ssq_m + T_ALL;
#ifndef PH_LIMIT
#define PH_LIMIT 100
#endif
        const bool is_gemm = (st == 1 || st == 8 || (st >= 11 && st <= 19));
        if (ph >= PH_LIMIT) {}
        else if (st == 0) {
#ifdef DUP_MISC
            if (l == 0) phase_prologue(a, lds); phase_wconv(a, l, lds); __syncthreads();
#endif
            if (l == 0) phase_prologue(a, lds); phase_wconv(a, l, lds); }
        else if (is_gemm) {
            const int ng = (st == 12) ? 2 : 1;
#pragma unroll 1
            for (int gi = 0; gi < ng; ++gi) {
                int nM = 128, nN = 4, mode = 0, lda = 1024, ldb = 1024, K = 1024, ks_shift = 30; size_t seg = 0;
                const void* A = xb; const void* B = ws + WS_WQ;
                const int half = (st >= 16) ? ((st - 16) >> 1) : 0;
                if (st == 1)       { nN = 6; B = ws + WS_WSSM; }
                else if (st == 8)  { nM = 6; nN = 128; A = ws + WS_WHY; B = xb; }
                else if (st == 11) { A = r1a; lda = 512; ks_shift = 3; seg = (size_t)(WS_R1B - WS_R1A); B = ws + WS_WOUT; }
                else if (st == 12) {
                    if (gi == 1)      { nM = 12; nN = 8; mode = 3; A = ws + WS_MEMB; B = ws + WS_WK; }
                }
                else if (st == 13) { mode = 1; K = 256; A = r1a; B = kmat; }
                else if (st == 14) { mode = 2; K = 256; A = r2; B = vtm; ldb = 3072; }
                else if (st == 15) { A = r1a; B = ws + WS_WO; }
                else if (st == 16 || st == 18) { nM = 64; nN = 16; A = xb + (size_t)half * TP * DM; B = ws + WS_WUP; }
                else               { nM = 64; A = r1a; lda = 4096; ldb = 4096; K = 4096; B = ws + WS_WDOWN; }
                pg8::Sched S; S.init(nM, nN, mode, A, lda, B, ldb);
                if (mode == 3) { S.A2 = (const char*)(ws + WS_WV); S.B2 = (const char*)(ws + WS_MEMB); }
                const pg8::Gemm g{lda, ldb, K, ks_shift, seg};
                const bool resid = (st == 11 || st == 15 || st == 17 || st == 19);
                if (!resid) { const EpiT<0> EK{st, gi, l, ws, out, a}; pg8::gemm_phase(lds, g, S, EK);
#ifdef DUP_GEMM
                    pg8::gemm_phase(lds, g, S, EK);
#endif
#ifdef DUP_ATT
                    if (st == 13 || st == 14) pg8::gemm_phase(lds, g, S, EK);
#endif
#ifdef DUP_WIN
                    if (st == 1 || st == 8) pg8::gemm_phase(lds, g, S, EK);
#endif
                } else { const EpiT<1> EK{st, gi, l, ws, out, a}; pg8::gemm_phase(lds, g, S, EK); }
            }
#ifdef DUP_MISC
            if (st == 1) phase_dt(a, l, xb, ssq_in);
#endif
            if (st == 1) phase_dt(a, l, xb, ssq_in);
            if (st == 8) { phase_ssm_norm(a, l, r1b); phase_filter(a, l, lds, (float*)kmat); }
        }
        else if (st == 2 || st == 5) {
#ifdef DUP_SSD
            phase_s1(a, l, st == 2 ? 0 : 128, lds, r2, r3, r1a); __syncthreads();
#endif
            phase_s1(a, l, st == 2 ? 0 : 128, lds, r2, r3, r1a); }
        else if (st == 3 || st == 6) {
#ifdef DUP_SSD
            { int dry = 1; asm volatile("" : "+s"(dry)); phase_s2(a, st == 3 ? 0 : 128, r1a, dry); }
#endif
            int dry = 0; asm volatile("" : "+s"(dry)); phase_s2(a, st == 3 ? 0 : 128, r1a, dry); }
        else if (st == 4 || st == 7) {
#ifdef DUP_SSD
            { int dry = 1; asm volatile("" : "+s"(dry)); phase_s3(a, l, st == 4 ? 0 : 128, lds, r2, r3, r1a, r1b, dry); __syncthreads(); }
#endif
            int dry = 0; asm volatile("" : "+s"(dry)); phase_s3(a, l, st == 4 ? 0 : 128, lds, r2, r3, r1a, r1b, dry); }
        else if (st == 9) {
#ifdef DUP_FFT
            { int dry = 1; asm volatile("" : "+s"(dry)); phase_hyena_conv(a, l, lds, r1a, r3, (const float*)kmat, dry); __syncthreads(); }
#endif
            int dry = 0; asm volatile("" : "+s"(dry)); phase_hyena_conv(a, l, lds, r1a, r3, (const float*)kmat, dry); }
        else if (st == 10) {
#ifdef DUP_MISC
            phase_hyena_norm(a, l, lds, r2, r3, r1a); __syncthreads();
#endif
            phase_hyena_norm(a, l, lds, r2, r3, r1a); }
        if (ph == 0) grid.sync(); else xcd_barrier((unsigned*)(ws + WS_BAR), xst);
#ifdef DBG_TIME
        { const unsigned long long dt_ = __builtin_amdgcn_s_memrealtime() - t_begin; t_all += dt_;
          const int grp = st == 0 ? 0 : (st == 2 || st == 5) ? 1 : (st == 3 || st == 6) ? 2 : (st == 4 || st == 7) ? 3 : st == 9 ? 4 : st == 10 ? 5 : (st == 1 || st == 8) ? 6 : (st == 16 || st == 18) ? 8 : (st == 17 || st == 19) ? 9 : 7;
          if (grp == DBG_TIME) t_sel += dt_; }
#endif
#ifdef DBG_SCAN
#if !defined(S3_PROBE) && !defined(S3_PROBE2)
        dbg_scan(ws, out, ph); grid.sync();
#endif
#endif
    }
}

#include <cstdio>
extern "C" void kernel_launch(void* const* d_in, const int* in_sizes, int n_in, void* d_out, int out_size, void* d_ws, size_t ws_size, hipStream_t stream) {
    static int grid = 0;
    if (grid == 0) {
        int dev = 0, cus = 0, per_cu = 0;
        if (n_in != 33 || ws_size < WS_END || out_size != T_ALL * DM) { fprintf(stderr, "kernel_launch: unexpected shapes (n_in %d, ws %zu, out %d)\n", n_in, ws_size, out_size); grid = -1; return; }
        (void)hipGetDevice(&dev); (void)hipDeviceGetAttribute(&cus, hipDeviceAttributeMultiprocessorCount, dev);
        if (hipFuncSetAttribute((const void*)mega_fwd, hipFuncAttributeMaxDynamicSharedMemorySize, LDS_BYTES) != hipSuccess) { fprintf(stderr, "kernel_launch: hipFuncSetAttribute failed\n"); grid = -1; return; }
        if (hipOccupancyMaxActiveBlocksPerMultiprocessor(&per_cu, (const void*)mega_fwd, 512, LDS_BYTES) != hipSuccess || per_cu < 1) { fprintf(stderr, "kernel_launch: occupancy query gives %d\n", per_cu); (void)hipGetLastError(); grid = -1; return; }
        grid = cus;
    }
    if (grid < 0) return;
#ifdef DBG_SCAN
    (void)hipMemsetAsync(d_ws, 0xAA, WS_END, stream); (void)hipMemsetAsync(d_out, 0xAA, (size_t)T_ALL * DM * 4, stream);
#endif
    (void)hipMemsetAsync((unsigned char*)d_ws + WS_BAR, 0, XCD_BAR_WORDS * 4, stream);
    Args a{};
    for (int i = 0; i < 33; ++i) a.in[i] = (const float*)d_in[i];
    a.out = (float*)d_out; a.ws = (unsigned char*)d_ws;
    void* args[] = {&a};
    hipError_t e = hipLaunchCooperativeKernel((const void*)mega_fwd, dim3(grid), dim3(512), args, LDS_BYTES, stream);
    if (e != hipSuccess) fprintf(stderr, "cooperative launch failed: %s (grid %d)\n", hipGetErrorString(e), grid);
}
```

```cpp
#include <hip/hip_runtime.h>
#include <hip/hip_cooperative_groups.h>
namespace cg = cooperative_groups;

#define LAS __attribute__((address_space(3)))
typedef unsigned short bf16_t;
typedef short bf16x8 __attribute__((ext_vector_type(8)));
typedef float f32x4 __attribute__((ext_vector_type(4)));
typedef float f32x2 __attribute__((ext_vector_type(2)));
typedef unsigned u32x4 __attribute__((ext_vector_type(4)));
typedef unsigned u32x2 __attribute__((ext_vector_type(2)));

constexpr int T_ALL = 32768, TP = 16384, DM = 1024;
constexpr float EPS = 1e-5f;
constexpr size_t MiB = 1048576;
constexpr size_t WS_WHY = 0 * MiB, WS_WSSM = 3 * MiB, WS_WOUT = 6 * MiB, WS_WQ = 8 * MiB, WS_WK = 10 * MiB, WS_WV = 12 * MiB, WS_WO = 14 * MiB, WS_WUP = 16 * MiB, WS_WDOWN = 24 * MiB;
constexpr size_t WS_XB = 32 * MiB, WS_MEMB = 96 * MiB, WS_SSQ = 102 * MiB, WS_H2 = 103 * MiB, WS_TW = 106 * MiB, WS_WDT = 106 * MiB + 65536, WS_DECAY = 106 * MiB + 131072;
constexpr size_t WS_DT = 107 * MiB, WS_PSUM = 109 * MiB, WS_R1A = 111 * MiB, WS_R1B = 143 * MiB, WS_R2 = 175 * MiB, WS_R3 = 207 * MiB, WS_R4 = 239 * MiB, WS_END = 263 * MiB;
constexpr int LDS_BYTES = 153600;

typedef __bf16 bf16x2v __attribute__((ext_vector_type(2)));
__device__ __forceinline__ unsigned pk2(float lo, float hi) { const f32x2 v = {lo, hi}; const bf16x2v b = __builtin_convertvector(v, bf16x2v); return __builtin_bit_cast(unsigned, b); }
__device__ __forceinline__ float bflo(unsigned u) { return __uint_as_float(u << 16); }
__device__ __forceinline__ float bfhi(unsigned u) { return __uint_as_float(u & 0xffff0000u); }
__device__ __forceinline__ float bf2f(bf16_t b) { return __uint_as_float(((unsigned)b) << 16); }
__device__ __forceinline__ float wave_sum(float v) {
#pragma unroll
    for (int o = 32; o >= 1; o >>= 1) v += __shfl_xor(v, o);
    return v;
}
__device__ __forceinline__ int otid() { int t = (int)threadIdx.x; asm volatile("" : "+v"(t)); return t; }
constexpr float SSQ_SCALE = 4096.0f;
__device__ __forceinline__ float ssq_ld(const float* p) { return (float)__float_as_uint(*p) * (1.0f / SSQ_SCALE); }
__device__ __forceinline__ unsigned ssq_fx(float s) { return (unsigned)(s * SSQ_SCALE + 0.5f); }
#define LDS_WAIT() asm volatile("s_waitcnt lgkmcnt(0)" ::: "memory")

namespace pg8 {
constexpr int BM = 256, BK = 64, HALF = 128, HTB = HALF * BK * 2, STAGE_BYTES = 8 * HTB, NXCD = 8, WGM = 8;
__host__ __device__ __forceinline__ int lds_byte(int r, int c) { const int st = (r >> 4) * 2 + (c >> 5), rr = r & 15, cc = c & 31, ob = rr * 64 + cc * 2; return st * 1024 + (ob ^ (((ob >> 9) & 1) << 5)); }
__host__ __device__ __forceinline__ void stage_rc(int b, int& R, int& C) { const int st = b / 1024, sb = b % 1024, swz = sb ^ (((sb >> 9) & 1) << 5); R = (st >> 1) * 16 + swz / 64; C = (st & 1) * 32 + (swz % 64) / 2; }
__host__ __device__ __forceinline__ int perm32(int rho) { const int n = rho >> 4, i = rho & 15; return 8 * (i >> 2) + 4 * n + (i & 3); }
struct Unit { int pm, pn; };
struct Gemm { int lda, ldb, K, ks_shift; size_t seg_bytes; };
__device__ __forceinline__ int seq_of_pm(int pm) { return pm < 64 ? (pm >> 3) : 8 + ((pm - 64) >> 4); }
struct Sched {
    int nM, nN, nwg, G, c, mode;
    const char* A; const char* B; const char* A2; const char* B2; int lda, ldb;
    __device__ void init(int nM_, int nN_, int mode_, const void* A_, int lda_, const void* B_, int ldb_) { nM = nM_; nN = nN_; nwg = nM * nN; G = (int)gridDim.x; c = (int)blockIdx.x; mode = mode_; A = (const char*)A_; B = (const char*)B_; A2 = A; B2 = B; lda = lda_; ldb = ldb_; }
    __device__ bool next(int i, Unit& u) const {
        const long L = (long)i * G + c; if (L >= nwg) return false;
        if (mode == 3) { if (L < 48) { u.pm = (int)(L % 12); u.pn = (int)(L / 12); } else { const int r = (int)L - 48; u.pm = 64 + (r & 3); u.pn = r >> 2; } return true; }
        int wgid = (int)L; { const int q = nwg / NXCD, r = nwg % NXCD, xcd = wgid % NXCD, off = wgid / NXCD; wgid = (xcd < r ? xcd * (q + 1) : r * (q + 1) + (xcd - r) * q) + off; }
        const int nig = WGM * nN, gid = wgid / nig, fm = gid * WGM, gsz = (nM - fm) < WGM ? (nM - fm) : WGM;
        u.pm = fm + ((wgid % nig) % gsz); u.pn = (wgid % nig) / gsz; return true;
    }
    __device__ __forceinline__ const char* abase(const Unit& u) const {
        if (mode == 0) return A + (size_t)u.pm * 256 * lda * 2;
        if (mode == 3) return (u.pm < 64 ? A : A2) + (size_t)(u.pm & 63) * 256 * lda * 2;
        return A + ((size_t)u.pm * 256 * lda + (size_t)u.pn * 256) * 2;
    }
    __device__ __forceinline__ const char* bbase(const Unit& u) const {
        if (mode == 0) return B + (size_t)u.pn * 256 * ldb * 2;
        if (mode == 3) return (u.pm < 64 ? B : B2) + (size_t)u.pn * 256 * ldb * 2;
        if (mode == 1) return B + ((size_t)seq_of_pm(u.pm) * 256 * ldb + (size_t)u.pn * 256) * 2;
        return B + ((size_t)u.pn * 256 * ldb + (size_t)seq_of_pm(u.pm) * 256) * 2;
    }
};

template <class Epi>
__device__ __forceinline__ void gemm_phase(LAS unsigned char* lds, const Gemm g, const Sched& S, const Epi& E) {
    const int tid = otid(), wid = __builtin_amdgcn_readfirstlane(tid >> 6), lane = tid & 63, wr = wid >> 2, wc = wid & 3, fr = lane & 15, fq = lane >> 4;
    const int nt = g.K / BK;
    unsigned voffA[2], voffB[2];
#pragma unroll
    for (int i = 0; i < 2; ++i) { int R, C; stage_rc(tid * 16 + i * 8192, R, C); const int Rb = Epi::PERM ? ((R & ~31) + perm32(R & 31)) : R;
        voffA[i] = (unsigned)(R * g.lda + C) * 2u; voffB[i] = (unsigned)(Rb * g.ldb + C) * 2u; }
    const size_t kstep = (size_t)(BK * 2);
    const size_t hstepA = (size_t)HALF * g.lda * 2, hstepB = (size_t)HALF * g.ldb * 2;
    const int ksm = (1 << g.ks_shift) - 1;
#define PG8_AKT(p, t) ((p) + (size_t)((t) >> g.ks_shift) * g.seg_bytes + (size_t)((t) & ksm) * kstep)
    const unsigned ldsw = (unsigned)wid * 1024u;
    const int aoff = lds_byte(wr * 64 + fr, fq * 8), boff = lds_byte(wc * 32 + fr, fq * 8);
#define PG8_SA(b, h) (((b) * 2 + (h)) * HTB)
#define PG8_SB(b, h) ((4 + (b) * 2 + (h)) * HTB)
#define PG8_STAGE(bufoff, gbase, voff) do { _Pragma("unroll") for (int _i = 0; _i < 2; ++_i) \
        __builtin_amdgcn_global_load_lds((const unsigned*)((const char*)(gbase) + (voff)[_i]), (LAS unsigned*)(lds + (bufoff) + ldsw + _i * 8192), 16, 0, 0); } while (0)
#define PG8_LDA(dst, b, h) do { _Pragma("unroll") for (int m = 0; m < 4; ++m) _Pragma("unroll") for (int k = 0; k < 2; ++k) dst[m][k] = *(const LAS bf16x8*)(lds + PG8_SA(b, h) + aoff + m * 2048 + k * 1024); } while (0)
#define PG8_LDB(dst, b, h) do { _Pragma("unroll") for (int n = 0; n < 2; ++n) _Pragma("unroll") for (int k = 0; k < 2; ++k) dst[n][k] = *(const LAS bf16x8*)(lds + PG8_SB(b, h) + boff + n * 2048 + k * 1024); } while (0)
#define PG8_MMA(ai, bj, At, Bt) do { __builtin_amdgcn_s_setprio(1); _Pragma("unroll") for (int m = 0; m < 4; ++m) _Pragma("unroll") for (int n = 0; n < 2; ++n) _Pragma("unroll") for (int k = 0; k < 2; ++k) \
        acc[ai][bj][m][n] = __builtin_amdgcn_mfma_f32_16x16x32_bf16(Bt[n][k], At[m][k], acc[ai][bj][m][n], 0, 0, 0); __builtin_amdgcn_s_setprio(0); } while (0)
#define PG8_WAIT_V(n) asm volatile("s_waitcnt vmcnt(" #n ")" ::: "memory")
#define PG8_WAIT_L(n) asm volatile("s_waitcnt lgkmcnt(" #n ")" ::: "memory")
#define PG8_BAR __builtin_amdgcn_s_barrier()
#define PG8_SCHED __builtin_amdgcn_sched_barrier(0)
    Unit cur, nxt; int ui = 0;
    if (!S.next(0, cur)) return;
    f32x4 acc[2][2][4][2];
#pragma unroll
    for (int a = 0; a < 2; ++a)
#pragma unroll
        for (int b = 0; b < 2; ++b)
#pragma unroll
            for (int m = 0; m < 4; ++m)
#pragma unroll
                for (int n = 0; n < 2; ++n) acc[a][b][m][n] = (f32x4){0.f, 0.f, 0.f, 0.f};
    bf16x8 At[4][2], B0[2][2], B1[2][2];
    const char* cA = S.abase(cur); const char* cB = S.bbase(cur);
    PG8_STAGE(PG8_SB(0, 0), cB, voffB); PG8_STAGE(PG8_SA(0, 0), cA, voffA); PG8_STAGE(PG8_SB(0, 1), cB + hstepB, voffB); PG8_STAGE(PG8_SA(0, 1), cA + hstepA, voffA);
    if (wr == 1) PG8_BAR;
    PG8_WAIT_V(4); PG8_BAR;
    PG8_STAGE(PG8_SB(1, 0), cB + kstep, voffB); PG8_STAGE(PG8_SA(1, 0), PG8_AKT(cA, 1), voffA); PG8_STAGE(PG8_SB(1, 1), cB + hstepB + kstep, voffB);
    PG8_WAIT_V(6); PG8_BAR;
    for (;;) {
        const bool has_next = S.next(ui + 1, nxt);
        const char* nA = has_next ? S.abase(nxt) : cA; const char* nB = has_next ? S.bbase(nxt) : cB;
        for (int t = 0; t < nt; t += 2) {
            const bool last = (t == nt - 2);
            const char* a1 = PG8_AKT(cA, t + 1);
            const char* a2 = last ? nA : PG8_AKT(cA, t + 2); const char* b2 = last ? nB : cB + (size_t)(t + 2) * kstep;
            const char* a3 = last ? PG8_AKT(nA, 1) : PG8_AKT(cA, t + 3); const char* b3 = b2 + kstep;
            PG8_LDB(B0, 0, 0); PG8_SCHED; PG8_LDA(At, 0, 0); PG8_STAGE(PG8_SA(1, 1), a1 + hstepA, voffA);
            PG8_WAIT_L(8); PG8_BAR; PG8_WAIT_L(0); PG8_MMA(0, 0, At, B0); PG8_BAR; PG8_SCHED;
            PG8_LDB(B1, 0, 1); PG8_STAGE(PG8_SB(0, 0), b2, voffB);
            PG8_BAR; PG8_WAIT_L(0); PG8_MMA(0, 1, At, B1); PG8_BAR;
            PG8_LDA(At, 0, 1); PG8_STAGE(PG8_SA(0, 0), a2, voffA);
            PG8_BAR; PG8_WAIT_L(0); PG8_MMA(1, 0, At, B0); PG8_BAR; PG8_SCHED;
            PG8_STAGE(PG8_SB(0, 1), b2 + hstepB, voffB);
            PG8_WAIT_V(6); PG8_BAR; PG8_MMA(1, 1, At, B1); PG8_BAR;
            PG8_LDB(B0, 1, 0); PG8_SCHED; PG8_LDA(At, 1, 0); PG8_STAGE(PG8_SA(0, 1), a2 + hstepA, voffA);
            PG8_WAIT_L(8); PG8_BAR; PG8_WAIT_L(0); PG8_MMA(0, 0, At, B0); PG8_BAR; PG8_SCHED;
            PG8_LDB(B1, 1, 1); PG8_STAGE(PG8_SB(1, 0), b3, voffB);
            PG8_BAR; PG8_WAIT_L(0); PG8_MMA(0, 1, At, B1); PG8_BAR;
            PG8_LDA(At, 1, 1); PG8_STAGE(PG8_SA(1, 0), a3, voffA);
            PG8_BAR; PG8_WAIT_L(0); PG8_MMA(1, 0, At, B0); PG8_BAR; PG8_SCHED;
            PG8_STAGE(PG8_SB(1, 1), b3 + hstepB, voffB);
            PG8_WAIT_V(6); PG8_BAR; PG8_MMA(1, 1, At, B1); PG8_BAR;
        }
        E(acc, cur, wr, wc, fr, fq);
        if (!has_next) break;
#pragma unroll
        for (int a = 0; a < 2; ++a)
#pragma unroll
            for (int b = 0; b < 2; ++b)
#pragma unroll
                for (int m = 0; m < 4; ++m)
#pragma unroll
                    for (int n = 0; n < 2; ++n) acc[a][b][m][n] = (f32x4){0.f, 0.f, 0.f, 0.f};
        cur = nxt; cA = nA; cB = nB; ++ui;
    }
    PG8_WAIT_V(0);
    if (wr == 0) PG8_BAR;
    PG8_BAR;
#undef PG8_AKT
#undef PG8_SA
#undef PG8_SB
#undef PG8_STAGE
#undef PG8_LDA
#undef PG8_LDB
#undef PG8_MMA
#undef PG8_WAIT_V
#undef PG8_WAIT_L
#undef PG8_BAR
#undef PG8_SCHED
}
}
struct Epi {
    int kind;
    static constexpr bool PERM = true;
    bf16_t* O0; long long d1, d2; int ldc; int csplit, rsplit;
    const float* ssq; float* psum; int row_off; int SCALE, ACT;
    __device__ __forceinline__ void bf_path(const f32x4 (&acc)[2][2][4][2], const pg8::Unit& u, int wr, int wc, int fr, int fq) const {
        int pm = u.pm, pn = u.pn, ai_ = 0;
        if (csplit) { ai_ = pn / csplit; pn = pn % csplit; }
        if (rsplit) { ai_ = pm / rsplit; pm = pm % rsplit; }
        bf16_t* base = O0 + (ai_ >= 1 ? d1 : 0ll) + (ai_ >= 2 ? d2 : 0ll);
        const int lrow0 = pm * 256 + wr * 64 + fr, grow0 = u.pm * 256 + wr * 64 + fr, lcol0 = pn * 256 + wc * 32 + 8 * fq, gcol0 = u.pn * 256 + wc * 32 + 8 * fq;
        f32x4 cs[2][2];
        if (SCALE == 2) {
#pragma unroll
            for (int bj = 0; bj < 2; ++bj)
#pragma unroll
                for (int n = 0; n < 2; ++n) { const u32x4 qu = *(const u32x4*)(ssq + gcol0 + bj * 128 + 4 * n); f32x4 q;
#pragma unroll
                    for (int j = 0; j < 4; ++j) q[j] = rsqrtf((float)qu[j] * (1.0f / SSQ_SCALE) * (1.0f / 1024.0f) + EPS);
                    cs[bj][n] = q; }
        }
        float rsv[2][4];
#pragma unroll
        for (int ai = 0; ai < 2; ++ai)
#pragma unroll
            for (int m = 0; m < 4; ++m) { const int grow = grow0 + ai * 128 + m * 16; float rs = 1.0f;
                if (SCALE == 1) rs = rsqrtf(ssq_ld(ssq + grow + row_off) * (1.0f / 1024.0f) + EPS);
                if (SCALE == 3) { const f32x4 q = *(const f32x4*)(psum + ((size_t)grow * 4 + u.pn) * 4); rs = __builtin_amdgcn_rcpf((q[0] + q[1]) + (q[2] + q[3])); }
                rsv[ai][m] = rs; }
#pragma unroll
        for (int ai = 0; ai < 2; ++ai)
#pragma unroll
            for (int m = 0; m < 4; ++m) {
                const int grow = grow0 + ai * 128 + m * 16;
                const float rs = rsv[ai][m];
                bf16_t* rowp = base + (size_t)(lrow0 + ai * 128 + m * 16) * ldc + lcol0;
                float psacc = 0.f;
#pragma unroll
                for (int bj = 0; bj < 2; ++bj) {
                    f32x4 v0 = acc[ai][bj][m][0], v1 = acc[ai][bj][m][1];
                    if (SCALE == 1 || SCALE == 3) { v0 = v0 * rs; v1 = v1 * rs; }
                    if (SCALE == 2) { v0 = v0 * cs[bj][0]; v1 = v1 * cs[bj][1]; }
                    if (ACT == 1) {
#pragma unroll
                        for (int j = 0; j < 4; ++j) { const float a0 = fmaxf(v0[j], 0.f), a1 = fmaxf(v1[j], 0.f); v0[j] = a0 * a0; v1[j] = a1 * a1; } }
                    if (ACT == 2) {
#pragma unroll
                        for (int j = 0; j < 4; ++j) { v0[j] = __expf(v0[j]); v1[j] = __expf(v1[j]); }
                        psacc += ((v0[0] + v0[1]) + (v0[2] + v0[3])) + ((v1[0] + v1[1]) + (v1[2] + v1[3])); }
                    u32x4 w; w.x = pk2(v0[0], v0[1]); w.y = pk2(v0[2], v0[3]); w.z = pk2(v1[0], v1[1]); w.w = pk2(v1[2], v1[3]);
                    *(u32x4*)(rowp + bj * 128) = w;
                }
                if (ACT == 2) { psacc += __shfl_xor(psacc, 16); psacc += __shfl_xor(psacc, 32); if (fq == 0) psum[((size_t)grow * 4 + u.pn) * 4 + wc] = psacc; }
            }
    }
    float* X; const float* rin0; const float* rin1; bf16_t* xb; float* ssq_out; int rin_bf16, write_x, write_xb;
    __device__ __forceinline__ void operator()(const f32x4 (&acc)[2][2][4][2], const pg8::Unit& u, int wr, int wc, int fr, int fq) const {
        if (kind == 0) bf_path(acc, u, wr, wc, fr, fq); else res_path(acc, u, wr, wc, fr, fq);
    }
    __device__ __forceinline__ void res_path(const f32x4 (&acc)[2][2][4][2], const pg8::Unit& u, int wr, int wc, int fr, int fq) const {
        const int row0 = u.pm * 256 + wr * 64 + fr + row_off, col0 = u.pn * 256 + wc * 32 + 8 * fq;
#pragma unroll
        for (int ai = 0; ai < 2; ++ai) {
            f32x4 rr[4][2][2];
#pragma unroll
            for (int m = 0; m < 4; ++m) { const int row = row0 + ai * 128 + m * 16;
                if (rin_bf16) {
                    const bf16_t* bq = xb + (size_t)row * DM + col0;
#pragma unroll
                    for (int bj = 0; bj < 2; ++bj) { const u32x4 q = *(const u32x4*)(bq + bj * 128);
                        rr[m][bj][0] = (f32x4){bflo(q.x), bfhi(q.x), bflo(q.y), bfhi(q.y)}; rr[m][bj][1] = (f32x4){bflo(q.z), bfhi(q.z), bflo(q.w), bfhi(q.w)}; }
                } else {
                    const float* rp = (row < TP ? rin0 + (size_t)row * DM : rin1 + (size_t)(row - TP) * DM) + col0;
#pragma unroll
                    for (int bj = 0; bj < 2; ++bj) { rr[m][bj][0] = *(const f32x4*)(rp + bj * 128); rr[m][bj][1] = *(const f32x4*)(rp + bj * 128 + 4); } } }
#pragma unroll
            for (int m = 0; m < 4; ++m) {
                const int row = row0 + ai * 128 + m * 16;
                float* xp = X + (size_t)row * DM + col0; bf16_t* bp = xb + (size_t)row * DM + col0;
                float sq = 0.f;
#pragma unroll
                for (int bj = 0; bj < 2; ++bj) {
                    const f32x4 v0 = acc[ai][bj][m][0] + rr[m][bj][0], v1 = acc[ai][bj][m][1] + rr[m][bj][1];
                    if (write_x) { *(f32x4*)(xp + bj * 128) = v0; *(f32x4*)(xp + bj * 128 + 4) = v1; }
                    u32x4 w; w.x = pk2(v0[0], v0[1]); w.y = pk2(v0[2], v0[3]); w.z = pk2(v1[0], v1[1]); w.w = pk2(v1[2], v1[3]);
                    if (write_xb) *(u32x4*)(bp + bj * 128) = w;
                    sq += ((v0[0] * v0[0] + v0[1] * v0[1]) + (v0[2] * v0[2] + v0[3] * v0[3])) + ((v1[0] * v1[0] + v1[1] * v1[1]) + (v1[2] * v1[2] + v1[3] * v1[3]));
                }
                sq += __shfl_xor(sq, 16); sq += __shfl_xor(sq, 32);
                if (fq == 0) atomicAdd((unsigned*)(ssq_out + row), ssq_fx(sq));
            }
        }
    }
};

struct Args { const float* in[33]; float* out; unsigned char* ws; };
typedef const __attribute__((address_space(4))) Args* ArgsP;
enum { I_XP = 0, I_XS, I_MP, I_MS, I_NMIX, I_WIN, I_HCW, I_HCB, I_FW1, I_FB1, I_FW2, I_FB2, I_FW3, I_FB3, I_FREQ, I_HBIAS, I_HNORM, I_SCW, I_SCB, I_DTB, I_ALOG, I_SD, I_SNORM,
       I_WOUT, I_NXA, I_NMEM, I_WQ, I_WKV, I_WO, I_NMLP, I_WUP, I_WDOWN, I_NFIN };

__device__ __forceinline__ void transpose_item(const float* W, int K, int N, bf16_t* WT, int n0, int k0, int dst_row0, const float* ksc, float gs, LAS float* scr, int lane) {
#pragma unroll 32
    for (int kk = 0; kk < 64; ++kk) { float v = W[(size_t)(k0 + kk) * N + n0 + lane] * gs; if (ksc) v *= ksc[k0 + kk]; scr[kk * 65 + lane] = v; }
    LDS_WAIT();
    const int c = lane & 7;
#pragma unroll
    for (int j = 0; j < 8; ++j) { const int n = (lane >> 3) + 8 * j; const LAS float* sp = scr + (8 * c) * 65 + n;
        u32x4 o; o.x = pk2(sp[0 * 65], sp[1 * 65]); o.y = pk2(sp[2 * 65], sp[3 * 65]); o.z = pk2(sp[4 * 65], sp[5 * 65]); o.w = pk2(sp[6 * 65], sp[7 * 65]);
        *(u32x4*)(WT + (size_t)(dst_row0 + n) * K + k0 + 8 * c) = o; }
    LDS_WAIT();
}
__device__ __forceinline__ void phase_wconv(ArgsP a, int l, LAS unsigned char* lds) {
    const int lane = otid() & 63, wave = otid() >> 6, gw = blockIdx.x * 8 + wave, NGW = gridDim.x * 8;
    LAS float* scr = (LAS float*)(lds + wave * 16896);
    unsigned char* ws = a->ws;
    constexpr int I_IN = 16 * 48, I_OUT = 16 * 16, I_Q = 16 * 16, I_KV = 16 * 32, I_O = 16 * 16, I_UP = 16 * 64, I_DN = 64 * 16;
    constexpr int NIT = I_IN + I_OUT + I_Q + I_KV + I_O + I_UP + I_DN;
    for (int it = gw; it < NIT; it += NGW) {
        int r = it;
        if (r < I_IN) { const int kb = r / 48, nb = r % 48, n0 = nb * 64;
            if (n0 < 1536) transpose_item(a->in[I_WIN] + (size_t)l * 1024 * 3088, 1024, 3088, (bf16_t*)(ws + WS_WHY), n0, kb * 64, n0, a->in[I_NMIX] + l * 1024, 1.f, scr, lane);
            else transpose_item(a->in[I_WIN] + (size_t)l * 1024 * 3088, 1024, 3088, (bf16_t*)(ws + WS_WSSM), n0, kb * 64, n0 - 1536, a->in[I_NMIX] + l * 1024, 1.f, scr, lane);
            continue; } r -= I_IN;
        if (r < I_OUT) { const int kb = r / 16, nb = r % 16; transpose_item(a->in[I_WOUT] + (size_t)l * 1024 * 1024, 1024, 1024, (bf16_t*)(ws + WS_WOUT), nb * 64, kb * 64, nb * 64, nullptr, 1.f, scr, lane); continue; } r -= I_OUT;
        if (r < I_Q) { const int kb = r / 16, nb = r % 16; transpose_item(a->in[I_WQ] + (size_t)l * 1024 * 1024, 1024, 1024, (bf16_t*)(ws + WS_WQ), nb * 64, kb * 64, nb * 64, a->in[I_NXA] + l * 1024, 0.0625f, scr, lane); continue; } r -= I_Q;
        if (r < I_KV) { const int kb = r / 32, nb = r % 32, n0 = nb * 64;
            if (n0 < 1024) transpose_item(a->in[I_WKV] + (size_t)l * 1024 * 2048, 1024, 2048, (bf16_t*)(ws + WS_WK), n0, kb * 64, n0, a->in[I_NMEM] + l * 1024, 1.f, scr, lane);
            else transpose_item(a->in[I_WKV] + (size_t)l * 1024 * 2048, 1024, 2048, (bf16_t*)(ws + WS_WV), n0, kb * 64, n0 - 1024, a->in[I_NMEM] + l * 1024, 1.f, scr, lane);
            continue; } r -= I_KV;
        if (r < I_O) { const int kb = r / 16, nb = r % 16; transpose_item(a->in[I_WO] + (size_t)l * 1024 * 1024, 1024, 1024, (bf16_t*)(ws + WS_WO), nb * 64, kb * 64, nb * 64, nullptr, 1.f, scr, lane); continue; } r -= I_O;
        if (r < I_UP) { const int kb = r / 64, nb = r % 64; transpose_item(a->in[I_WUP] + (size_t)l * 1024 * 4096, 1024, 4096, (bf16_t*)(ws + WS_WUP), nb * 64, kb * 64, nb * 64, a->in[I_NMLP] + l * 1024, 1.f, scr, lane); continue; } r -= I_UP;
        { const int kb = r / 16, nb = r % 16; transpose_item(a->in[I_WDOWN] + (size_t)l * 4096 * 1024, 4096, 1024, (bf16_t*)(ws + WS_WDOWN), nb * 64, kb * 64, nb * 64, nullptr, 1.f, scr, lane); }
    }
    bf16_t* wdt = (bf16_t*)(ws + WS_WDT);
    for (int i = blockIdx.x * 512 + otid(); i < 16 * 512; i += gridDim.x * 512) { const int j = i >> 9, k = (i & 511) * 2;
        const float v0 = a->in[I_NMIX][l * 1024 + k] * a->in[I_WIN][((size_t)l * 1024 + k) * 3088 + 3072 + j], v1 = a->in[I_NMIX][l * 1024 + k + 1] * a->in[I_WIN][((size_t)l * 1024 + k + 1) * 3088 + 3072 + j];
        *(unsigned*)(wdt + j * 1024 + k) = pk2(v0, v1); }
}
__device__ __forceinline__ const float* xin_row(ArgsP a, int t) { return t < TP ? a->in[I_XP] + (size_t)t * DM : a->in[I_XS] + (size_t)(t - TP) * DM; }

__device__ __forceinline__ void phase_prologue(ArgsP a, LAS unsigned char* lds) {
    const int lane = otid() & 63, wave = otid() >> 6, gw = blockIdx.x * 8 + wave, NGW = gridDim.x * 8;
    unsigned char* ws = a->ws;
    float* ssq = (float*)(ws + WS_SSQ);
    for (int i = blockIdx.x * 512 + otid(); i < 6 * T_ALL; i += gridDim.x * 512) ssq[T_ALL + i] = 0.f;
    { f32x2* tw = (f32x2*)(ws + WS_TW); for (int i = blockIdx.x * 512 + otid(); i < 4096; i += gridDim.x * 512) { float s, c; sincospif(-(float)i * (1.0f / 4096.0f), &s, &c); tw[i] = (f32x2){c, s}; } }
    bf16_t* xb = (bf16_t*)(ws + WS_XB);
    for (int t = gw; t < T_ALL; t += 2 * NGW) {
        f32x4 v[2][4];
#pragma unroll
        for (int r = 0; r < 2; ++r) { const f32x4* xr = (const f32x4*)xin_row(a, t + r * NGW) + lane;
#pragma unroll
            for (int j = 0; j < 4; ++j) v[r][j] = xr[64 * j]; }
#pragma unroll
        for (int r = 0; r < 2; ++r) { float s = 0.f; u32x2* o = (u32x2*)(xb + (size_t)(t + r * NGW) * DM) + lane;
#pragma unroll
            for (int j = 0; j < 4; ++j) { const f32x4 x = v[r][j]; s += (x[0] * x[0] + x[1] * x[1]) + (x[2] * x[2] + x[3] * x[3]); u32x2 w; w.x = pk2(x[0], x[1]); w.y = pk2(x[2], x[3]); o[64 * j] = w; }
            s = wave_sum(s); if (lane == 0) ssq[t + r * NGW] = __uint_as_float(ssq_fx(s)); }
    }
    bf16_t* memb = (bf16_t*)(ws + WS_MEMB);
    for (int t = gw; t < 3072; t += NGW) {
        const float* mr = t < 2048 ? a->in[I_MP] + (size_t)t * DM : a->in[I_MS] + (size_t)(t - 2048) * DM;
        const f32x4* xr = (const f32x4*)mr + lane; f32x4 v[4]; float s = 0.f;
#pragma unroll
        for (int j = 0; j < 4; ++j) { v[j] = xr[64 * j]; s += (v[j][0] * v[j][0] + v[j][1] * v[j][1]) + (v[j][2] * v[j][2] + v[j][3] * v[j][3]); }
        const float rs = rsqrtf(wave_sum(s) * (1.0f / 1024.0f) + EPS);
        u32x2* o = (u32x2*)(memb + (size_t)t * DM) + lane;
#pragma unroll
        for (int j = 0; j < 4; ++j) { u32x2 w; w.x = pk2(v[j][0] * rs, v[j][1] * rs); w.y = pk2(v[j][2] * rs, v[j][3] * rs); o[64 * j] = w; }
    }
    float* h2 = (float*)(ws + WS_H2);
    for (int idx = gw; idx < 2 * 6144; idx += NGW) {
        const int l = idx / 6144, r = idx % 6144, set = r >= 2048 ? 1 : 0, t = set ? r - 2048 : r, L = set ? 4096 : 2048;
        const float tl = (float)t / (float)(L - 1), w = (6.283185307179586f / (float)L) * (float)t;
        const float fm = 1e-4f + (float)(lane & 15) * ((15.0f - 1e-4f) / 15.0f);
        float sv, cv; sincosf(fm * w, &sv, &cv);
        const float* fw1 = a->in[I_FW1] + l * 33 * 64; const float* fw2 = a->in[I_FW2] + l * 64 * 64;
        float acc = a->in[I_FB1][l * 64 + lane] + tl * fw1[lane];
#pragma unroll
        for (int i = 0; i < 16; ++i) { acc += __shfl(cv, i) * fw1[(1 + i) * 64 + lane]; acc -= __shfl(sv, i) * fw1[(17 + i) * 64 + lane]; }
        const float fr = a->in[I_FREQ][l * 64 + lane];
        const float h1 = sinf(fr * acc);
        float acc2 = a->in[I_FB2][l * 64 + lane];
#pragma unroll 8
        for (int i = 0; i < 64; ++i) acc2 += __shfl(h1, i) * fw2[i * 64 + lane];
        h2[(size_t)idx * 64 + lane] = sinf(fr * acc2);
    }
}
__device__ __forceinline__ void phase_dt(ArgsP a, int l, const bf16_t* xb, const float* ssq_in) {
    const int tid = otid(), lane = tid & 63, wave = tid >> 6, gw = blockIdx.x * 8 + wave, NGW = gridDim.x * 8, fr = lane & 15, fq = lane >> 4;
    const bf16_t* wdt = (const bf16_t*)(a->ws + WS_WDT); float* dt = (float*)(a->ws + WS_DT);
    for (int tile = gw; tile < T_ALL / 16; tile += NGW) {
        const int t0 = tile * 16;
        const bf16_t* ap = xb + (size_t)(t0 + fr) * DM + fq * 8; const bf16_t* bp = wdt + fr * 1024 + fq * 8;
        f32x4 acc = {0.f, 0.f, 0.f, 0.f};
#pragma unroll 16
        for (int ks = 0; ks < 32; ++ks) acc = __builtin_amdgcn_mfma_f32_16x16x32_bf16(*(const bf16x8*)(ap + ks * 32), *(const bf16x8*)(bp + ks * 32), acc, 0, 0, 0);
        const float bias = a->in[I_DTB][l * 16 + fr];
#pragma unroll
        for (int r = 0; r < 4; ++r) { const int t = t0 + fq * 4 + r; const float x = acc[r] * rsqrtf(ssq_ld(ssq_in + t) * (1.0f / 1024.0f) + EPS) + bias; dt[(size_t)t * 16 + fr] = x > 20.f ? x : log1pf(expf(x)); }
    }
}
__device__ __forceinline__ void phase_final(ArgsP a, const float* ssq, const bf16_t* xb) {
    const int lane = otid() & 63, wave = otid() >> 6, gw = blockIdx.x * 8 + wave, NGW = gridDim.x * 8;
    f32x4 g[4];
#pragma unroll
    for (int j = 0; j < 4; ++j) g[j] = *((const f32x4*)a->in[I_NFIN] + lane + 64 * j);
    for (int t = gw; t < T_ALL; t += 4 * NGW) {
        u32x2 q[4][4]; float rs[4];
#pragma unroll
        for (int r = 0; r < 4; ++r) { const int tr = t + r * NGW; rs[r] = rsqrtf(ssq_ld(ssq + tr) * (1.0f / 1024.0f) + EPS);
            const u32x2* xr = (const u32x2*)(xb + (size_t)tr * DM) + lane;
#pragma unroll
            for (int j = 0; j < 4; ++j) q[r][j] = xr[64 * j]; }
#pragma unroll
        for (int r = 0; r < 4; ++r) { f32x4* orow = (f32x4*)(a->out + (size_t)(t + r * NGW) * DM) + lane;
#pragma unroll
            for (int j = 0; j < 4; ++j) orow[64 * j] = (f32x4){bflo(q[r][j].x), bfhi(q[r][j].x), bflo(q[r][j].y), bfhi(q[r][j].y)} * rs[r] * g[j]; }
    }
}
__device__ __forceinline__ void phase_ssm_norm(ArgsP a, int l, bf16_t* buf) {
    const int lane = otid() & 63, wave = otid() >> 6, gw = blockIdx.x * 8 + wave, NGW = gridDim.x * 8;
    const float* gn = a->in[I_SNORM] + l * 512 + lane * 8;
    float g[8];
#pragma unroll
    for (int j = 0; j < 8; ++j) g[j] = gn[j];
    for (int t = gw; t < T_ALL; t += 4 * NGW) {
        u32x4 wv[4];
#pragma unroll
        for (int q = 0; q < 4; ++q) wv[q] = *((const u32x4*)(buf + (size_t)(t + q * NGW) * 512) + lane);
#pragma unroll
        for (int q = 0; q < 4; ++q) { const u32x4 w = wv[q];
            float v[8] = {bflo(w.x), bfhi(w.x), bflo(w.y), bfhi(w.y), bflo(w.z), bfhi(w.z), bflo(w.w), bfhi(w.w)};
            float s = 0.f;
#pragma unroll
            for (int j = 0; j < 8; ++j) s += v[j] * v[j];
            const float rs = rsqrtf(wave_sum(s) * (1.0f / 512.0f) + EPS);
            u32x4 o; o.x = pk2(v[0] * rs * g[0], v[1] * rs * g[1]); o.y = pk2(v[2] * rs * g[2], v[3] * rs * g[3]); o.z = pk2(v[4] * rs * g[4], v[5] * rs * g[5]); o.w = pk2(v[6] * rs * g[6], v[7] * rs * g[7]);
            *((u32x4*)(buf + (size_t)(t + q * NGW) * 512) + lane) = o; }
    }
}
constexpr int SLD = 136;
__device__ __forceinline__ void seq_bounds(int t0, int& lo, int& hi) { if (t0 < TP) { lo = t0 & ~2047; hi = lo + 2048; } else { lo = TP + ((t0 - TP) & ~4095); hi = lo + 4096; } }
__device__ __forceinline__ float silu_f(float x) { return x * __builtin_amdgcn_rcpf(1.0f + __expf(-x)); }

template <int NC, bool TRANS>
__device__ __forceinline__ void load_conv_tile(const bf16_t* src, int ldsrc, int col0, int t0, int lo, int hi, const float* cw, const float* cbias, int ch0, LAS bf16_t* dst) {
    constexpr int CGS = NC / 8, RUNS = 512 / CGS, R = 128 / RUNS;
    const int tid = otid(), cgi = tid % CGS, run = tid / CGS, c = cgi * 8, r0 = run * R;
    float w[5][8], bb[8];
#pragma unroll
    for (int k = 0; k < 5; ++k) { const f32x4 a0 = *(const f32x4*)(cw + k * 1024 + ch0 + c), a1 = *(const f32x4*)(cw + k * 1024 + ch0 + c + 4);
#pragma unroll
        for (int e = 0; e < 4; ++e) { w[k][e] = a0[e]; w[k][4 + e] = a1[e]; } }
    { const f32x4 a0 = *(const f32x4*)(cbias + ch0 + c), a1 = *(const f32x4*)(cbias + ch0 + c + 4);
#pragma unroll
      for (int e = 0; e < 4; ++e) { bb[e] = a0[e]; bb[4 + e] = a1[e]; } }
    u32x4 raw[R + 4];
#pragma unroll
    for (int i = 0; i < R + 4; ++i) { const int t = t0 + r0 - 2 + i, tc = t < lo ? lo : (t >= hi ? hi - 1 : t);
        u32x4 q = *(const u32x4*)(src + (size_t)tc * ldsrc + col0 + c);
        if (t < lo || t >= hi) q = (u32x4){0u, 0u, 0u, 0u};
        raw[i] = q; }
    float win[5][8];
    auto cvrow = [&](const u32x4 q, float (&o)[8]) { o[0] = bflo(q.x); o[1] = bfhi(q.x); o[2] = bflo(q.y); o[3] = bfhi(q.y); o[4] = bflo(q.z); o[5] = bfhi(q.z); o[6] = bflo(q.w); o[7] = bfhi(q.w); };
#pragma unroll
    for (int i = 0; i < 4; ++i) cvrow(raw[i], win[i]);
    unsigned outp[8][R / 2];
#pragma unroll
    for (int rr = 0; rr < R; ++rr) {
        cvrow(raw[rr + 4], win[(rr + 4) % 5]);
        float o[8];
#pragma unroll
        for (int e = 0; e < 8; ++e) { float s = bb[e];
#pragma unroll
            for (int k = 0; k < 5; ++k) s += w[k][e] * win[(rr + k) % 5][e];
            o[e] = silu_f(s); }
        if (!TRANS) { u32x4 q; q.x = pk2(o[0], o[1]); q.y = pk2(o[2], o[3]); q.z = pk2(o[4], o[5]); q.w = pk2(o[6], o[7]); *(LAS u32x4*)(dst + (r0 + rr) * SLD + c) = q; }
        else {
#pragma unroll
            for (int e = 0; e < 8; ++e) { if (rr & 1) outp[e][rr >> 1] = (outp[e][rr >> 1] & 0xffffu) | (pk2(0.f, o[e]) & 0xffff0000u); else outp[e][rr >> 1] = pk2(o[e], 0.f) & 0xffffu; } }
    }
    if (TRANS) {
#pragma unroll
        for (int e = 0; e < 8; ++e) {
            if (R == 8) { u32x4 q; q.x = outp[e][0]; q.y = outp[e][1]; q.z = outp[e][2]; q.w = outp[e][R / 2 - 1]; *(LAS u32x4*)(dst + (c + e) * SLD + r0) = q; }
            else { u32x2 q; q.x = outp[e][0]; q.y = outp[e][R / 2 - 1]; *(LAS u32x2*)(dst + (c + e) * SLD + r0) = q; }
        }
    }
}
__device__ __forceinline__ void chunk_scan(const float* dt, int t0, int col, float A, int dir, int lane, float& d0, float& d1, float& c0, float& c1, float& total) {
    d0 = dt[(size_t)(t0 + 2 * lane) * 16 + col]; d1 = dt[(size_t)(t0 + 2 * lane + 1) * 16 + col];
    const float a0 = d0 * A, a1 = d1 * A;
    float v = a0 + a1;
#pragma unroll
    for (int d = 1; d < 64; d <<= 1) { const float tt = __shfl_up(v, d); if (lane >= d) v += tt; }
    total = __shfl(v, 63);
    const float p0 = v - a1, p1 = v;
    if (dir == 0) { c0 = p0; c1 = p1; } else { c0 = total - p0 + a0; c1 = total - p1 + a1; }
}
__device__ __forceinline__ bf16x8 scale_frag8(bf16x8 f, const float (&sc)[8]) {
    union { bf16x8 v; unsigned u[4]; } in, out; in.v = f;
#pragma unroll
    for (int j = 0; j < 4; ++j) out.u[j] = pk2(bflo(in.u[j]) * sc[2 * j], bfhi(in.u[j]) * sc[2 * j + 1]);
    return out.v;
}
__device__ __forceinline__ void phase_s1(ArgsP a, int l, int cbase, LAS unsigned char* lds, const bf16_t* xs_raw, const bf16_t* bc_raw, bf16_t* states) {
    const int tid = otid(), lane = tid & 63, wave = __builtin_amdgcn_readfirstlane(tid >> 6);
    LAS bf16_t* xsT = (LAS bf16_t*)lds;
    LAS bf16_t* BT = (LAS bf16_t*)(lds + 256 * SLD * 2);
    LAS float* sW = (LAS float*)(lds + 384 * SLD * 2);
    const float* dt = (const float*)(a->ws + WS_DT); float* decay = (float*)(a->ws + WS_DECAY);
    const float* cw = a->in[I_SCW] + l * 5 * 1024; const float* cbs = a->in[I_SCB] + l * 1024;
    for (int it = blockIdx.x; it < 256; it += gridDim.x) {
        const int gc = cbase + (it >> 1), g = it & 1, t0 = gc * 128; int lo, hi; seq_bounds(t0, lo, hi);
        const int hh = wave >> 1, dir = wave & 1, h8 = g * 4 + hh;
        { float d0, d1, c0, c1, tot; const float A = -__expf(a->in[I_ALOG][l * 16 + dir * 8 + h8]);
          chunk_scan(dt, t0, dir * 8 + h8, A, dir, lane, d0, d1, c0, c1, tot);
          sW[wave * 128 + 2 * lane] = d0 * __expf(tot - c0); sW[wave * 128 + 2 * lane + 1] = d1 * __expf(tot - c1);
          if (lane == 0) decay[gc * 16 + h8 * 2 + dir] = __expf(tot); }
        load_conv_tile<256, true>(xs_raw, 512, g * 256, t0, lo, hi, cw, cbs, g * 256, xsT);
        load_conv_tile<128, true>(bc_raw, 512, g * 128, t0, lo, hi, cw, cbs, 512 + g * 128, BT);
        __syncthreads();
        f32x4 acc[8][4];
#pragma unroll
        for (int i = 0; i < 8; ++i)
#pragma unroll
            for (int j = 0; j < 4; ++j) acc[i][j] = (f32x4){0.f, 0.f, 0.f, 0.f};
        const int fr = lane & 15, fq = lane >> 4;
#pragma unroll 1
        for (int ks = 0; ks < 4; ++ks) {
            const int s0 = ks * 32 + fq * 8;
            float sc[8]; { const f32x4 q0 = *(const LAS f32x4*)(sW + wave * 128 + s0), q1 = *(const LAS f32x4*)(sW + wave * 128 + s0 + 4);
#pragma unroll
                for (int e = 0; e < 4; ++e) { sc[e] = q0[e]; sc[4 + e] = q1[e]; } }
            bf16x8 xf[4];
#pragma unroll
            for (int pt = 0; pt < 4; ++pt) xf[pt] = scale_frag8(*(const LAS bf16x8*)(xsT + (hh * 64 + pt * 16 + fr) * SLD + s0), sc);
#pragma unroll
            for (int nt = 0; nt < 8; ++nt) { const bf16x8 bf = *(const LAS bf16x8*)(BT + (nt * 16 + fr) * SLD + s0);
#pragma unroll
                for (int pt = 0; pt < 4; ++pt) acc[nt][pt] = __builtin_amdgcn_mfma_f32_16x16x32_bf16(bf, xf[pt], acc[nt][pt], 0, 0, 0); }
        }
        bf16_t* st = states + ((size_t)((gc - cbase) * 8 + h8) * 2 + dir) * 8192;
#pragma unroll
        for (int nt = 0; nt < 8; ++nt)
#pragma unroll
            for (int pt = 0; pt < 4; ++pt) { u32x2 q; q.x = pk2(acc[nt][pt][0], acc[nt][pt][1]); q.y = pk2(acc[nt][pt][2], acc[nt][pt][3]); *(u32x2*)(st + (pt * 16 + fr) * 128 + nt * 16 + fq * 4) = q; }
        __syncthreads();
    }
}
__device__ __forceinline__ void phase_s2(ArgsP a, int cbase, bf16_t* states, int dry) {
    const int nseq = cbase == 0 ? 8 : 4, cps = cbase == 0 ? 16 : 32;
    const float* decay = (const float*)(a->ws + WS_DECAY);
    const int total = nseq * 16 * 1024;
    for (int i = blockIdx.x * 512 + otid(); i < total; i += gridDim.x * 512) {
        const int e8 = i & 1023, hd = (i >> 10) & 15, sq = i >> 14, dir = hd & 1;
        float hs[8];
#pragma unroll
        for (int j = 0; j < 8; ++j) hs[j] = 0.f;
#pragma unroll 1
        for (int cc0 = 0; cc0 < cps; cc0 += 8) {
            u32x4 w[8]; float dcv[8]; u32x4* pp[8];
#pragma unroll
            for (int u = 0; u < 8; ++u) { const int cc = cc0 + u, crel = sq * cps + (dir ? cps - 1 - cc : cc);
                pp[u] = (u32x4*)(states + ((size_t)crel * 16 + hd) * 8192) + e8; w[u] = *pp[u]; dcv[u] = decay[(cbase + crel) * 16 + hd]; }
#pragma unroll
            for (int u = 0; u < 8; ++u) { const float dc = dcv[u];
                u32x4 o; o.x = pk2(hs[0], hs[1]); o.y = pk2(hs[2], hs[3]); o.z = pk2(hs[4], hs[5]); o.w = pk2(hs[6], hs[7]); if (!dry) *pp[u] = o;
                hs[0] = hs[0] * dc + bflo(w[u].x); hs[1] = hs[1] * dc + bfhi(w[u].x); hs[2] = hs[2] * dc + bflo(w[u].y); hs[3] = hs[3] * dc + bfhi(w[u].y);
                hs[4] = hs[4] * dc + bflo(w[u].z); hs[5] = hs[5] * dc + bfhi(w[u].z); hs[6] = hs[6] * dc + bflo(w[u].w); hs[7] = hs[7] * dc + bfhi(w[u].w); }
        }
    }
}
__device__ __forceinline__ void phase_s3(ArgsP a, int l, int cbase, LAS unsigned char* lds, const bf16_t* xs_raw, const bf16_t* bc_raw, const bf16_t* states, bf16_t* gate, int dry) {
    const int tid = otid(), lane = tid & 63, wave = __builtin_amdgcn_readfirstlane(tid >> 6), fr = lane & 15, fq = lane >> 4;
    LAS bf16_t* xsT = (LAS bf16_t*)lds;
    LAS bf16_t* sC = (LAS bf16_t*)(lds + 128 * SLD * 2);
    LAS bf16_t* sB = (LAS bf16_t*)(lds + 256 * SLD * 2);
    LAS float* sDt = (LAS float*)(lds + 384 * SLD * 2);
    LAS float* sCs = sDt + 1024;
    const float* dt = (const float*)(a->ws + WS_DT);
    const float* cw = a->in[I_SCW] + l * 5 * 1024; const float* cbs = a->in[I_SCB] + l * 1024;
    for (int it = blockIdx.x; it < 256; it += gridDim.x) {
        const int gc = cbase + (it >> 1), g = it & 1, t0 = gc * 128; int lo, hi; seq_bounds(t0, lo, hi);
        { const int w4 = wave, hh4 = w4 >> 1, dir = w4 & 1, h8 = g * 4 + hh4; float d0, d1, c0, c1, tot; const float A = -__expf(a->in[I_ALOG][l * 16 + dir * 8 + h8]);
          chunk_scan(dt, t0, dir * 8 + h8, A, dir, lane, d0, d1, c0, c1, tot);
          { sDt[w4 * 128 + 2 * lane] = d0; sDt[w4 * 128 + 2 * lane + 1] = d1; sCs[w4 * 128 + 2 * lane] = c0; sCs[w4 * 128 + 2 * lane + 1] = c1; } }
        load_conv_tile<128, false>(bc_raw, 512, g * 128, t0, lo, hi, cw, cbs, 512 + g * 128, sB);
        load_conv_tile<128, false>(bc_raw, 512, 256 + g * 128, t0, lo, hi, cw, cbs, 768 + g * 128, sC);
        __syncthreads();
        {
            f32x4 cacc[8];
#pragma unroll
            for (int i = 0; i < 8; ++i) cacc[i] = (f32x4){0.f, 0.f, 0.f, 0.f};
#pragma unroll
            for (int ks = 0; ks < 4; ++ks) { const bf16x8 cf = *(const LAS bf16x8*)(sC + (wave * 16 + fr) * SLD + ks * 32 + fq * 8);
#pragma unroll
                for (int st = 0; st < 8; ++st) { const bf16x8 bf = *(const LAS bf16x8*)(sB + (st * 16 + fr) * SLD + ks * 32 + fq * 8); cacc[st] = __builtin_amdgcn_mfma_f32_16x16x32_bf16(bf, cf, cacc[st], 0, 0, 0); } }
            __syncthreads();
#pragma unroll
            for (int st = 0; st < 8; ++st) { u32x2 q; q.x = pk2(cacc[st][0], cacc[st][1]); q.y = pk2(cacc[st][2], cacc[st][3]); *(LAS u32x2*)(sB + (wave * 16 + fr) * SLD + st * 16 + fq * 4) = q; }
            __syncthreads();
        }
#pragma unroll 1
        for (int hp = 0; hp < 2; ++hp) {
        load_conv_tile<128, true>(xs_raw, 512, g * 256 + hp * 128, t0, lo, hi, cw, cbs, g * 256 + hp * 128, xsT);
        __syncthreads();
        const int hh2 = wave >> 2, lq = wave & 3, h8 = g * 4 + hp * 2 + hh2;
        const float Dh = a->in[I_SD][l * 8 + h8];
        const int hq = hp * 2 + hh2; const LAS float* dtf = sDt + (hq * 2) * 128; const LAS float* dtb = sDt + (hq * 2 + 1) * 128; const LAS float* csf = sCs + (hq * 2) * 128; const LAS float* csb = sCs + (hq * 2 + 1) * 128;
        f32x4 acc[2][4];
#pragma unroll
        for (int i = 0; i < 2; ++i)
#pragma unroll
            for (int j = 0; j < 4; ++j) acc[i][j] = (f32x4){0.f, 0.f, 0.f, 0.f};
#pragma unroll 1
        for (int ks = 0; ks < 4; ++ks) {
            const int s0 = ks * 32 + fq * 8;
            bf16x8 xf[4];
#pragma unroll
            for (int pt = 0; pt < 4; ++pt) xf[pt] = *(const LAS bf16x8*)(xsT + (hh2 * 64 + pt * 16 + fr) * SLD + s0);
            float vdf[8], vdb[8], vcf[8], vcb[8];
            { const f32x4 q0 = *(const LAS f32x4*)(dtf + s0), q1 = *(const LAS f32x4*)(dtf + s0 + 4), r0 = *(const LAS f32x4*)(dtb + s0), r1 = *(const LAS f32x4*)(dtb + s0 + 4);
              const f32x4 u0 = *(const LAS f32x4*)(csf + s0), u1 = *(const LAS f32x4*)(csf + s0 + 4), w0 = *(const LAS f32x4*)(csb + s0), w1 = *(const LAS f32x4*)(csb + s0 + 4);
#pragma unroll
              for (int e = 0; e < 4; ++e) { vdf[e] = q0[e]; vdf[4 + e] = q1[e]; vdb[e] = r0[e]; vdb[4 + e] = r1[e]; vcf[e] = u0[e]; vcf[4 + e] = u1[e]; vcb[e] = w0[e]; vcb[4 + e] = w1[e]; } }
#pragma unroll
            for (int lt = 0; lt < 2; ++lt) {
                const int lrow = lq * 32 + lt * 16 + fr;
                const float csf_l = csf[lrow], csb_l = csb[lrow];
                const u32x4 cbq = *(const LAS u32x4*)(sB + lrow * SLD + s0);
                const float cbv[8] = {bflo(cbq.x), bfhi(cbq.x), bflo(cbq.y), bfhi(cbq.y), bflo(cbq.z), bfhi(cbq.z), bflo(cbq.w), bfhi(cbq.w)};
                float mv[8];
#pragma unroll
                for (int e = 0; e < 8; ++e) { const int s = s0 + e;
                    const float ex = s < lrow ? csf_l - vcf[e] : csb_l - vcb[e];
                    const float dd = s < lrow ? vdf[e] : vdb[e];
                    float mm = cbv[e] * __expf(ex) * dd;
                    if (s == lrow) mm = cbv[e] * (vdf[e] + vdb[e]) + Dh;
                    mv[e] = mm;
                    }
                union { bf16x8 v; unsigned u[4]; } mf;
#pragma unroll
                for (int j = 0; j < 4; ++j) mf.u[j] = pk2(mv[2 * j], mv[2 * j + 1]);
#pragma unroll
                for (int pt = 0; pt < 4; ++pt) acc[lt][pt] = __builtin_amdgcn_mfma_f32_16x16x32_bf16(xf[pt], mf.v, acc[lt][pt], 0, 0, 0);
            }
        }
#pragma unroll 1
        for (int dir = 0; dir < 2; ++dir) {
            const bf16_t* pv = states + ((size_t)((gc - cbase) * 8 + h8) * 2 + dir) * 8192;
            const LAS float* cs = dir ? csb : csf;
            float el[2];
#pragma unroll
            for (int lt = 0; lt < 2; ++lt) el[lt] = __expf(cs[lq * 32 + lt * 16 + fr]);
#pragma unroll
            for (int ks = 0; ks < 4; ++ks) {
                const int n0 = ks * 32 + fq * 8;
                bf16x8 pf[4];
#pragma unroll
                for (int pt = 0; pt < 4; ++pt) pf[pt] = *(const bf16x8*)(pv + (pt * 16 + fr) * 128 + n0);
#pragma unroll
                for (int lt = 0; lt < 2; ++lt) {
                    const float sc[8] = {el[lt], el[lt], el[lt], el[lt], el[lt], el[lt], el[lt], el[lt]};
                    const bf16x8 cf = scale_frag8(*(const LAS bf16x8*)(sC + (lq * 32 + lt * 16 + fr) * SLD + n0), sc);
#pragma unroll
                    for (int pt = 0; pt < 4; ++pt) acc[lt][pt] = __builtin_amdgcn_mfma_f32_16x16x32_bf16(pf[pt], cf, acc[lt][pt], 0, 0, 0);
                }
            }
        }
        u32x2 gqv[2][4];
#pragma unroll
        for (int lt = 0; lt < 2; ++lt)
#pragma unroll
            for (int pt = 0; pt < 4; ++pt) gqv[lt][pt] = *(const u32x2*)(gate + (size_t)(t0 + lq * 32 + lt * 16 + fr) * 512 + g * 256 + (hp * 2 + hh2) * 64 + pt * 16 + fq * 4);
#pragma unroll
        for (int lt = 0; lt < 2; ++lt)
#pragma unroll
            for (int pt = 0; pt < 4; ++pt) {
                u32x2* gp = (u32x2*)(gate + (size_t)(t0 + lq * 32 + lt * 16 + fr) * 512 + g * 256 + (hp * 2 + hh2) * 64 + pt * 16 + fq * 4);
                const u32x2 gq = gqv[lt][pt];
                u32x2 o; o.x = pk2(acc[lt][pt][0] * silu_f(bflo(gq.x)), acc[lt][pt][1] * silu_f(bfhi(gq.x))); o.y = pk2(acc[lt][pt][2] * silu_f(bflo(gq.y)), acc[lt][pt][3] * silu_f(bfhi(gq.y)));
                if (!dry) *gp = o;
            }
        __syncthreads();
        }
    }
}
__device__ __forceinline__ f32x2 cmul(f32x2 a, f32x2 b) { const f32x2 bx = {b.x, b.x}, by = {b.y, b.y}, ar = {-a.y, a.x}; return a * bx + ar * by; }
__device__ __forceinline__ f32x2 cmulc(f32x2 a, f32x2 b) { const f32x2 bx = {b.x, b.x}, by = {b.y, b.y}, ar = {a.y, -a.x}; return a * bx + ar * by; }
#define DP(e) d[(e) + ((e) >> 4)]
__device__ __forceinline__ f32x2 w16(int k) {
    constexpr float C[8] = {1.f, 0.9238795325112867f, 0.7071067811865476f, 0.3826834323650898f, 0.f, -0.3826834323650898f, -0.7071067811865476f, -0.9238795325112867f};
    constexpr float S[8] = {0.f, 0.3826834323650898f, 0.7071067811865476f, 0.9238795325112867f, 1.f, 0.9238795325112867f, 0.7071067811865476f, 0.3826834323650898f};
    return (f32x2){C[k], -S[k]};
}
__device__ __forceinline__ f32x2 mulw16(f32x2 v, int k) { if (k == 0) return v; if (k == 4) return (f32x2){v.y, -v.x}; return cmul(v, w16(k)); }
__device__ __forceinline__ f32x2 mulw16c(f32x2 v, int k) { if (k == 0) return v; if (k == 4) return (f32x2){-v.y, v.x}; return cmulc(v, w16(k)); }
template <int LOGN, bool FOLD = false, int TPA = 512> __device__ __forceinline__ void fft_fwd(LAS f32x2* d, const LAS f32x2* tw, const int tq) {
    constexpr int N = 1 << LOGN;
    if (LOGN == 13 && !FOLD) {
#pragma unroll
        for (int qi = 0; qi < 8; ++qi) { const int q = tq + 512 * qi; const f32x2 x0 = DP(q), x1 = DP(q + 4096); DP(q) = x0 + x1; DP(q + 4096) = cmul(x0 - x1, tw[q]); }
        __syncthreads();
    }
#pragma unroll 1
    for (int ls = 11; ls >= 7; ls -= 4) {
        const int st = 1 << (ls - 3);
#pragma unroll
        for (int gi = 0; gi < (N / 16 + TPA - 1) / TPA; ++gi) { const int g = tq + TPA * gi;
            if (g < N / 16) {
                const int j = g & (st - 1), blk = g >> (ls - 3), base = (blk << (ls + 1)) + j;
                const f32x2 W1 = tw[j << (12 - ls)], W2 = tw[j << (13 - ls)], W3 = tw[j << (14 - ls)], W4 = tw[j << (15 - ls)];
                f32x2 x[16];
#pragma unroll
                for (int k = 0; k < 16; ++k) x[k] = DP(base + k * st);
#pragma unroll
                for (int k = 0; k < 8; ++k) { const f32x2 a = x[k], b = x[k + 8]; x[k] = a + b; x[k + 8] = cmul(mulw16(a - b, k), W1); }
#pragma unroll
                for (int k = 0; k < 16; ++k) if ((k & 7) < 4) { const f32x2 a = x[k], b = x[k + 4]; x[k] = a + b; x[k + 4] = cmul(mulw16(a - b, 2 * (k & 3)), W2); }
#pragma unroll
                for (int k = 0; k < 16; ++k) if ((k & 3) < 2) { const f32x2 a = x[k], b = x[k + 2]; x[k] = a + b; x[k + 2] = cmul(mulw16(a - b, 4 * (k & 1)), W3); }
#pragma unroll
                for (int k = 0; k < 16; k += 2) { const f32x2 a = x[k], b = x[k + 1]; x[k] = a + b; x[k + 1] = cmul(a - b, W4); }
#pragma unroll
                for (int k = 0; k < 16; ++k) DP(base + k * st) = x[k];
            }
        }
        __syncthreads();
    }
#pragma unroll
    for (int gi = 0; gi < (N / 16 + TPA - 1) / TPA; ++gi) { const int g = tq + TPA * gi;
        if (g < N / 16) {
            f32x2 x[16];
#pragma unroll
            for (int i = 0; i < 16; ++i) x[i] = d[17 * g + i];
#pragma unroll
            for (int i = 0; i < 8; ++i) { const f32x2 a = x[i], b = x[i + 8]; x[i] = a + b; x[i + 8] = mulw16(a - b, i); }
#pragma unroll
            for (int i = 0; i < 16; ++i) if ((i & 7) < 4) { const f32x2 a = x[i], b = x[i + 4]; x[i] = a + b; x[i + 4] = mulw16(a - b, 2 * (i & 3)); }
#pragma unroll
            for (int i = 0; i < 16; ++i) if ((i & 3) < 2) { const f32x2 a = x[i], b = x[i + 2]; x[i] = a + b; x[i + 2] = mulw16(a - b, 4 * (i & 1)); }
#pragma unroll
            for (int i = 0; i < 16; i += 2) { const f32x2 a = x[i], b = x[i + 1]; x[i] = a + b; x[i + 1] = a - b; }
#pragma unroll
            for (int i = 0; i < 16; ++i) d[17 * g + i] = x[i];
        }
    }
    __syncthreads();
}
template <int LOGN, bool FOLD = false, int TPA = 512> __device__ __forceinline__ void fft_inv(LAS f32x2* d, const LAS f32x2* tw, const int tq) {
    constexpr int N = 1 << LOGN;
#pragma unroll
    for (int gi = 0; gi < (N / 16 + TPA - 1) / TPA; ++gi) { const int g = tq + TPA * gi;
        if (g < N / 16) {
            f32x2 x[16];
#pragma unroll
            for (int i = 0; i < 16; ++i) x[i] = d[17 * g + i];
#pragma unroll
            for (int i = 0; i < 16; i += 2) { const f32x2 a = x[i], b = x[i + 1]; x[i] = a + b; x[i + 1] = a - b; }
#pragma unroll
            for (int i = 0; i < 16; ++i) if ((i & 3) < 2) { const f32x2 a = x[i], b = mulw16c(x[i + 2], 4 * (i & 1)); x[i] = a + b; x[i + 2] = a - b; }
#pragma unroll
            for (int i = 0; i < 16; ++i) if ((i & 7) < 4) { const f32x2 a = x[i], b = mulw16c(x[i + 4], 2 * (i & 3)); x[i] = a + b; x[i + 4] = a - b; }
#pragma unroll
            for (int i = 0; i < 8; ++i) { const f32x2 a = x[i], b = mulw16c(x[i + 8], i); x[i] = a + b; x[i + 8] = a - b; }
#pragma unroll
            for (int i = 0; i < 16; ++i) d[17 * g + i] = x[i];
        }
    }
    __syncthreads();
#pragma unroll 1
    for (int ls = 7; ls <= 11; ls += 4) {
        const int st = 1 << (ls - 3);
#pragma unroll
        for (int gi = 0; gi < (N / 16 + TPA - 1) / TPA; ++gi) { const int g = tq + TPA * gi;
            if (g < N / 16) {
                const int j = g & (st - 1), blk = g >> (ls - 3), base = (blk << (ls + 1)) + j;
                const f32x2 W1 = tw[j << (12 - ls)], W2 = tw[j << (13 - ls)], W3 = tw[j << (14 - ls)], W4 = tw[j << (15 - ls)];
                f32x2 x[16];
#pragma unroll
                for (int k = 0; k < 16; ++k) x[k] = DP(base + k * st);
#pragma unroll
                for (int k = 0; k < 16; k += 2) { const f32x2 a = x[k], b = cmulc(x[k + 1], W4); x[k] = a + b; x[k + 1] = a - b; }
#pragma unroll
                for (int k = 0; k < 16; ++k) if ((k & 3) < 2) { const f32x2 a = x[k], b = cmulc(mulw16c(x[k + 2], 4 * (k & 1)), W3); x[k] = a + b; x[k + 2] = a - b; }
#pragma unroll
                for (int k = 0; k < 16; ++k) if ((k & 7) < 4) { const f32x2 a = x[k], b = cmulc(mulw16c(x[k + 4], 2 * (k & 3)), W2); x[k] = a + b; x[k + 4] = a - b; }
#pragma unroll
                for (int k = 0; k < 8; ++k) { const f32x2 a = x[k], b = cmulc(mulw16c(x[k + 8], k), W1); x[k] = a + b; x[k + 8] = a - b; }
#pragma unroll
                for (int k = 0; k < 16; ++k) DP(base + k * st) = x[k];
            }
        }
        __syncthreads();
    }
    if (LOGN == 13 && !FOLD) {
#pragma unroll
        for (int qi = 0; qi < 8; ++qi) { const int q = tq + 512 * qi; const f32x2 u = DP(q), v = cmulc(DP(q + 4096), tw[q]); DP(q) = u + v; DP(q + 4096) = u - v; }
        __syncthreads();
    }
}
constexpr size_t FT_SET0_OFF = (size_t)2 * 512 * 4096;
__device__ __forceinline__ void phase_filter(ArgsP a, int l, LAS unsigned char* lds, float* FT) {
    LAS float* sh = (LAS float*)lds;
    LAS float* sw = (LAS float*)(lds + 64 * 65 * 4);
    const int tid = otid(), lane = tid & 63, wave = tid >> 6;
    const float min_decay = -3.0701134573253944f, max_decay = -15.350567286626972f;
    for (int it = blockIdx.x; it < 1536; it += gridDim.x) {
        const int set = it < 1024 ? 1 : 0, r = set ? it : it - 1024, L = set ? 4096 : 2048, tt0 = (r >> 4) * 64, cc0 = (r & 15) * 64;
        const float* h2 = (const float*)(a->ws + WS_H2) + ((size_t)l * 6144 + (set ? 2048 : 0) + tt0) * 64;
        const float* fw3 = a->in[I_FW3] + (size_t)l * 64 * 1024 + cc0;
        { const int rr = tid >> 3, c8 = (tid & 7) * 8;
          const f32x4 h0 = *(const f32x4*)(h2 + rr * 64 + c8), h1 = *(const f32x4*)(h2 + rr * 64 + c8 + 4);
          const f32x4 w0 = *(const f32x4*)(fw3 + (size_t)rr * 1024 + c8), w1 = *(const f32x4*)(fw3 + (size_t)rr * 1024 + c8 + 4);
#pragma unroll
          for (int e = 0; e < 4; ++e) { sh[rr * 65 + c8 + e] = h0[e]; sh[rr * 65 + c8 + 4 + e] = h1[e]; }
          *(LAS f32x4*)(sw + rr * 64 + c8) = w0; *(LAS f32x4*)(sw + rr * 64 + c8 + 4) = w1; }
        __syncthreads();
        float o[8];
#pragma unroll
        for (int k = 0; k < 8; ++k) o[k] = 0.f;
#pragma unroll 8
        for (int i = 0; i < 64; ++i) { const float hv = sh[lane * 65 + i]; const f32x4 w0 = *(const LAS f32x4*)(sw + i * 64 + wave * 8), w1 = *(const LAS f32x4*)(sw + i * 64 + wave * 8 + 4);
#pragma unroll
            for (int e = 0; e < 4; ++e) { o[e] += hv * w0[e]; o[4 + e] += hv * w1[e]; } }
        const int t = tt0 + lane; const float tl = (float)t / (float)(L - 1);
        float fb[8];
#pragma unroll
        for (int k = 0; k < 8; ++k) fb[k] = a->in[I_FB3][l * 1024 + cc0 + wave * 8 + k];
#pragma unroll
        for (int k = 0; k < 8; ++k) { const int cp = cc0 + wave * 8 + k, dir = cp >> 9, c = cp & 511;
            const float delta = fabsf(min_decay + (float)c * ((max_decay - min_decay) / 511.0f));
            FT[(set ? 0 : FT_SET0_OFF) + ((size_t)dir * 512 + c) * L + t] = (o[k] + fb[k]) * __expf(-tl * delta); }
        __syncthreads();
    }
}
template <int LOGN> __device__ __forceinline__ void hyena_conv_item(ArgsP a, int l, int c, LAS unsigned char* lds, const bf16_t* x1T, bf16_t* vT, const float* FT, int dry) {
    constexpr int N = 1 << LOGN, L = N / 2, SET = (LOGN == 13), NB = SET ? 4 : 8, TOK0 = SET ? TP : 0, TPA = SET ? 512 : 256, NPAR = 512 / TPA, NJ = L / TPA, NK = N / TPA;
    static_assert(NJ == 8 && NK == 16, "shape");
    LAS f32x2* d = (LAS f32x2*)lds;
    LAS f32x2* tw = (LAS f32x2*)(lds + 69632);
    const int tid = otid(), tl = tid % TPA;
    const float* hfT = FT + (SET ? 0 : FT_SET0_OFF) + (size_t)c * L; const float* hbT = hfT + (size_t)512 * L;
#pragma unroll
    for (int j = 0; j < L / 512; ++j) { const int t = tid + 512 * j;
        DP(t) = (f32x2){hfT[t], 0.f};
        if (t >= 1) DP(N - t) = (f32x2){hbT[t], 0.f};
    }
    if (tid == 0) DP(L) = (f32x2){0.f, 0.f};
    __syncthreads();
    fft_fwd<LOGN>(d, tw, tid);
    f32x2 kf[NK];
#pragma unroll
    for (int j = 0; j < NK; ++j) kf[j] = DP(tl + TPA * j) * (1.0f / (float)N);
    __syncthreads();
    const float* cw = a->in[I_HCW] + l * 3 * 1536; const float cb1 = a->in[I_HCB][l * 1536 + 512 + c], cbv = a->in[I_HCB][l * 1536 + 1024 + c];
    const float w10 = cw[512 + c], w11 = cw[1536 + 512 + c], w12 = cw[3072 + 512 + c], wv0 = cw[1024 + c], wv1 = cw[1536 + 1024 + c], wv2 = cw[3072 + 1024 + c];
    const float hbias = a->in[I_HBIAS][l * 512 + c];
    LAS f32x2* const d0 = d; d = d0 + (tid / TPA) * (N + N / 16);
#pragma unroll 1
    for (int bp0 = 0; bp0 < NB / 2; bp0 += NPAR) {
        const int bp = bp0 + tid / TPA;
        const size_t rowA = (size_t)c * T_ALL + TOK0 + (size_t)(2 * bp) * L, rowB = rowA + L;
        float zA[NJ], zB[NJ];
        {
            const int tb = tl * NJ;
            float x1a[NJ + 2], va[NJ + 2], x1b[NJ + 2], vb[NJ + 2];
            auto ldrow = [&](const bf16_t* p, float (&o)[NJ + 2]) {
                const u32x4 q = *(const u32x4*)(p + tb); o[1] = bflo(q.x); o[2] = bfhi(q.x); o[3] = bflo(q.y); o[4] = bfhi(q.y); o[5] = bflo(q.z); o[6] = bfhi(q.z); o[7] = bflo(q.w); o[8] = bfhi(q.w);
                o[0] = tb > 0 ? bf2f(p[tb - 1]) : 0.f; o[NJ + 1] = tb + NJ < L ? bf2f(p[tb + NJ]) : 0.f;
            };
            ldrow(x1T + rowA, x1a); ldrow(vT + rowA, va); ldrow(x1T + rowB, x1b); ldrow(vT + rowB, vb);
#pragma unroll
            for (int jj = 0; jj < NJ; ++jj) {
                zA[jj] = (cb1 + w10 * x1a[jj] + w11 * x1a[jj + 1] + w12 * x1a[jj + 2]) * (cbv + wv0 * va[jj] + wv1 * va[jj + 1] + wv2 * va[jj + 2]);
                zB[jj] = (cb1 + w10 * x1b[jj] + w11 * x1b[jj + 1] + w12 * x1b[jj + 2]) * (cbv + wv0 * vb[jj] + wv1 * vb[jj + 1] + wv2 * vb[jj + 2]);
                const f32x2 zz = {zA[jj], zB[jj]}; DP(tb + jj) = zz; DP(L + tb + jj) = (LOGN == 13) ? cmul(zz, tw[tb + jj]) : (f32x2){0.f, 0.f};
            }
        }
        __syncthreads();
        fft_fwd<LOGN, true, TPA>(d, tw, tl);
#pragma unroll
        for (int j = 0; j < NK; ++j) DP(tl + TPA * j) = cmul(DP(tl + TPA * j), kf[j]);
        __syncthreads();
        fft_inv<LOGN, true, TPA>(d, tw, tl);
        {   const int tb = tl * NJ; unsigned oa[NJ / 2], ob[NJ / 2];
#pragma unroll
            for (int jj = 0; jj < NJ; jj += 2) { f32x2 y0 = DP(tb + jj), y1 = DP(tb + jj + 1);
                if (LOGN == 13) { y0 = y0 + cmulc(DP(L + tb + jj), tw[tb + jj]); y1 = y1 + cmulc(DP(L + tb + jj + 1), tw[tb + jj + 1]); }
                oa[jj / 2] = pk2(y0.x + zA[jj] * hbias, y1.x + zA[jj + 1] * hbias); ob[jj / 2] = pk2(y0.y + zB[jj] * hbias, y1.y + zB[jj + 1] * hbias); }
            if (!dry) { u32x4 qa, qb; qa.x = oa[0]; qa.y = oa[1]; qa.z = oa[2]; qa.w = oa[3]; qb.x = ob[0]; qb.y = ob[1]; qb.z = ob[2]; qb.w = ob[3]; *(u32x4*)(vT + rowA + tb) = qa; *(u32x4*)(vT + rowB + tb) = qb; }
        }
        __syncthreads();
    }
}
__device__ __forceinline__ void phase_hyena_conv(ArgsP a, int l, LAS unsigned char* lds, const bf16_t* x1T, bf16_t* vT, const float* FT, int dry) {
    { LAS f32x2* tw = (LAS f32x2*)(lds + 69632); const f32x2* g = (const f32x2*)(a->ws + WS_TW); for (int i = otid(); i < 4096; i += 512) tw[i] = g[i]; }
    __syncthreads();
    for (int it = blockIdx.x; it < 1024; it += gridDim.x) {
        if (it < 512) hyena_conv_item<13>(a, l, it, lds, x1T, vT, FT, dry);
        else hyena_conv_item<12>(a, l, it - 512, lds, x1T, vT, FT, dry);
    }
}
__device__ __forceinline__ void phase_hyena_norm(ArgsP a, int l, LAS unsigned char* lds, const bf16_t* x0T, const bf16_t* yT, bf16_t* hyn) {
    constexpr int PLD = 513;
    LAS float* P = (LAS float*)lds;
    LAS float* part = (LAS float*)(lds + 64 * PLD * 4);
    const int tid = otid(), lane = tid & 63, wave = tid >> 6, tp = lane & 15, cq = lane >> 4;
    const float* cw = a->in[I_HCW] + l * 3 * 1536; const float* cb = a->in[I_HCB] + l * 1536;
    float hg[8];
#pragma unroll
    for (int j = 0; j < 4; ++j) { hg[2 * j] = a->in[I_HNORM][l * 512 + 2 * lane + 128 * j]; hg[2 * j + 1] = a->in[I_HNORM][l * 512 + 2 * lane + 128 * j + 1]; }
    for (int it = blockIdx.x; it < T_ALL / 64; it += gridDim.x) {
        const int tile0 = it * 64, t = tile0 + 4 * tp; int lo, hi; seq_bounds(tile0, lo, hi);
        const bool hasl = t > lo, hasr = t + 4 < hi;
        float ss0 = 0.f, ss1 = 0.f, ss2 = 0.f, ss3 = 0.f;
#pragma unroll 8
        for (int i = 0; i < 16; ++i) {
            const int c = wave * 64 + 4 * i + cq; const size_t row = (size_t)c * T_ALL;
            const u32x2 xc = *(const u32x2*)(x0T + row + t), yc = *(const u32x2*)(yT + row + t);
            const float xm = hasl ? bf2f(x0T[row + t - 1]) : 0.f, xp = hasr ? bf2f(x0T[row + t + 4]) : 0.f;
            const float x0 = bflo(xc.x), x1 = bfhi(xc.x), x2 = bflo(xc.y), x3 = bfhi(xc.y), w0 = cw[c], w1 = cw[1536 + c], w2 = cw[3072 + c], bb = cb[c];
            const float p0 = (bb + w0 * xm + w1 * x0 + w2 * x1) * bflo(yc.x), p1 = (bb + w0 * x0 + w1 * x1 + w2 * x2) * bfhi(yc.x);
            const float p2 = (bb + w0 * x1 + w1 * x2 + w2 * x3) * bflo(yc.y), p3 = (bb + w0 * x2 + w1 * x3 + w2 * xp) * bfhi(yc.y);
            P[(4 * tp) * PLD + c] = p0; P[(4 * tp + 1) * PLD + c] = p1; P[(4 * tp + 2) * PLD + c] = p2; P[(4 * tp + 3) * PLD + c] = p3;
            ss0 += p0 * p0; ss1 += p1 * p1; ss2 += p2 * p2; ss3 += p3 * p3;
        }
        ss0 += __shfl_xor(ss0, 16); ss1 += __shfl_xor(ss1, 16); ss2 += __shfl_xor(ss2, 16); ss3 += __shfl_xor(ss3, 16);
        ss0 += __shfl_xor(ss0, 32); ss1 += __shfl_xor(ss1, 32); ss2 += __shfl_xor(ss2, 32); ss3 += __shfl_xor(ss3, 32);
        if (lane < 16) { part[wave * 64 + 4 * lane] = ss0; part[wave * 64 + 4 * lane + 1] = ss1; part[wave * 64 + 4 * lane + 2] = ss2; part[wave * 64 + 4 * lane + 3] = ss3; }
        __syncthreads();
#pragma unroll 1
        for (int r = 0; r < 8; ++r) {
            const int tl = wave * 8 + r;
            float s = 0.f;
#pragma unroll
            for (int w = 0; w < 8; ++w) s += part[w * 64 + tl];
            const float rs = rsqrtf(s * (1.0f / 512.0f) + EPS);
            bf16_t* orow = hyn + (size_t)(tile0 + tl) * 512;
#pragma unroll
            for (int j = 0; j < 4; ++j) { const int c = 2 * lane + 128 * j;
                const float v0 = P[tl * PLD + c] * rs * hg[2 * j], v1 = P[tl * PLD + c + 1] * rs * hg[2 * j + 1];
                *(unsigned*)(orow + c) = pk2(v0, v1); }
        }
        __syncthreads();
    }
}
#define XB_TMO      128
#define XB_XCNT(j)  (256  + 64 * (j))
#define XB_XSUB(j)  (1280 + 64 * (j))
#define XB_XGEN(j)  (2304 + 64 * (j))
#define XB_TOP      3328
#define XB_TOPGEN   3392
#define XCD_BAR_WORDS 3456
#define XB_SPIN_CAP (1u << 22)
constexpr size_t WS_BAR = 106 * MiB + 524288;
__device__ __forceinline__ unsigned xb_ld(unsigned* p)              { return __hip_atomic_load(p, __ATOMIC_RELAXED, __HIP_MEMORY_SCOPE_AGENT); }
__device__ __forceinline__ unsigned xb_add(unsigned* p, unsigned v) { return __hip_atomic_fetch_add(p, v, __ATOMIC_RELAXED, __HIP_MEMORY_SCOPE_AGENT); }
__device__ __forceinline__ unsigned xb_xcc_id() { return (unsigned)__builtin_amdgcn_s_getreg((3 << 11) | 20) & 0xFu; }
#define XB_SPIN(cond, bar) do { unsigned _sp = 0; while (cond) { __builtin_amdgcn_s_sleep(1); \
    if ((++_sp & 255u) == 0u) { if (xb_ld(&(bar)[XB_TMO])) break; if (_sp > XB_SPIN_CAP) { atomicAdd(&(bar)[XB_TMO], 1u); break; } } } } while (0)
__device__ __forceinline__ void xcd_barrier_complete(unsigned* bar, unsigned x, unsigned& nloc, unsigned& nx) {
    const unsigned G = gridDim.x;
    unsigned sum, cnt, mine, sp = 0u;
    for (;;) {
        sum = 0u; cnt = 0u; mine = 0u;
#pragma unroll
        for (unsigned j = 0; j < 16; ++j) { const unsigned c = xb_ld(&bar[XB_XCNT(j)]); sum += c; cnt += (c > 0u) ? 1u : 0u; mine = (j == x) ? c : mine; }
        if (sum == G) break;
        __builtin_amdgcn_s_sleep(1);
        if ((++sp & 255u) == 0u) { if (xb_ld(&bar[XB_TMO])) break; if (sp > XB_SPIN_CAP) { atomicAdd(&bar[XB_TMO], 1u); break; } }
    }
    nloc = mine > 0u ? mine : 1u; nx = cnt > 0u ? cnt : 1u;
}
__device__ __forceinline__ void xcd_barrier(unsigned* bar, volatile LAS unsigned* st) {
    asm volatile("s_waitcnt vmcnt(0)" ::: "memory");
    __syncthreads();
    if (threadIdx.x == 0) {
        const unsigned x = xb_xcc_id();
        __builtin_amdgcn_s_waitcnt(0);
        unsigned nloc = st[0], nx = st[1];
        if (nloc == 0u) { xcd_barrier_complete(bar, x, nloc, nx); st[0] = nloc; st[1] = nx; }
        const unsigned old = xb_add(&bar[XB_XSUB(x)], 1u);
        const unsigned gen = old / nloc;
        if (old + 1u == (gen + 1u) * nloc) {
            __builtin_amdgcn_fence(__ATOMIC_RELEASE, "agent");
            asm volatile("s_waitcnt vmcnt(0)" ::: "memory");
            const unsigned og = xb_add(&bar[XB_TOP], 1u);
            const unsigned tg = og / nx;
            if (og + 1u == (tg + 1u) * nx) xb_add(&bar[XB_TOPGEN], 1u);
            else XB_SPIN(xb_ld(&bar[XB_TOPGEN]) == tg, bar);
            __builtin_amdgcn_fence(__ATOMIC_ACQUIRE, "agent");
            xb_add(&bar[XB_XGEN(x)], 1u);
            asm volatile("s_waitcnt vmcnt(0)" ::: "memory");
        } else {
            XB_SPIN(xb_ld(&bar[XB_XGEN(x)]) == gen, bar);
            __builtin_amdgcn_fence(__ATOMIC_ACQUIRE, "agent");
            asm volatile("s_waitcnt vmcnt(0)" ::: "memory");
        }
    }
    __syncthreads();
}
__device__ __forceinline__ void epi_cfg(int st, int gi, int l, unsigned char* ws, float* out, ArgsP a, Epi& E) {
    float* ssq = (float*)(ws + WS_SSQ); bf16_t* xb = (bf16_t*)(ws + WS_XB);
    bf16_t* r1a = (bf16_t*)(ws + WS_R1A); bf16_t* r1b = (bf16_t*)(ws + WS_R1B); bf16_t* r2 = (bf16_t*)(ws + WS_R2); bf16_t* r3 = (bf16_t*)(ws + WS_R3);
    bf16_t* kmat = (bf16_t*)(ws + WS_R4); bf16_t* vtm = (bf16_t*)(ws + WS_R4 + 6 * MiB);
    float* ssq_in = ssq + (size_t)(3 * l) * T_ALL; float* ssq_a = ssq_in + T_ALL; float* ssq_m = ssq_a + T_ALL; float* ssq_n = ssq_m + T_ALL;
    const int half = (st >= 16) ? ((st - 16) >> 1) : 0;
    E.kind = 0; E.O0 = r1a; E.d1 = 0; E.d2 = 0; E.ldc = 1024; E.csplit = 0; E.rsplit = 0; E.ssq = ssq_in; E.psum = (float*)(ws + WS_PSUM); E.row_off = 0; E.SCALE = 0; E.ACT = 0;
    E.X = out; E.rin0 = out; E.rin1 = out + (size_t)TP * DM; E.xb = xb; E.ssq_out = ssq_a; E.rin_bf16 = 0; E.write_x = 1; E.write_xb = 1;
    if (st == 1)       { E.O0 = r1b; E.d1 = r2 - r1b; E.d2 = r3 - r2; E.ldc = 512; E.csplit = 2; E.SCALE = 1; }
    else if (st == 8)  { E.O0 = r2; E.d1 = r1a - r2; E.d2 = r3 - r1a; E.ldc = T_ALL; E.rsplit = 2; E.SCALE = 2; }
    else if (st == 11) { E.kind = 1; E.write_x = 0; E.rin_bf16 = 1; }
    else if (st == 12) {
        if (gi == 0)      { E.SCALE = 1; E.ssq = ssq_a; }
        else              { E.O0 = kmat; }
    }
    else if (st == 13) { E.O0 = r2; E.ACT = 2; }
    else if (st == 14) { E.SCALE = 3; }
    else if (st == 15) { E.kind = 1; E.ssq_out = ssq_m; E.rin_bf16 = 1; E.write_x = 0; }
    else if (st == 16 || st == 18) { E.ldc = 4096; E.SCALE = 1; E.ACT = 1; E.ssq = ssq_m; E.row_off = half * TP; }
    else               { E.kind = 1; E.ssq_out = ssq_n; E.row_off = half * TP; E.rin_bf16 = 1; E.write_x = 0; E.write_xb = 1; }
}
template <int KIND> struct EpiT {
    static constexpr bool PERM = true;
    int st, gi, l; unsigned char* ws; float* out; ArgsP a;
    __device__ __forceinline__ void operator()(const f32x4 (&acc)[2][2][4][2], const pg8::Unit& u, int wr, int wc, int fr, int fq) const {
        int st_ = st; asm volatile("" : "+s"(st_));
        Epi E; epi_cfg(st_, gi, l, ws, out, a, E);
        pg8::Unit uu = u;
        if (st_ == 12 && gi == 1 && u.pm >= 64) { uu.pm = u.pm - 64; E.O0 = (bf16_t*)(ws + WS_R4 + 6 * MiB); E.ldc = 3072; }
        if (KIND == 0) E.bf_path(acc, uu, wr, wc, fr, fq); else E.res_path(acc, uu, wr, wc, fr, fq);
    }
};
#ifdef DBG_SCAN
constexpr size_t WS_FLAG = 106 * MiB + 262144;
__device__ __forceinline__ void dbg_scan(unsigned char* ws, float* out, int ph) {
    int bad = 0;
    const size_t gt = (size_t)blockIdx.x * 512 + otid(), gs = (size_t)gridDim.x * 512;
    { const u32x4* p = (const u32x4*)(ws + 32 * MiB); const size_t n = (70 * MiB) / 16;
      for (size_t i = gt; i < n; i += gs) { const u32x4 w = p[i];
#pragma unroll
          for (int e = 0; e < 4; ++e) { const unsigned x = w[e]; if ((x & 0x7f80u) == 0x7f80u || (x & 0x7f800000u) == 0x7f800000u) bad = 1; } } }
    { const u32x4* p = (const u32x4*)(ws + 111 * MiB); const size_t n = (140 * MiB) / 16;
      for (size_t i = gt; i < n; i += gs) { const u32x4 w = p[i];
#pragma unroll
          for (int e = 0; e < 4; ++e) { const unsigned x = w[e]; if ((x & 0x7f80u) == 0x7f80u || (x & 0x7f800000u) == 0x7f800000u) bad = 1; } } }
    { const u32x4* p = (const u32x4*)(ws + 102 * MiB); const size_t n = (9 * MiB) / 16;
      for (size_t i = gt; i < n; i += gs) { const u32x4 w = p[i];
#pragma unroll
          for (int e = 0; e < 4; ++e) { const unsigned x = w[e]; if ((x & 0x7f800000u) == 0x7f800000u) bad = 1; } } }
    { const u32x4* p = (const u32x4*)out; const size_t n = (128 * MiB) / 16;
      for (size_t i = gt; i < n; i += gs) { const u32x4 w = p[i];
#pragma unroll
          for (int e = 0; e < 4; ++e) { const unsigned x = w[e]; if ((x & 0x7f800000u) == 0x7f800000u) bad = 1; } } }
    if (bad) atomicMax((int*)(ws + WS_FLAG), 100 - (ph + 1));
}
#endif
__global__ __launch_bounds__(512, 2) void mega_fwd(Args a_by_value) {
    extern __shared__ __attribute__((aligned(16))) unsigned char shm[];
    LAS unsigned char* lds = (LAS unsigned char*)shm;
    cg::grid_group grid = cg::this_grid();
    volatile LAS unsigned* xst = (volatile LAS unsigned*)(lds + LDS_BYTES - 16);
    if (threadIdx.x == 0) { xst[0] = 0u; xst[1] = 0u; xst[2] = 0u; xst[3] = 0u; (void)xb_add(&((unsigned*)(a_by_value.ws + WS_BAR))[XB_XCNT(xb_xcc_id())], 1u); }
    __syncthreads();
#ifdef DBG_TIME
    unsigned long long t_sel = 0, t_all = 0;
#endif
#pragma unroll 1
    for (int ph = 0; ph <= 40; ++ph) {
#ifdef DBG_TIME
        const unsigned long long t_begin = __builtin_amdgcn_s_memrealtime();
#endif
        ArgsP a = (ArgsP)__builtin_amdgcn_kernarg_segment_ptr(); asm volatile("" : "+s"(a));
        unsigned char* ws = a->ws; float* out = a->out;
        float* ssq = (float*)(ws + WS_SSQ);
        bf16_t* xb = (bf16_t*)(ws + WS_XB);
        bf16_t* r1a = (bf16_t*)(ws + WS_R1A); bf16_t* r1b = (bf16_t*)(ws + WS_R1B); bf16_t* r2 = (bf16_t*)(ws + WS_R2); bf16_t* r3 = (bf16_t*)(ws + WS_R3);
        bf16_t* kmat = (bf16_t*)(ws + WS_R4); bf16_t* vtm = (bf16_t*)(ws + WS_R4 + 6 * MiB);
        float* psum = (float*)(ws + WS_PSUM);
#ifdef DBG_TIME
        if (ph == 40) { if (blockIdx.x == 0 && threadIdx.x == 0) { *(volatile float*)(ws + 106 * MiB + 262144) = 2.0f * sqrtf((float)t_sel / (float)t_all); __threadfence(); }
            xcd_barrier((unsigned*)(ws + WS_BAR), xst);
            const float cval = *(volatile float*)(ws + 106 * MiB + 262144);
            for (size_t i = (size_t)blockIdx.x * 512 + otid(); i < (size_t)T_ALL * DM; i += (size_t)gridDim.x * 512) out[i] = cval; break; }
#elif defined(DBG_SCAN)
        if (ph == 40) { const int fl = *(volatile int*)(ws + WS_FLAG); const float cval = fl < 0 ? 0.f : sqrtf((float)(100 - fl));
            for (size_t i = (size_t)blockIdx.x * 512 + otid(); i < (size_t)T_ALL * DM; i += (size_t)gridDim.x * 512) out[i] = cval; break; }
#else
        if (ph == 40) { phase_final(a, ssq + (size_t)6 * T_ALL, xb); break; }
#endif
        const int l = ph / 20, st = ph % 20;
        const float* rin0 = l == 0 ? a->in[I_XP] : out; const float* rin1 = l == 0 ? a->in[I_XS] : out + (size_t)TP * DM;
        float* ssq_in = ssq + (size_t)(3 * l) * T_ALL; float* ssq_a = ssq_in + T_ALL; float* ssq_m = ssq_a + T_ALL; float* ssq_n = ssq_m + T_ALL;
#ifndef PH_LIMIT
#define PH_LIMIT 100
#endif
        const bool is_gemm = (st == 1 || st == 8 || (st >= 11 && st <= 19));
        if (ph >= PH_LIMIT) {}
        else if (st == 0) {
#ifdef DUP_MISC
            if (l == 0) phase_prologue(a, lds); phase_wconv(a, l, lds); __syncthreads();
#endif
            if (l == 0) phase_prologue(a, lds); phase_wconv(a, l, lds); }
        else if (is_gemm) {
            const int ng = (st == 12) ? 2 : 1;
#pragma unroll 1
            for (int gi = 0; gi < ng; ++gi) {
                int nM = 128, nN = 4, mode = 0, lda = 1024, ldb = 1024, K = 1024, ks_shift = 30; size_t seg = 0;
                const void* A = xb; const void* B = ws + WS_WQ;
                const int half = (st >= 16) ? ((st - 16) >> 1) : 0;
                if (st == 1)       { nN = 6; B = ws + WS_WSSM; }
                else if (st == 8)  { nM = 6; nN = 128; A = ws + WS_WHY; B = xb; }
                else if (st == 11) { A = r1a; lda = 512; ks_shift = 3; seg = (size_t)(WS_R1B - WS_R1A); B = ws + WS_WOUT; }
                else if (st == 12) {
                    if (gi == 1)      { nM = 12; nN = 8; mode = 3; A = ws + WS_MEMB; B = ws + WS_WK; }
                }
                else if (st == 13) { mode = 1; K = 256; A = r1a; B = kmat; }
                else if (st == 14) { mode = 2; K = 256; A = r2; B = vtm; ldb = 3072; }
                else if (st == 15) { A = r1a; B = ws + WS_WO; }
                else if (st == 16 || st == 18) { nM = 64; nN = 16; A = xb + (size_t)half * TP * DM; B = ws + WS_WUP; }
                else               { nM = 64; A = r1a; lda = 4096; ldb = 4096; K = 4096; B = ws + WS_WDOWN; }
                pg8::Sched S; S.init(nM, nN, mode, A, lda, B, ldb);
                if (mode == 3) { S.A2 = (const char*)(ws + WS_WV); S.B2 = (const char*)(ws + WS_MEMB); }
                const pg8::Gemm g{lda, ldb, K, ks_shift, seg};
                const bool resid = (st == 11 || st == 15 || st == 17 || st == 19);
                if (!resid) { const EpiT<0> EK{st, gi, l, ws, out, a}; pg8::gemm_phase(lds, g, S, EK);
#ifdef DUP_GEMM
                    pg8::gemm_phase(lds, g, S, EK);
#endif
#ifdef DUP_ATT
                    if (st == 13 || st == 14) pg8::gemm_phase(lds, g, S, EK);
#endif
#ifdef DUP_WIN
                    if (st == 1 || st == 8) pg8::gemm_phase(lds, g, S, EK);
#endif
                } else { const EpiT<1> EK{st, gi, l, ws, out, a}; pg8::gemm_phase(lds, g, S, EK); }
            }
#ifdef DUP_MISC
            if (st == 1) phase_dt(a, l, xb, ssq_in);
#endif
            if (st == 1) phase_dt(a, l, xb, ssq_in);
            if (st == 8) { phase_ssm_norm(a, l, r1b); phase_filter(a, l, lds, (float*)kmat); }
        }
        else if (st == 2 || st == 5) {
#ifdef DUP_SSD
            phase_s1(a, l, st == 2 ? 0 : 128, lds, r2, r3, r1a); __syncthreads();
#endif
            phase_s1(a, l, st == 2 ? 0 : 128, lds, r2, r3, r1a); }
        else if (st == 3 || st == 6) {
#ifdef DUP_SSD
            { int dry = 1; asm volatile("" : "+s"(dry)); phase_s2(a, st == 3 ? 0 : 128, r1a, dry); }
#endif
            int dry = 0; asm volatile("" : "+s"(dry)); phase_s2(a, st == 3 ? 0 : 128, r1a, dry); }
        else if (st == 4 || st == 7) {
#ifdef DUP_SSD
            { int dry = 1; asm volatile("" : "+s"(dry)); phase_s3(a, l, st == 4 ? 0 : 128, lds, r2, r3, r1a, r1b, dry); __syncthreads(); }
#endif
            int dry = 0; asm volatile("" : "+s"(dry)); phase_s3(a, l, st == 4 ? 0 : 128, lds, r2, r3, r1a, r1b, dry); }
        else if (st == 9) {
#ifdef DUP_FFT
            { int dry = 1; asm volatile("" : "+s"(dry)); phase_hyena_conv(a, l, lds, r1a, r3, (const float*)kmat, dry); __syncthreads(); }
#endif
            int dry = 0; asm volatile("" : "+s"(dry)); phase_hyena_conv(a, l, lds, r1a, r3, (const float*)kmat, dry); }
        else if (st == 10) {
#ifdef DUP_MISC
            phase_hyena_norm(a, l, lds, r2, r3, r1a); __syncthreads();
#endif
            phase_hyena_norm(a, l, lds, r2, r3, r1a); }
        if (ph == 0) grid.sync(); else xcd_barrier((unsigned*)(ws + WS_BAR), xst);
#ifdef DBG_TIME
        { const unsigned long long dt_ = __builtin_amdgcn_s_memrealtime() - t_begin; t_all += dt_;
          const int grp = st == 0 ? 0 : (st == 2 || st == 5) ? 1 : (st == 3 || st == 6) ? 2 : (st == 4 || st == 7) ? 3 : st == 9 ? 4 : st == 10 ? 5 : (st == 1 || st == 8) ? 6 : (st == 16 || st == 18) ? 8 : (st == 17 || st == 19) ? 9 : 7;
          if (grp == DBG_TIME) t_sel += dt_; }
#endif
#ifdef DBG_SCAN
#if !defined(S3_PROBE) && !defined(S3_PROBE2)
        dbg_scan(ws, out, ph); grid.sync();
#endif
#endif
    }
}

#include <cstdio>
extern "C" void kernel_launch(void* const* d_in, const int* in_sizes, int n_in, void* d_out, int out_size, void* d_ws, size_t ws_size, hipStream_t stream) {
    static int grid = 0;
    if (grid == 0) {
        int dev = 0, cus = 0, per_cu = 0;
        if (n_in != 33 || ws_size < WS_END || out_size != T_ALL * DM) { fprintf(stderr, "kernel_launch: unexpected shapes (n_in %d, ws %zu, out %d)\n", n_in, ws_size, out_size); grid = -1; return; }
        (void)hipGetDevice(&dev); (void)hipDeviceGetAttribute(&cus, hipDeviceAttributeMultiprocessorCount, dev);
        if (hipFuncSetAttribute((const void*)mega_fwd, hipFuncAttributeMaxDynamicSharedMemorySize, LDS_BYTES) != hipSuccess) { fprintf(stderr, "kernel_launch: hipFuncSetAttribute failed\n"); grid = -1; return; }
        if (hipOccupancyMaxActiveBlocksPerMultiprocessor(&per_cu, (const void*)mega_fwd, 512, LDS_BYTES) != hipSuccess || per_cu < 1) { fprintf(stderr, "kernel_launch: occupancy query gives %d\n", per_cu); (void)hipGetLastError(); grid = -1; return; }
        grid = cus;
    }
    if (grid < 0) return;
#ifdef DBG_SCAN
    (void)hipMemsetAsync(d_ws, 0xAA, WS_END, stream); (void)hipMemsetAsync(d_out, 0xAA, (size_t)T_ALL * DM * 4, stream);
#endif
    (void)hipMemsetAsync((unsigned char*)d_ws + WS_BAR, 0, XCD_BAR_WORDS * 4, stream);
    Args a{};
    for (int i = 0; i < 33; ++i) a.in[i] = (const float*)d_in[i];
    a.out = (float*)d_out; a.ws = (unsigned char*)d_ws;
    void* args[] = {&a};
    hipError_t e = hipLaunchCooperativeKernel((const void*)mega_fwd, dim3(grid), dim3(512), args, LDS_BYTES, stream);
    if (e != hipSuccess) fprintf(stderr, "cooperative launch failed: %s (grid %d)\n", hipGetErrorString(e), grid);
}
```

```cpp
#include <hip/hip_runtime.h>
#include <hip/hip_cooperative_groups.h>
namespace cg = cooperative_groups;

#define LAS __attribute__((address_space(3)))
typedef unsigned short bf16_t;
typedef short bf16x8 __attribute__((ext_vector_type(8)));
typedef float f32x4 __attribute__((ext_vector_type(4)));
typedef float f32x2 __attribute__((ext_vector_type(2)));
typedef unsigned u32x4 __attribute__((ext_vector_type(4)));
typedef unsigned u32x2 __attribute__((ext_vector_type(2)));

constexpr int T_ALL = 32768, TP = 16384, DM = 1024;
constexpr float EPS = 1e-5f;
constexpr size_t MiB = 1048576;
constexpr size_t WS_WHY = 0 * MiB, WS_WSSM = 3 * MiB, WS_WOUT = 6 * MiB, WS_WQ = 8 * MiB, WS_WK = 10 * MiB, WS_WV = 12 * MiB, WS_WO = 14 * MiB, WS_WUP = 16 * MiB, WS_WDOWN = 24 * MiB;
constexpr size_t WS_XB = 32 * MiB, WS_MEMB = 96 * MiB, WS_SSQ = 102 * MiB, WS_H2 = 103 * MiB, WS_TW = 106 * MiB, WS_WDT = 106 * MiB + 65536, WS_DECAY = 106 * MiB + 131072;
constexpr size_t WS_DT = 107 * MiB, WS_PSUM = 109 * MiB, WS_R1A = 111 * MiB, WS_R1B = 143 * MiB, WS_R2 = 175 * MiB, WS_R3 = 207 * MiB, WS_R4 = 239 * MiB, WS_END = 263 * MiB;
constexpr int LDS_BYTES = 153600;

typedef __bf16 bf16x2v __attribute__((ext_vector_type(2)));
__device__ __forceinline__ unsigned pk2(float lo, float hi) { const f32x2 v = {lo, hi}; const bf16x2v b = __builtin_convertvector(v, bf16x2v); return __builtin_bit_cast(unsigned, b); }
__device__ __forceinline__ float bflo(unsigned u) { return __uint_as_float(u << 16); }
__device__ __forceinline__ float bfhi(unsigned u) { return __uint_as_float(u & 0xffff0000u); }
__device__ __forceinline__ float bf2f(bf16_t b) { return __uint_as_float(((unsigned)b) << 16); }
__device__ __forceinline__ float wave_sum(float v) {
#pragma unroll
    for (int o = 32; o >= 1; o >>= 1) v += __shfl_xor(v, o);
    return v;
}
__device__ __forceinline__ int otid() { int t = (int)threadIdx.x; asm volatile("" : "+v"(t)); return t; }
constexpr float SSQ_SCALE = 4096.0f;
__device__ __forceinline__ float ssq_ld(const float* p) { return (float)__float_as_uint(*p) * (1.0f / SSQ_SCALE); }
__device__ __forceinline__ unsigned ssq_fx(float s) { return (unsigned)(s * SSQ_SCALE + 0.5f); }
#define LDS_WAIT() asm volatile("s_waitcnt lgkmcnt(0)" ::: "memory")

namespace pg8 {
constexpr int BM = 256, BK = 64, HALF = 128, HTB = HALF * BK * 2, STAGE_BYTES = 8 * HTB, NXCD = 8, WGM = 8;
__host__ __device__ __forceinline__ int lds_byte(int r, int c) { const int st = (r >> 4) * 2 + (c >> 5), rr = r & 15, cc = c & 31, ob = rr * 64 + cc * 2; return st * 1024 + (ob ^ (((ob >> 9) & 1) << 5)); }
__host__ __device__ __forceinline__ void stage_rc(int b, int& R, int& C) { const int st = b / 1024, sb = b % 1024, swz = sb ^ (((sb >> 9) & 1) << 5); R = (st >> 1) * 16 + swz / 64; C = (st & 1) * 32 + (swz % 64) / 2; }
__host__ __device__ __forceinline__ int perm32(int rho) { const int n = rho >> 4, i = rho & 15; return 8 * (i >> 2) + 4 * n + (i & 3); }
struct Unit { int pm, pn; };
struct Gemm { int lda, ldb, K, ks_shift; size_t seg_bytes; };
__device__ __forceinline__ int seq_of_pm(int pm) { return pm < 64 ? (pm >> 3) : 8 + ((pm - 64) >> 4); }
struct Sched {
    int nM, nN, nwg, G, c, mode;
    const char* A; const char* B; const char* A2; const char* B2; int lda, ldb;
    __device__ void init(int nM_, int nN_, int mode_, const void* A_, int lda_, const void* B_, int ldb_) { nM = nM_; nN = nN_; nwg = nM * nN; G = (int)gridDim.x; c = (int)blockIdx.x; mode = mode_; A = (const char*)A_; B = (const char*)B_; A2 = A; B2 = B; lda = lda_; ldb = ldb_; }
    __device__ bool next(int i, Unit& u) const {
        const long L = (long)i * G + c; if (L >= nwg) return false;
        if (mode == 3) { if (L < 48) { u.pm = (int)(L % 12); u.pn = (int)(L / 12); } else { const int r = (int)L - 48; u.pm = 64 + (r & 3); u.pn = r >> 2; } return true; }
        int wgid = (int)L; { const int q = nwg / NXCD, r = nwg % NXCD, xcd = wgid % NXCD, off = wgid / NXCD; wgid = (xcd < r ? xcd * (q + 1) : r * (q + 1) + (xcd - r) * q) + off; }
        const int nig = WGM * nN, gid = wgid / nig, fm = gid * WGM, gsz = (nM - fm) < WGM ? (nM - fm) : WGM;
        u.pm = fm + ((wgid % nig) % gsz); u.pn = (wgid % nig) / gsz; return true;
    }
    __device__ __forceinline__ const char* abase(const Unit& u) const {
        if (mode == 0) return A + (size_t)u.pm * 256 * lda * 2;
        if (mode == 3) return (u.pm < 64 ? A : A2) + (size_t)(u.pm & 63) * 256 * lda * 2;
        return A + ((size_t)u.pm * 256 * lda + (size_t)u.pn * 256) * 2;
    }
    __device__ __forceinline__ const char* bbase(const Unit& u) const {
        if (mode == 0) return B + (size_t)u.pn * 256 * ldb * 2;
        if (mode == 3) return (u.pm < 64 ? B : B2) + (size_t)u.pn * 256 * ldb * 2;
        if (mode == 1) return B + ((size_t)seq_of_pm(u.pm) * 256 * ldb + (size_t)u.pn * 256) * 2;
        return B + ((size_t)u.pn * 256 * ldb + (size_t)seq_of_pm(u.pm) * 256) * 2;
    }
};

template <class Epi>
__device__ __forceinline__ void gemm_phase(LAS unsigned char* lds, const Gemm g, const Sched& S, const Epi& E) {
    const int tid = otid(), wid = __builtin_amdgcn_readfirstlane(tid >> 6), lane = tid & 63, wr = wid >> 2, wc = wid & 3, fr = lane & 15, fq = lane >> 4;
    const int nt = g.K / BK;
    unsigned voffA[2], voffB[2];
#pragma unroll
    for (int i = 0; i < 2; ++i) { int R, C; stage_rc(tid * 16 + i * 8192, R, C); const int Rb = Epi::PERM ? ((R & ~31) + perm32(R & 31)) : R;
        voffA[i] = (unsigned)(R * g.lda + C) * 2u; voffB[i] = (unsigned)(Rb * g.ldb + C) * 2u; }
    const size_t kstep = (size_t)(BK * 2);
    const size_t hstepA = (size_t)HALF * g.lda * 2, hstepB = (size_t)HALF * g.ldb * 2;
    const int ksm = (1 << g.ks_shift) - 1;
#define PG8_AKT(p, t) ((p) + (size_t)((t) >> g.ks_shift) * g.seg_bytes + (size_t)((t) & ksm) * kstep)
    const unsigned ldsw = (unsigned)wid * 1024u;
    const int aoff = lds_byte(wr * 64 + fr, fq * 8), boff = lds_byte(wc * 32 + fr, fq * 8);
#define PG8_SA(b, h) (((b) * 2 + (h)) * HTB)
#define PG8_SB(b, h) ((4 + (b) * 2 + (h)) * HTB)
#define PG8_STAGE(bufoff, gbase, voff) do { _Pragma("unroll") for (int _i = 0; _i < 2; ++_i) \
        __builtin_amdgcn_global_load_lds((const unsigned*)((const char*)(gbase) + (voff)[_i]), (LAS unsigned*)(lds + (bufoff) + ldsw + _i * 8192), 16, 0, 0); } while (0)
#define PG8_LDA(dst, b, h) do { _Pragma("unroll") for (int m = 0; m < 4; ++m) _Pragma("unroll") for (int k = 0; k < 2; ++k) dst[m][k] = *(const LAS bf16x8*)(lds + PG8_SA(b, h) + aoff + m * 2048 + k * 1024); } while (0)
#define PG8_LDB(dst, b, h) do { _Pragma("unroll") for (int n = 0; n < 2; ++n) _Pragma("unroll") for (int k = 0; k < 2; ++k) dst[n][k] = *(const LAS bf16x8*)(lds + PG8_SB(b, h) + boff + n * 2048 + k * 1024); } while (0)
#define PG8_MMA(ai, bj, At, Bt) do { __builtin_amdgcn_s_setprio(1); _Pragma("unroll") for (int m = 0; m < 4; ++m) _Pragma("unroll") for (int n = 0; n < 2; ++n) _Pragma("unroll") for (int k = 0; k < 2; ++k) \
        acc[ai][bj][m][n] = __builtin_amdgcn_mfma_f32_16x16x32_bf16(Bt[n][k], At[m][k], acc[ai][bj][m][n], 0, 0, 0); __builtin_amdgcn_s_setprio(0); } while (0)
#define PG8_WAIT_V(n) asm volatile("s_waitcnt vmcnt(" #n ")" ::: "memory")
#define PG8_WAIT_L(n) asm volatile("s_waitcnt lgkmcnt(" #n ")" ::: "memory")
#define PG8_BAR __builtin_amdgcn_s_barrier()
#define PG8_SCHED __builtin_amdgcn_sched_barrier(0)
    Unit cur, nxt; int ui = 0;
    if (!S.next(0, cur)) return;
    f32x4 acc[2][2][4][2];
#pragma unroll
    for (int a = 0; a < 2; ++a)
#pragma unroll
        for (int b = 0; b < 2; ++b)
#pragma unroll
            for (int m = 0; m < 4; ++m)
#pragma unroll
                for (int n = 0; n < 2; ++n) acc[a][b][m][n] = (f32x4){0.f, 0.f, 0.f, 0.f};
    bf16x8 At[4][2], B0[2][2], B1[2][2];
    const char* cA = S.abase(cur); const char* cB = S.bbase(cur);
    PG8_STAGE(PG8_SB(0, 0), cB, voffB); PG8_STAGE(PG8_SA(0, 0), cA, voffA); PG8_STAGE(PG8_SB(0, 1), cB + hstepB, voffB); PG8_STAGE(PG8_SA(0, 1), cA + hstepA, voffA);
    if (wr == 1) PG8_BAR;
    PG8_WAIT_V(4); PG8_BAR;
    PG8_STAGE(PG8_SB(1, 0), cB + kstep, voffB); PG8_STAGE(PG8_SA(1, 0), PG8_AKT(cA, 1), voffA); PG8_STAGE(PG8_SB(1, 1), cB + hstepB + kstep, voffB);
    PG8_WAIT_V(6); PG8_BAR;
    for (;;) {
        const bool has_next = S.next(ui + 1, nxt);
        const char* nA = has_next ? S.abase(nxt) : cA; const char* nB = has_next ? S.bbase(nxt) : cB;
        for (int t = 0; t < nt; t += 2) {
            const bool last = (t == nt - 2);
            const char* a1 = PG8_AKT(cA, t + 1);
            const char* a2 = last ? nA : PG8_AKT(cA, t + 2); const char* b2 = last ? nB : cB + (size_t)(t + 2) * kstep;
            const char* a3 = last ? PG8_AKT(nA, 1) : PG8_AKT(cA, t + 3); const char* b3 = b2 + kstep;
            PG8_LDB(B0, 0, 0); PG8_SCHED; PG8_LDA(At, 0, 0); PG8_STAGE(PG8_SA(1, 1), a1 + hstepA, voffA);
            PG8_WAIT_L(8); PG8_BAR; PG8_WAIT_L(0); PG8_MMA(0, 0, At, B0); PG8_BAR; PG8_SCHED;
            PG8_LDB(B1, 0, 1); PG8_STAGE(PG8_SB(0, 0), b2, voffB);
            PG8_BAR; PG8_WAIT_L(0); PG8_MMA(0, 1, At, B1); PG8_BAR;
            PG8_LDA(At, 0, 1); PG8_STAGE(PG8_SA(0, 0), a2, voffA);
            PG8_BAR; PG8_WAIT_L(0); PG8_MMA(1, 0, At, B0); PG8_BAR; PG8_SCHED;
            PG8_STAGE(PG8_SB(0, 1), b2 + hstepB, voffB);
            PG8_WAIT_V(6); PG8_BAR; PG8_MMA(1, 1, At, B1); PG8_BAR;
            PG8_LDB(B0, 1, 0); PG8_SCHED; PG8_LDA(At, 1, 0); PG8_STAGE(PG8_SA(0, 1), a2 + hstepA, voffA);
            PG8_WAIT_L(8); PG8_BAR; PG8_WAIT_L(0); PG8_MMA(0, 0, At, B0); PG8_BAR; PG8_SCHED;
            PG8_LDB(B1, 1, 1); PG8_STAGE(PG8_SB(1, 0), b3, voffB);
            PG8_BAR; PG8_WAIT_L(0); PG8_MMA(0, 1, At, B1); PG8_BAR;
            PG8_LDA(At, 1, 1); PG8_STAGE(PG8_SA(1, 0), a3, voffA);
            PG8_BAR; PG8_WAIT_L(0); PG8_MMA(1, 0, At, B0); PG8_BAR; PG8_SCHED;
            PG8_STAGE(PG8_SB(1, 1), b3 + hstepB, voffB);
            PG8_WAIT_V(6); PG8_BAR; PG8_MMA(1, 1, At, B1); PG8_BAR;
        }
        E(acc, cur, wr, wc, fr, fq);
        if (!has_next) break;
#pragma unroll
        for (int a = 0; a < 2; ++a)
#pragma unroll
            for (int b = 0; b < 2; ++b)
#pragma unroll
                for (int m = 0; m < 4; ++m)
#pragma unroll
                    for (int n = 0; n < 2; ++n) acc[a][b][m][n] = (f32x4){0.f, 0.f, 0.f, 0.f};
        cur = nxt; cA = nA; cB = nB; ++ui;
    }
    PG8_WAIT_V(0);
    if (wr == 0) PG8_BAR;
    PG8_BAR;
#undef PG8_AKT
#undef PG8_SA
#undef PG8_SB
#undef PG8_STAGE
#undef PG8_LDA
#undef PG8_LDB
#undef PG8_MMA
#undef PG8_WAIT_V
#undef PG8_WAIT_L
#undef PG8_BAR
#undef PG8_SCHED
}
}
struct Epi {
    int kind;
    static constexpr bool PERM = true;
    bf16_t* O0; long long d1, d2; int ldc; int csplit, rsplit;
    const float* ssq; float* psum; int row_off; int SCALE, ACT;
    __device__ __forceinline__ void bf_path(const f32x4 (&acc)[2][2][4][2], const pg8::Unit& u, int wr, int wc, int fr, int fq) const {
        int pm = u.pm, pn = u.pn, ai_ = 0;
        if (csplit) { ai_ = pn / csplit; pn = pn % csplit; }
        if (rsplit) { ai_ = pm / rsplit; pm = pm % rsplit; }
        bf16_t* base = O0 + (ai_ >= 1 ? d1 : 0ll) + (ai_ >= 2 ? d2 : 0ll);
        const int lrow0 = pm * 256 + wr * 64 + fr, grow0 = u.pm * 256 + wr * 64 + fr, lcol0 = pn * 256 + wc * 32 + 8 * fq, gcol0 = u.pn * 256 + wc * 32 + 8 * fq;
        f32x4 cs[2][2];
        if (SCALE == 2) {
#pragma unroll
            for (int bj = 0; bj < 2; ++bj)
#pragma unroll
                for (int n = 0; n < 2; ++n) { const u32x4 qu = *(const u32x4*)(ssq + gcol0 + bj * 128 + 4 * n); f32x4 q;
#pragma unroll
                    for (int j = 0; j < 4; ++j) q[j] = rsqrtf((float)qu[j] * (1.0f / SSQ_SCALE) * (1.0f / 1024.0f) + EPS);
                    cs[bj][n] = q; }
        }
        float rsv[2][4];
#pragma unroll
        for (int ai = 0; ai < 2; ++ai)
#pragma unroll
            for (int m = 0; m < 4; ++m) { const int grow = grow0 + ai * 128 + m * 16; float rs = 1.0f;
                if (SCALE == 1) rs = rsqrtf(ssq_ld(ssq + grow + row_off) * (1.0f / 1024.0f) + EPS);
                if (SCALE == 3) { const f32x4 q = *(const f32x4*)(psum + ((size_t)grow * 4 + u.pn) * 4); rs = __builtin_amdgcn_rcpf((q[0] + q[1]) + (q[2] + q[3])); }
                rsv[ai][m] = rs; }
#pragma unroll
        for (int ai = 0; ai < 2; ++ai)
#pragma unroll
            for (int m = 0; m < 4; ++m) {
                const int grow = grow0 + ai * 128 + m * 16;
                const float rs = rsv[ai][m];
                bf16_t* rowp = base + (size_t)(lrow0 + ai * 128 + m * 16) * ldc + lcol0;
                float psacc = 0.f;
#pragma unroll
                for (int bj = 0; bj < 2; ++bj) {
                    f32x4 v0 = acc[ai][bj][m][0], v1 = acc[ai][bj][m][1];
                    if (SCALE == 1 || SCALE == 3) { v0 = v0 * rs; v1 = v1 * rs; }
                    if (SCALE == 2) { v0 = v0 * cs[bj][0]; v1 = v1 * cs[bj][1]; }
                    if (ACT == 1) {
#pragma unroll
                        for (int j = 0; j < 4; ++j) { const float a0 = fmaxf(v0[j], 0.f), a1 = fmaxf(v1[j], 0.f); v0[j] = a0 * a0; v1[j] = a1 * a1; } }
                    if (ACT == 2) {
#pragma unroll
                        for (int j = 0; j < 4; ++j) { v0[j] = __expf(v0[j]); v1[j] = __expf(v1[j]); }
                        psacc += ((v0[0] + v0[1]) + (v0[2] + v0[3])) + ((v1[0] + v1[1]) + (v1[2] + v1[3])); }
                    u32x4 w; w.x = pk2(v0[0], v0[1]); w.y = pk2(v0[2], v0[3]); w.z = pk2(v1[0], v1[1]); w.w = pk2(v1[2], v1[3]);
                    *(u32x4*)(rowp + bj * 128) = w;
                }
                if (ACT == 2) { psacc += __shfl_xor(psacc, 16); psacc += __shfl_xor(psacc, 32); if (fq == 0) psum[((size_t)grow * 4 + u.pn) * 4 + wc] = psacc; }
            }
    }
    float* X; const float* rin0; const float* rin1; bf16_t* xb; float* ssq_out; int rin_bf16, write_x, write_xb;
    __device__ __forceinline__ void operator()(const f32x4 (&acc)[2][2][4][2], const pg8::Unit& u, int wr, int wc, int fr, int fq) const {
        if (kind == 0) bf_path(acc, u, wr, wc, fr, fq); else res_path(acc, u, wr, wc, fr, fq);
    }
    __device__ __forceinline__ void res_path(const f32x4 (&acc)[2][2][4][2], const pg8::Unit& u, int wr, int wc, int fr, int fq) const {
        const int row0 = u.pm * 256 + wr * 64 + fr + row_off, col0 = u.pn * 256 + wc * 32 + 8 * fq;
#pragma unroll
        for (int ai = 0; ai < 2; ++ai) {
            f32x4 rr[4][2][2];
#pragma unroll
            for (int m = 0; m < 4; ++m) { const int row = row0 + ai * 128 + m * 16;
                if (rin_bf16) {
                    const bf16_t* bq = xb + (size_t)row * DM + col0;
#pragma unroll
                    for (int bj = 0; bj < 2; ++bj) { const u32x4 q = *(const u32x4*)(bq + bj * 128);
                        rr[m][bj][0] = (f32x4){bflo(q.x), bfhi(q.x), bflo(q.y), bfhi(q.y)}; rr[m][bj][1] = (f32x4){bflo(q.z), bfhi(q.z), bflo(q.w), bfhi(q.w)}; }
                } else {
                    const float* rp = (row < TP ? rin0 + (size_t)row * DM : rin1 + (size_t)(row - TP) * DM) + col0;
#pragma unroll
                    for (int bj = 0; bj < 2; ++bj) { rr[m][bj][0] = *(const f32x4*)(rp + bj * 128); rr[m][bj][1] = *(const f32x4*)(rp + bj * 128 + 4); } } }
#pragma unroll
            for (int m = 0; m < 4; ++m) {
                const int row = row0 + ai * 128 + m * 16;
                float* xp = X + (size_t)row * DM + col0; bf16_t* bp = xb + (size_t)row * DM + col0;
                float sq = 0.f;
#pragma unroll
                for (int bj = 0; bj < 2; ++bj) {
                    const f32x4 v0 = acc[ai][bj][m][0] + rr[m][bj][0], v1 = acc[ai][bj][m][1] + rr[m][bj][1];
                    if (write_x) { *(f32x4*)(xp + bj * 128) = v0; *(f32x4*)(xp + bj * 128 + 4) = v1; }
                    u32x4 w; w.x = pk2(v0[0], v0[1]); w.y = pk2(v0[2], v0[3]); w.z = pk2(v1[0], v1[1]); w.w = pk2(v1[2], v1[3]);
                    if (write_xb) *(u32x4*)(bp + bj * 128) = w;
                    sq += ((v0[0] * v0[0] + v0[1] * v0[1]) + (v0[2] * v0[2] + v0[3] * v0[3])) + ((v1[0] * v1[0] + v1[1] * v1[1]) + (v1[2] * v1[2] + v1[3] * v1[3]));
                }
                sq += __shfl_xor(sq, 16); sq += __shfl_xor(sq, 32);
                if (fq == 0) atomicAdd((unsigned*)(ssq_out + row), ssq_fx(sq));
            }
        }
    }
};

struct Args { const float* in[33]; float* out; unsigned char* ws; };
typedef const __attribute__((address_space(4))) Args* ArgsP;
enum { I_XP = 0, I_XS, I_MP, I_MS, I_NMIX, I_WIN, I_HCW, I_HCB, I_FW1, I_FB1, I_FW2, I_FB2, I_FW3, I_FB3, I_FREQ, I_HBIAS, I_HNORM, I_SCW, I_SCB, I_DTB, I_ALOG, I_SD, I_SNORM,
       I_WOUT, I_NXA, I_NMEM, I_WQ, I_WKV, I_WO, I_NMLP, I_WUP, I_WDOWN, I_NFIN };

__device__ __forceinline__ void transpose_item(const float* W, int K, int N, bf16_t* WT, int n0, int k0, int dst_row0, const float* ksc, float gs, LAS float* scr, int lane) {
#pragma unroll 32
    for (int kk = 0; kk < 64; ++kk) { float v = W[(size_t)(k0 + kk) * N + n0 + lane] * gs; if (ksc) v *= ksc[k0 + kk]; scr[kk * 65 + lane] = v; }
    LDS_WAIT();
    const int c = lane & 7;
#pragma unroll
    for (int j = 0; j < 8; ++j) { const int n = (lane >> 3) + 8 * j; const LAS float* sp = scr + (8 * c) * 65 + n;
        u32x4 o; o.x = pk2(sp[0 * 65], sp[1 * 65]); o.y = pk2(sp[2 * 65], sp[3 * 65]); o.z = pk2(sp[4 * 65], sp[5 * 65]); o.w = pk2(sp[6 * 65], sp[7 * 65]);
        *(u32x4*)(WT + (size_t)(dst_row0 + n) * K + k0 + 8 * c) = o; }
    LDS_WAIT();
}
__device__ __forceinline__ void phase_wconv(ArgsP a, int l, LAS unsigned char* lds) {
    const int lane = otid() & 63, wave = otid() >> 6, gw = blockIdx.x * 8 + wave, NGW = gridDim.x * 8;
    LAS float* scr = (LAS float*)(lds + wave * 16896);
    unsigned char* ws = a->ws;
    constexpr int I_IN = 16 * 48, I_OUT = 16 * 16, I_Q = 16 * 16, I_KV = 16 * 32, I_O = 16 * 16, I_UP = 16 * 64, I_DN = 64 * 16;
    constexpr int NIT = I_IN + I_OUT + I_Q + I_KV + I_O + I_UP + I_DN;
    for (int it = gw; it < NIT; it += NGW) {
        int r = it;
        if (r < I_IN) { const int kb = r / 48, nb = r % 48, n0 = nb * 64;
            if (n0 < 1536) transpose_item(a->in[I_WIN] + (size_t)l * 1024 * 3088, 1024, 3088, (bf16_t*)(ws + WS_WHY), n0, kb * 64, n0, a->in[I_NMIX] + l * 1024, 1.f, scr, lane);
            else transpose_item(a->in[I_WIN] + (size_t)l * 1024 * 3088, 1024, 3088, (bf16_t*)(ws + WS_WSSM), n0, kb * 64, n0 - 1536, a->in[I_NMIX] + l * 1024, 1.f, scr, lane);
            continue; } r -= I_IN;
        if (r < I_OUT) { const int kb = r / 16, nb = r % 16; transpose_item(a->in[I_WOUT] + (size_t)l * 1024 * 1024, 1024, 1024, (bf16_t*)(ws + WS_WOUT), nb * 64, kb * 64, nb * 64, nullptr, 1.f, scr, lane); continue; } r -= I_OUT;
        if (r < I_Q) { const int kb = r / 16, nb = r % 16; transpose_item(a->in[I_WQ] + (size_t)l * 1024 * 1024, 1024, 1024, (bf16_t*)(ws + WS_WQ), nb * 64, kb * 64, nb * 64, a->in[I_NXA] + l * 1024, 0.0625f, scr, lane); continue; } r -= I_Q;
        if (r < I_KV) { const int kb = r / 32, nb = r % 32, n0 = nb * 64;
            if (n0 < 1024) transpose_item(a->in[I_WKV] + (size_t)l * 1024 * 2048, 1024, 2048, (bf16_t*)(ws + WS_WK), n0, kb * 64, n0, a->in[I_NMEM] + l * 1024, 1.f, scr, lane);
            else transpose_item(a->in[I_WKV] + (size_t)l * 1024 * 2048, 1024, 2048, (bf16_t*)(ws + WS_WV), n0, kb * 64, n0 - 1024, a->in[I_NMEM] + l * 1024, 1.f, scr, lane);
            continue; } r -= I_KV;
        if (r < I_O) { const int kb = r / 16, nb = r % 16; transpose_item(a->in[I_WO] + (size_t)l * 1024 * 1024, 1024, 1024, (bf16_t*)(ws + WS_WO), nb * 64, kb * 64, nb * 64, nullptr, 1.f, scr, lane); continue; } r -= I_O;
        if (r < I_UP) { const int kb = r / 64, nb = r % 64; transpose_item(a->in[I_WUP] + (size_t)l * 1024 * 4096, 1024, 4096, (bf16_t*)(ws + WS_WUP), nb * 64, kb * 64, nb * 64, a->in[I_NMLP] + l * 1024, 1.f, scr, lane); continue; } r -= I_UP;
        { const int kb = r / 16, nb = r % 16; transpose_item(a->in[I_WDOWN] + (size_t)l * 4096 * 1024, 4096, 1024, (bf16_t*)(ws + WS_WDOWN), nb * 64, kb * 64, nb * 64, nullptr, 1.f, scr, lane); }
    }
    bf16_t* wdt = (bf16_t*)(ws + WS_WDT);
    for (int i = blockIdx.x * 512 + otid(); i < 16 * 512; i += gridDim.x * 512) { const int j = i >> 9, k = (i & 511) * 2;
        const float v0 = a->in[I_NMIX][l * 1024 + k] * a->in[I_WIN][((size_t)l * 1024 + k) * 3088 + 3072 + j], v1 = a->in[I_NMIX][l * 1024 + k + 1] * a->in[I_WIN][((size_t)l * 1024 + k + 1) * 3088 + 3072 + j];
        *(unsigned*)(wdt + j * 1024 + k) = pk2(v0, v1); }
}
__device__ __forceinline__ const float* xin_row(ArgsP a, int t) { return t < TP ? a->in[I_XP] + (size_t)t * DM : a->in[I_XS] + (size_t)(t - TP) * DM; }

__device__ __forceinline__ void phase_prologue(ArgsP a, LAS unsigned char* lds) {
    const int lane = otid() & 63, wave = otid() >> 6, gw = blockIdx.x * 8 + wave, NGW = gridDim.x * 8;
    unsigned char* ws = a->ws;
    float* ssq = (float*)(ws + WS_SSQ);
    for (int i = blockIdx.x * 512 + otid(); i < 6 * T_ALL; i += gridDim.x * 512) ssq[T_ALL + i] = 0.f;
    { f32x2* tw = (f32x2*)(ws + WS_TW); for (int i = blockIdx.x * 512 + otid(); i < 4096; i += gridDim.x * 512) { float s, c; sincospif(-(float)i * (1.0f / 4096.0f), &s, &c); tw[i] = (f32x2){c, s}; } }
    bf16_t* xb = (bf16_t*)(ws + WS_XB);
    for (int t = gw; t < T_ALL; t += 2 * NGW) {
        f32x4 v[2][4];
#pragma unroll
        for (int r = 0; r < 2; ++r) { const f32x4* xr = (const f32x4*)xin_row(a, t + r * NGW) + lane;
#pragma unroll
            for (int j = 0; j < 4; ++j) v[r][j] = xr[64 * j]; }
#pragma unroll
        for (int r = 0; r < 2; ++r) { float s = 0.f; u32x2* o = (u32x2*)(xb + (size_t)(t + r * NGW) * DM) + lane;
#pragma unroll
            for (int j = 0; j < 4; ++j) { const f32x4 x = v[r][j]; s += (x[0] * x[0] + x[1] * x[1]) + (x[2] * x[2] + x[3] * x[3]); u32x2 w; w.x = pk2(x[0], x[1]); w.y = pk2(x[2], x[3]); o[64 * j] = w; }
            s = wave_sum(s); if (lane == 0) ssq[t + r * NGW] = __uint_as_float(ssq_fx(s)); }
    }
    bf16_t* memb = (bf16_t*)(ws + WS_MEMB);
    for (int t = gw; t < 3072; t += NGW) {
        const float* mr = t < 2048 ? a->in[I_MP] + (size_t)t * DM : a->in[I_MS] + (size_t)(t - 2048) * DM;
        const f32x4* xr = (const f32x4*)mr + lane; f32x4 v[4]; float s = 0.f;
#pragma unroll
        for (int j = 0; j < 4; ++j) { v[j] = xr[64 * j]; s += (v[j][0] * v[j][0] + v[j][1] * v[j][1]) + (v[j][2] * v[j][2] + v[j][3] * v[j][3]); }
        const float rs = rsqrtf(wave_sum(s) * (1.0f / 1024.0f) + EPS);
        u32x2* o = (u32x2*)(memb + (size_t)t * DM) + lane;
#pragma unroll
        for (int j = 0; j < 4; ++j) { u32x2 w; w.x = pk2(v[j][0] * rs, v[j][1] * rs); w.y = pk2(v[j][2] * rs, v[j][3] * rs); o[64 * j] = w; }
    }
    float* h2 = (float*)(ws + WS_H2);
    for (int idx = gw; idx < 2 * 6144; idx += NGW) {
        const int l = idx / 6144, r = idx % 6144, set = r >= 2048 ? 1 : 0, t = set ? r - 2048 : r, L = set ? 4096 : 2048;
        const float tl = (float)t / (float)(L - 1), w = (6.283185307179586f / (float)L) * (float)t;
        const float fm = 1e-4f + (float)(lane & 15) * ((15.0f - 1e-4f) / 15.0f);
        float sv, cv; sincosf(fm * w, &sv, &cv);
        const float* fw1 = a->in[I_FW1] + l * 33 * 64; const float* fw2 = a->in[I_FW2] + l * 64 * 64;
        float acc = a->in[I_FB1][l * 64 + lane] + tl * fw1[lane];
#pragma unroll
        for (int i = 0; i < 16; ++i) { acc += __shfl(cv, i) * fw1[(1 + i) * 64 + lane]; acc -= __shfl(sv, i) * fw1[(17 + i) * 64 + lane]; }
        const float fr = a->in[I_FREQ][l * 64 + lane];
        const float h1 = sinf(fr * acc);
        float acc2 = a->in[I_FB2][l * 64 + lane];
#pragma unroll 8
        for (int i = 0; i < 64; ++i) acc2 += __shfl(h1, i) * fw2[i * 64 + lane];
        h2[(size_t)idx * 64 + lane] = sinf(fr * acc2);
    }
}
__device__ __forceinline__ void phase_dt(ArgsP a, int l, const bf16_t* xb, const float* ssq_in) {
    const int tid = otid(), lane = tid & 63, wave = tid >> 6, gw = blockIdx.x * 8 + wave, NGW = gridDim.x * 8, fr = lane & 15, fq = lane >> 4;
    const bf16_t* wdt = (const bf16_t*)(a->ws + WS_WDT); float* dt = (float*)(a->ws + WS_DT);
    for (int tile = gw; tile < T_ALL / 16; tile += NGW) {
        const int t0 = tile * 16;
        const bf16_t* ap = xb + (size_t)(t0 + fr) * DM + fq * 8; const bf16_t* bp = wdt + fr * 1024 + fq * 8;
        f32x4 acc = {0.f, 0.f, 0.f, 0.f};
#pragma unroll 16
        for (int ks = 0; ks < 32; ++ks) acc = __builtin_amdgcn_mfma_f32_16x16x32_bf16(*(const bf16x8*)(ap + ks * 32), *(const bf16x8*)(bp + ks * 32), acc, 0, 0, 0);
        const float bias = a->in[I_DTB][l * 16 + fr];
#pragma unroll
        for (int r = 0; r < 4; ++r) { const int t = t0 + fq * 4 + r; const float x = acc[r] * rsqrtf(ssq_ld(ssq_in + t) * (1.0f / 1024.0f) + EPS) + bias; dt[(size_t)t * 16 + fr] = x > 20.f ? x : log1pf(expf(x)); }
    }
}
__device__ __forceinline__ void phase_final(ArgsP a, const float* ssq, const bf16_t* xb) {
    const int lane = otid() & 63, wave = otid() >> 6, gw = blockIdx.x * 8 + wave, NGW = gridDim.x * 8;
    f32x4 g[4];
#pragma unroll
    for (int j = 0; j < 4; ++j) g[j] = *((const f32x4*)a->in[I_NFIN] + lane + 64 * j);
    for (int t = gw; t < T_ALL; t += 4 * NGW) {
        u32x2 q[4][4]; float rs[4];
#pragma unroll
        for (int r = 0; r < 4; ++r) { const int tr = t + r * NGW; rs[r] = rsqrtf(ssq_ld(ssq + tr) * (1.0f / 1024.0f) + EPS);
            const u32x2* xr = (const u32x2*)(xb + (size_t)tr * DM) + lane;
#pragma unroll
            for (int j = 0; j < 4; ++j) q[r][j] = xr[64 * j]; }
#pragma unroll
        for (int r = 0; r < 4; ++r) { f32x4* orow = (f32x4*)(a->out + (size_t)(t + r * NGW) * DM) + lane;
#pragma unroll
            for (int j = 0; j < 4; ++j) orow[64 * j] = (f32x4){bflo(q[r][j].x), bfhi(q[r][j].x), bflo(q[r][j].y), bfhi(q[r][j].y)} * rs[r] * g[j]; }
    }
}
__device__ __forceinline__ void phase_ssm_norm(ArgsP a, int l, bf16_t* buf) {
    const int lane = otid() & 63, wave = otid() >> 6, gw = blockIdx.x * 8 + wave, NGW = gridDim.x * 8;
    const float* gn = a->in[I_SNORM] + l * 512 + lane * 8;
    float g[8];
#pragma unroll
    for (int j = 0; j < 8; ++j) g[j] = gn[j];
    for (int t = gw; t < T_ALL; t += 4 * NGW) {
        u32x4 wv[4];
#pragma unroll
        for (int q = 0; q < 4; ++q) wv[q] = *((const u32x4*)(buf + (size_t)(t + q * NGW) * 512) + lane);
#pragma unroll
        for (int q = 0; q < 4; ++q) { const u32x4 w = wv[q];
            float v[8] = {bflo(w.x), bfhi(w.x), bflo(w.y), bfhi(w.y), bflo(w.z), bfhi(w.z), bflo(w.w), bfhi(w.w)};
            float s = 0.f;
#pragma unroll
            for (int j = 0; j < 8; ++j) s += v[j] * v[j];
            const float rs = rsqrtf(wave_sum(s) * (1.0f / 512.0f) + EPS);
            u32x4 o; o.x = pk2(v[0] * rs * g[0], v[1] * rs * g[1]); o.y = pk2(v[2] * rs * g[2], v[3] * rs * g[3]); o.z = pk2(v[4] * rs * g[4], v[5] * rs * g[5]); o.w = pk2(v[6] * rs * g[6], v[7] * rs * g[7]);
            *((u32x4*)(buf + (size_t)(t + q * NGW) * 512) + lane) = o; }
    }
}
constexpr int SLD = 136;
__device__ __forceinline__ int tsw(int p, int s) { return p * SLD + ((((s >> 3) ^ ((p >> 4) & 7)) << 3) | (s & 7)); }
__device__ __forceinline__ void seq_bounds(int t0, int& lo, int& hi) { if (t0 < TP) { lo = t0 & ~2047; hi = lo + 2048; } else { lo = TP + ((t0 - TP) & ~4095); hi = lo + 4096; } }
__device__ __forceinline__ float silu_f(float x) { return x * __builtin_amdgcn_rcpf(1.0f + __expf(-x)); }

template <int NC, bool TRANS>
__device__ __forceinline__ void load_conv_tile(const bf16_t* src, int ldsrc, int col0, int t0, int lo, int hi, const float* cw, const float* cbias, int ch0, LAS bf16_t* dst) {
    constexpr int CGS = NC / 8, RUNS = 512 / CGS, R = 128 / RUNS;
    const int tid = otid(), cgi = tid % CGS, run = tid / CGS, c = cgi * 8, r0 = run * R;
    float w[5][8], bb[8];
#pragma unroll
    for (int k = 0; k < 5; ++k) { const f32x4 a0 = *(const f32x4*)(cw + k * 1024 + ch0 + c), a1 = *(const f32x4*)(cw + k * 1024 + ch0 + c + 4);
#pragma unroll
        for (int e = 0; e < 4; ++e) { w[k][e] = a0[e]; w[k][4 + e] = a1[e]; } }
    { const f32x4 a0 = *(const f32x4*)(cbias + ch0 + c), a1 = *(const f32x4*)(cbias + ch0 + c + 4);
#pragma unroll
      for (int e = 0; e < 4; ++e) { bb[e] = a0[e]; bb[4 + e] = a1[e]; } }
    u32x4 raw[R + 4];
#pragma unroll
    for (int i = 0; i < R + 4; ++i) { const int t = t0 + r0 - 2 + i, tc = t < lo ? lo : (t >= hi ? hi - 1 : t);
        u32x4 q = *(const u32x4*)(src + (size_t)tc * ldsrc + col0 + c);
        if (t < lo || t >= hi) q = (u32x4){0u, 0u, 0u, 0u};
        raw[i] = q; }
    float win[5][8];
    auto cvrow = [&](const u32x4 q, float (&o)[8]) { o[0] = bflo(q.x); o[1] = bfhi(q.x); o[2] = bflo(q.y); o[3] = bfhi(q.y); o[4] = bflo(q.z); o[5] = bfhi(q.z); o[6] = bflo(q.w); o[7] = bfhi(q.w); };
#pragma unroll
    for (int i = 0; i < 4; ++i) cvrow(raw[i], win[i]);
    unsigned outp[8][R / 2];
#pragma unroll
    for (int rr = 0; rr < R; ++rr) {
        cvrow(raw[rr + 4], win[(rr + 4) % 5]);
        float o[8];
#pragma unroll
        for (int e = 0; e < 8; ++e) { float s = bb[e];
#pragma unroll
            for (int k = 0; k < 5; ++k) s += w[k][e] * win[(rr + k) % 5][e];
            o[e] = silu_f(s); }
        if (!TRANS) { u32x4 q; q.x = pk2(o[0], o[1]); q.y = pk2(o[2], o[3]); q.z = pk2(o[4], o[5]); q.w = pk2(o[6], o[7]); *(LAS u32x4*)(dst + (r0 + rr) * SLD + c) = q; }
        else {
#pragma unroll
            for (int e = 0; e < 8; ++e) { if (rr & 1) outp[e][rr >> 1] = (outp[e][rr >> 1] & 0xffffu) | (pk2(0.f, o[e]) & 0xffff0000u); else outp[e][rr >> 1] = pk2(o[e], 0.f) & 0xffffu; } }
    }
    if (TRANS) {
#pragma unroll
        for (int e = 0; e < 8; ++e) {
            if (R == 8) { u32x4 q; q.x = outp[e][0]; q.y = outp[e][1]; q.z = outp[e][2]; q.w = outp[e][R / 2 - 1]; *(LAS u32x4*)(dst + tsw(c + e, r0)) = q; }
            else { u32x2 q; q.x = outp[e][0]; q.y = outp[e][R / 2 - 1]; *(LAS u32x2*)(dst + tsw(c + e, r0)) = q; }
        }
    }
}
__device__ __forceinline__ void chunk_scan(const float* dt, int t0, int col, float A, int dir, int lane, float& d0, float& d1, float& c0, float& c1, float& total) {
    d0 = dt[(size_t)(t0 + 2 * lane) * 16 + col]; d1 = dt[(size_t)(t0 + 2 * lane + 1) * 16 + col];
    const float a0 = d0 * A, a1 = d1 * A;
    float v = a0 + a1;
#pragma unroll
    for (int d = 1; d < 64; d <<= 1) { const float tt = __shfl_up(v, d); if (lane >= d) v += tt; }
    total = __shfl(v, 63);
    const float p0 = v - a1, p1 = v;
    if (dir == 0) { c0 = p0; c1 = p1; } else { c0 = total - p0 + a0; c1 = total - p1 + a1; }
}
__device__ __forceinline__ bf16x8 scale_frag8(bf16x8 f, const float (&sc)[8]) {
    union { bf16x8 v; unsigned u[4]; } in, out; in.v = f;
#pragma unroll
    for (int j = 0; j < 4; ++j) out.u[j] = pk2(bflo(in.u[j]) * sc[2 * j], bfhi(in.u[j]) * sc[2 * j + 1]);
    return out.v;
}
__device__ __forceinline__ void phase_s1(ArgsP a, int l, int cbase, LAS unsigned char* lds, const bf16_t* xs_raw, const bf16_t* bc_raw, bf16_t* states) {
    const int tid = otid(), lane = tid & 63, wave = __builtin_amdgcn_readfirstlane(tid >> 6);
    LAS bf16_t* xsT = (LAS bf16_t*)lds;
    LAS bf16_t* BT = (LAS bf16_t*)(lds + 256 * SLD * 2);
    LAS float* sW = (LAS float*)(lds + 384 * SLD * 2);
    const float* dt = (const float*)(a->ws + WS_DT); float* decay = (float*)(a->ws + WS_DECAY);
    const float* cw = a->in[I_SCW] + l * 5 * 1024; const float* cbs = a->in[I_SCB] + l * 1024;
    for (int it = blockIdx.x; it < 256; it += gridDim.x) {
        const int gc = cbase + (it >> 1), g = it & 1, t0 = gc * 128; int lo, hi; seq_bounds(t0, lo, hi);
        const int hh = wave >> 1, dir = wave & 1, h8 = g * 4 + hh;
        { float d0, d1, c0, c1, tot; const float A = -__expf(a->in[I_ALOG][l * 16 + dir * 8 + h8]);
          chunk_scan(dt, t0, dir * 8 + h8, A, dir, lane, d0, d1, c0, c1, tot);
          sW[wave * 128 + 2 * lane] = d0 * __expf(tot - c0); sW[wave * 128 + 2 * lane + 1] = d1 * __expf(tot - c1);
          if (lane == 0) decay[gc * 16 + h8 * 2 + dir] = __expf(tot); }
        load_conv_tile<256, true>(xs_raw, 512, g * 256, t0, lo, hi, cw, cbs, g * 256, xsT);
        load_conv_tile<128, true>(bc_raw, 512, g * 128, t0, lo, hi, cw, cbs, 512 + g * 128, BT);
        __syncthreads();
        f32x4 acc[8][4];
#pragma unroll
        for (int i = 0; i < 8; ++i)
#pragma unroll
            for (int j = 0; j < 4; ++j) acc[i][j] = (f32x4){0.f, 0.f, 0.f, 0.f};
        const int fr = lane & 15, fq = lane >> 4;
#pragma unroll 1
        for (int ks = 0; ks < 4; ++ks) {
            const int s0 = ks * 32 + fq * 8;
            float sc[8]; { const f32x4 q0 = *(const LAS f32x4*)(sW + wave * 128 + s0), q1 = *(const LAS f32x4*)(sW + wave * 128 + s0 + 4);
#pragma unroll
                for (int e = 0; e < 4; ++e) { sc[e] = q0[e]; sc[4 + e] = q1[e]; } }
            bf16x8 xf[4];
#pragma unroll
            for (int pt = 0; pt < 4; ++pt) xf[pt] = scale_frag8(*(const LAS bf16x8*)(xsT + tsw(hh * 64 + pt * 16 + fr, s0)), sc);
#pragma unroll
            for (int nt = 0; nt < 8; ++nt) { const bf16x8 bf = *(const LAS bf16x8*)(BT + tsw(nt * 16 + fr, s0));
#pragma unroll
                for (int pt = 0; pt < 4; ++pt) acc[nt][pt] = __builtin_amdgcn_mfma_f32_16x16x32_bf16(bf, xf[pt], acc[nt][pt], 0, 0, 0); }
        }
        bf16_t* st = states + ((size_t)((gc - cbase) * 8 + h8) * 2 + dir) * 8192;
#pragma unroll
        for (int nt = 0; nt < 8; ++nt)
#pragma unroll
            for (int pt = 0; pt < 4; ++pt) { u32x2 q; q.x = pk2(acc[nt][pt][0], acc[nt][pt][1]); q.y = pk2(acc[nt][pt][2], acc[nt][pt][3]); *(u32x2*)(st + (pt * 16 + fr) * 128 + nt * 16 + fq * 4) = q; }
        __syncthreads();
    }
}
__device__ __forceinline__ void phase_s2(ArgsP a, int cbase, bf16_t* states, int dry) {
    const int nseq = cbase == 0 ? 8 : 4, cps = cbase == 0 ? 16 : 32;
    const float* decay = (const float*)(a->ws + WS_DECAY);
    const int total = nseq * 16 * 1024;
    for (int i = blockIdx.x * 512 + otid(); i < total; i += gridDim.x * 512) {
        const int e8 = i & 1023, hd = (i >> 10) & 15, sq = i >> 14, dir = hd & 1;
        float hs[8];
#pragma unroll
        for (int j = 0; j < 8; ++j) hs[j] = 0.f;
#pragma unroll 1
        for (int cc0 = 0; cc0 < cps; cc0 += 8) {
            u32x4 w[8]; float dcv[8]; u32x4* pp[8];
#pragma unroll
            for (int u = 0; u < 8; ++u) { const int cc = cc0 + u, crel = sq * cps + (dir ? cps - 1 - cc : cc);
                pp[u] = (u32x4*)(states + ((size_t)crel * 16 + hd) * 8192) + e8; w[u] = *pp[u]; dcv[u] = decay[(cbase + crel) * 16 + hd]; }
#pragma unroll
            for (int u = 0; u < 8; ++u) { const float dc = dcv[u];
                u32x4 o; o.x = pk2(hs[0], hs[1]); o.y = pk2(hs[2], hs[3]); o.z = pk2(hs[4], hs[5]); o.w = pk2(hs[6], hs[7]); if (!dry) *pp[u] = o;
                hs[0] = hs[0] * dc + bflo(w[u].x); hs[1] = hs[1] * dc + bfhi(w[u].x); hs[2] = hs[2] * dc + bflo(w[u].y); hs[3] = hs[3] * dc + bfhi(w[u].y);
                hs[4] = hs[4] * dc + bflo(w[u].z); hs[5] = hs[5] * dc + bfhi(w[u].z); hs[6] = hs[6] * dc + bflo(w[u].w); hs[7] = hs[7] * dc + bfhi(w[u].w); }
        }
    }
}
__device__ __forceinline__ void phase_s3(ArgsP a, int l, int cbase, LAS unsigned char* lds, const bf16_t* xs_raw, const bf16_t* bc_raw, const bf16_t* states, bf16_t* gate, int dry) {
    const int tid = otid(), lane = tid & 63, wave = __builtin_amdgcn_readfirstlane(tid >> 6), fr = lane & 15, fq = lane >> 4;
    LAS bf16_t* xsT = (LAS bf16_t*)lds;
    LAS bf16_t* sC = (LAS bf16_t*)(lds + 128 * SLD * 2);
    LAS bf16_t* sB = (LAS bf16_t*)(lds + 256 * SLD * 2);
    LAS float* sDt = (LAS float*)(lds + 384 * SLD * 2);
    LAS float* sCs = sDt + 1024;
    const float* dt = (const float*)(a->ws + WS_DT);
    const float* cw = a->in[I_SCW] + l * 5 * 1024; const float* cbs = a->in[I_SCB] + l * 1024;
    for (int it = blockIdx.x; it < 256; it += gridDim.x) {
        const int gc = cbase + (it >> 1), g = it & 1, t0 = gc * 128; int lo, hi; seq_bounds(t0, lo, hi);
        { const int w4 = wave, hh4 = w4 >> 1, dir = w4 & 1, h8 = g * 4 + hh4; float d0, d1, c0, c1, tot; const float A = -__expf(a->in[I_ALOG][l * 16 + dir * 8 + h8]);
          chunk_scan(dt, t0, dir * 8 + h8, A, dir, lane, d0, d1, c0, c1, tot);
          { sDt[w4 * 128 + 2 * lane] = d0; sDt[w4 * 128 + 2 * lane + 1] = d1; sCs[w4 * 128 + 2 * lane] = c0; sCs[w4 * 128 + 2 * lane + 1] = c1; } }
        load_conv_tile<128, false>(bc_raw, 512, g * 128, t0, lo, hi, cw, cbs, 512 + g * 128, sB);
        load_conv_tile<128, false>(bc_raw, 512, 256 + g * 128, t0, lo, hi, cw, cbs, 768 + g * 128, sC);
        __syncthreads();
        {
            f32x4 cacc[8];
#pragma unroll
            for (int i = 0; i < 8; ++i) cacc[i] = (f32x4){0.f, 0.f, 0.f, 0.f};
#pragma unroll
            for (int ks = 0; ks < 4; ++ks) { const bf16x8 cf = *(const LAS bf16x8*)(sC + (wave * 16 + fr) * SLD + ks * 32 + fq * 8);
#pragma unroll
                for (int st = 0; st < 8; ++st) { const bf16x8 bf = *(const LAS bf16x8*)(sB + (st * 16 + fr) * SLD + ks * 32 + fq * 8); cacc[st] = __builtin_amdgcn_mfma_f32_16x16x32_bf16(bf, cf, cacc[st], 0, 0, 0); } }
            __syncthreads();
#pragma unroll
            for (int st = 0; st < 8; ++st) { u32x2 q; q.x = pk2(cacc[st][0], cacc[st][1]); q.y = pk2(cacc[st][2], cacc[st][3]); *(LAS u32x2*)(sB + (wave * 16 + fr) * SLD + st * 16 + fq * 4) = q; }
            __syncthreads();
        }
#pragma unroll 1
        for (int hp = 0; hp < 2; ++hp) {
        load_conv_tile<128, true>(xs_raw, 512, g * 256 + hp * 128, t0, lo, hi, cw, cbs, g * 256 + hp * 128, xsT);
        __syncthreads();
        const int hh2 = wave >> 2, lq = wave & 3, h8 = g * 4 + hp * 2 + hh2;
        const float Dh = a->in[I_SD][l * 8 + h8];
        const int hq = hp * 2 + hh2; const LAS float* dtf = sDt + (hq * 2) * 128; const LAS float* dtb = sDt + (hq * 2 + 1) * 128; const LAS float* csf = sCs + (hq * 2) * 128; const LAS float* csb = sCs + (hq * 2 + 1) * 128;
        f32x4 acc[2][4];
#pragma unroll
        for (int i = 0; i < 2; ++i)
#pragma unroll
            for (int j = 0; j < 4; ++j) acc[i][j] = (f32x4){0.f, 0.f, 0.f, 0.f};
#pragma unroll 1
        for (int ks = 0; ks < 4; ++ks) {
            const int s0 = ks * 32 + fq * 8;
            bf16x8 xf[4];
#pragma unroll
            for (int pt = 0; pt < 4; ++pt) xf[pt] = *(const LAS bf16x8*)(xsT + tsw(hh2 * 64 + pt * 16 + fr, s0));
            float vdf[8], vdb[8], vcf[8], vcb[8];
            { const f32x4 q0 = *(const LAS f32x4*)(dtf + s0), q1 = *(const LAS f32x4*)(dtf + s0 + 4), r0 = *(const LAS f32x4*)(dtb + s0), r1 = *(const LAS f32x4*)(dtb + s0 + 4);
              const f32x4 u0 = *(const LAS f32x4*)(csf + s0), u1 = *(const LAS f32x4*)(csf + s0 + 4), w0 = *(const LAS f32x4*)(csb + s0), w1 = *(const LAS f32x4*)(csb + s0 + 4);
#pragma unroll
              for (int e = 0; e < 4; ++e) { vdf[e] = q0[e]; vdf[4 + e] = q1[e]; vdb[e] = r0[e]; vdb[4 + e] = r1[e]; vcf[e] = u0[e]; vcf[4 + e] = u1[e]; vcb[e] = w0[e]; vcb[4 + e] = w1[e]; } }
#pragma unroll
            for (int lt = 0; lt < 2; ++lt) {
                const int lrow = lq * 32 + lt * 16 + fr;
                const float csf_l = csf[lrow], csb_l = csb[lrow];
                const u32x4 cbq = *(const LAS u32x4*)(sB + lrow * SLD + s0);
                const float cbv[8] = {bflo(cbq.x), bfhi(cbq.x), bflo(cbq.y), bfhi(cbq.y), bflo(cbq.z), bfhi(cbq.z), bflo(cbq.w), bfhi(cbq.w)};
                float mv[8];
#pragma unroll
                for (int e = 0; e < 8; ++e) { const int s = s0 + e;
                    const float ex = s < lrow ? csf_l - vcf[e] : csb_l - vcb[e];
                    const float dd = s < lrow ? vdf[e] : vdb[e];
                    float mm = cbv[e] * __expf(ex) * dd;
                    if (s == lrow) mm = cbv[e] * (vdf[e] + vdb[e]) + Dh;
                    mv[e] = mm;
                    }
                union { bf16x8 v; unsigned u[4]; } mf;
#pragma unroll
                for (int j = 0; j < 4; ++j) mf.u[j] = pk2(mv[2 * j], mv[2 * j + 1]);
#pragma unroll
                for (int pt = 0; pt < 4; ++pt) acc[lt][pt] = __builtin_amdgcn_mfma_f32_16x16x32_bf16(xf[pt], mf.v, acc[lt][pt], 0, 0, 0);
            }
        }
#pragma unroll 1
        for (int dir = 0; dir < 2; ++dir) {
            const bf16_t* pv = states + ((size_t)((gc - cbase) * 8 + h8) * 2 + dir) * 8192;
            const LAS float* cs = dir ? csb : csf;
            float el[2];
#pragma unroll
            for (int lt = 0; lt < 2; ++lt) el[lt] = __expf(cs[lq * 32 + lt * 16 + fr]);
#pragma unroll
            for (int ks = 0; ks < 4; ++ks) {
                const int n0 = ks * 32 + fq * 8;
                bf16x8 pf[4];
#pragma unroll
                for (int pt = 0; pt < 4; ++pt) pf[pt] = *(const bf16x8*)(pv + (pt * 16 + fr) * 128 + n0);
#pragma unroll
                for (int lt = 0; lt < 2; ++lt) {
                    const float sc[8] = {el[lt], el[lt], el[lt], el[lt], el[lt], el[lt], el[lt], el[lt]};
                    const bf16x8 cf = scale_frag8(*(const LAS bf16x8*)(sC + (lq * 32 + lt * 16 + fr) * SLD + n0), sc);
#pragma unroll
                    for (int pt = 0; pt < 4; ++pt) acc[lt][pt] = __builtin_amdgcn_mfma_f32_16x16x32_bf16(pf[pt], cf, acc[lt][pt], 0, 0, 0);
                }
            }
        }
        u32x2 gqv[2][4];
#pragma unroll
        for (int lt = 0; lt < 2; ++lt)
#pragma unroll
            for (int pt = 0; pt < 4; ++pt) gqv[lt][pt] = *(const u32x2*)(gate + (size_t)(t0 + lq * 32 + lt * 16 + fr) * 512 + g * 256 + (hp * 2 + hh2) * 64 + pt * 16 + fq * 4);
#pragma unroll
        for (int lt = 0; lt < 2; ++lt)
#pragma unroll
            for (int pt = 0; pt < 4; ++pt) {
                u32x2* gp = (u32x2*)(gate + (size_t)(t0 + lq * 32 + lt * 16 + fr) * 512 + g * 256 + (hp * 2 + hh2) * 64 + pt * 16 + fq * 4);
                const u32x2 gq = gqv[lt][pt];
                u32x2 o; o.x = pk2(acc[lt][pt][0] * silu_f(bflo(gq.x)), acc[lt][pt][1] * silu_f(bfhi(gq.x))); o.y = pk2(acc[lt][pt][2] * silu_f(bflo(gq.y)), acc[lt][pt][3] * silu_f(bfhi(gq.y)));
                if (!dry) *gp = o;
            }
        __syncthreads();
        }
    }
}
__device__ __forceinline__ f32x2 cmul(f32x2 a, f32x2 b) { const f32x2 bx = {b.x, b.x}, by = {b.y, b.y}, ar = {-a.y, a.x}; return a * bx + ar * by; }
__device__ __forceinline__ f32x2 cmulc(f32x2 a, f32x2 b) { const f32x2 bx = {b.x, b.x}, by = {b.y, b.y}, ar = {a.y, -a.x}; return a * bx + ar * by; }
#define DP(e) d[(e) + ((e) >> 4)]
__device__ __forceinline__ f32x2 w16(int k) {
    constexpr float C[8] = {1.f, 0.9238795325112867f, 0.7071067811865476f, 0.3826834323650898f, 0.f, -0.3826834323650898f, -0.7071067811865476f, -0.9238795325112867f};
    constexpr float S[8] = {0.f, 0.3826834323650898f, 0.7071067811865476f, 0.9238795325112867f, 1.f, 0.9238795325112867f, 0.7071067811865476f, 0.3826834323650898f};
    return (f32x2){C[k], -S[k]};
}
__device__ __forceinline__ f32x2 mulw16(f32x2 v, int k) { if (k == 0) return v; if (k == 4) return (f32x2){v.y, -v.x}; return cmul(v, w16(k)); }
__device__ __forceinline__ f32x2 mulw16c(f32x2 v, int k) { if (k == 0) return v; if (k == 4) return (f32x2){-v.y, v.x}; return cmulc(v, w16(k)); }
template <int LOGN, bool FOLD = false, int TPA = 512> __device__ __forceinline__ void fft_fwd(LAS f32x2* d, const LAS f32x2* tw, const int tq) {
    constexpr int N = 1 << LOGN;
    if (LOGN == 13 && !FOLD) {
#pragma unroll
        for (int qi = 0; qi < 8; ++qi) { const int q = tq + 512 * qi; const f32x2 x0 = DP(q), x1 = DP(q + 4096); DP(q) = x0 + x1; DP(q + 4096) = cmul(x0 - x1, tw[q]); }
        __syncthreads();
    }
#pragma unroll 1
    for (int ls = 11; ls >= 7; ls -= 4) {
        const int st = 1 << (ls - 3);
#pragma unroll
        for (int gi = 0; gi < (N / 16 + TPA - 1) / TPA; ++gi) { const int g = tq + TPA * gi;
            if (g < N / 16) {
                const int j = g & (st - 1), blk = g >> (ls - 3), base = (blk << (ls + 1)) + j;
                const f32x2 W1 = tw[j << (12 - ls)], W2 = tw[j << (13 - ls)], W3 = tw[j << (14 - ls)], W4 = tw[j << (15 - ls)];
                f32x2 x[16];
#pragma unroll
                for (int k = 0; k < 16; ++k) x[k] = DP(base + k * st);
#pragma unroll
                for (int k = 0; k < 8; ++k) { const f32x2 a = x[k], b = x[k + 8]; x[k] = a + b; x[k + 8] = cmul(mulw16(a - b, k), W1); }
#pragma unroll
                for (int k = 0; k < 16; ++k) if ((k & 7) < 4) { const f32x2 a = x[k], b = x[k + 4]; x[k] = a + b; x[k + 4] = cmul(mulw16(a - b, 2 * (k & 3)), W2); }
#pragma unroll
                for (int k = 0; k < 16; ++k) if ((k & 3) < 2) { const f32x2 a = x[k], b = x[k + 2]; x[k] = a + b; x[k + 2] = cmul(mulw16(a - b, 4 * (k & 1)), W3); }
#pragma unroll
                for (int k = 0; k < 16; k += 2) { const f32x2 a = x[k], b = x[k + 1]; x[k] = a + b; x[k + 1] = cmul(a - b, W4); }
#pragma unroll
                for (int k = 0; k < 16; ++k) DP(base + k * st) = x[k];
            }
        }
        __syncthreads();
    }
#pragma unroll
    for (int gi = 0; gi < (N / 16 + TPA - 1) / TPA; ++gi) { const int g = tq + TPA * gi;
        if (g < N / 16) {
            f32x2 x[16];
#pragma unroll
            for (int i = 0; i < 16; ++i) x[i] = d[17 * g + i];
#pragma unroll
            for (int i = 0; i < 8; ++i) { const f32x2 a = x[i], b = x[i + 8]; x[i] = a + b; x[i + 8] = mulw16(a - b, i); }
#pragma unroll
            for (int i = 0; i < 16; ++i) if ((i & 7) < 4) { const f32x2 a = x[i], b = x[i + 4]; x[i] = a + b; x[i + 4] = mulw16(a - b, 2 * (i & 3)); }
#pragma unroll
            for (int i = 0; i < 16; ++i) if ((i & 3) < 2) { const f32x2 a = x[i], b = x[i + 2]; x[i] = a + b; x[i + 2] = mulw16(a - b, 4 * (i & 1)); }
#pragma unroll
            for (int i = 0; i < 16; i += 2) { const f32x2 a = x[i], b = x[i + 1]; x[i] = a + b; x[i + 1] = a - b; }
#pragma unroll
            for (int i = 0; i < 16; ++i) d[17 * g + i] = x[i];
        }
    }
    __syncthreads();
}
template <int LOGN, bool FOLD = false, int TPA = 512> __device__ __forceinline__ void fft_inv(LAS f32x2* d, const LAS f32x2* tw, const int tq) {
    constexpr int N = 1 << LOGN;
#pragma unroll
    for (int gi = 0; gi < (N / 16 + TPA - 1) / TPA; ++gi) { const int g = tq + TPA * gi;
        if (g < N / 16) {
            f32x2 x[16];
#pragma unroll
            for (int i = 0; i < 16; ++i) x[i] = d[17 * g + i];
#pragma unroll
            for (int i = 0; i < 16; i += 2) { const f32x2 a = x[i], b = x[i + 1]; x[i] = a + b; x[i + 1] = a - b; }
#pragma unroll
            for (int i = 0; i < 16; ++i) if ((i & 3) < 2) { const f32x2 a = x[i], b = mulw16c(x[i + 2], 4 * (i & 1)); x[i] = a + b; x[i + 2] = a - b; }
#pragma unroll
            for (int i = 0; i < 16; ++i) if ((i & 7) < 4) { const f32x2 a = x[i], b = mulw16c(x[i + 4], 2 * (i & 3)); x[i] = a + b; x[i + 4] = a - b; }
#pragma unroll
            for (int i = 0; i < 8; ++i) { const f32x2 a = x[i], b = mulw16c(x[i + 8], i); x[i] = a + b; x[i + 8] = a - b; }
#pragma unroll
            for (int i = 0; i < 16; ++i) d[17 * g + i] = x[i];
        }
    }
    __syncthreads();
#pragma unroll 1
    for (int ls = 7; ls <= 11; ls += 4) {
        const int st = 1 << (ls - 3);
#pragma unroll
        for (int gi = 0; gi < (N / 16 + TPA - 1) / TPA; ++gi) { const int g = tq + TPA * gi;
            if (g < N / 16) {
                const int j = g & (st - 1), blk = g >> (ls - 3), base = (blk << (ls + 1)) + j;
                const f32x2 W1 = tw[j << (12 - ls)], W2 = tw[j << (13 - ls)], W3 = tw[j << (14 - ls)], W4 = tw[j << (15 - ls)];
                f32x2 x[16];
#pragma unroll
                for (int k = 0; k < 16; ++k) x[k] = DP(base + k * st);
#pragma unroll
                for (int k = 0; k < 16; k += 2) { const f32x2 a = x[k], b = cmulc(x[k + 1], W4); x[k] = a + b; x[k + 1] = a - b; }
#pragma unroll
                for (int k = 0; k < 16; ++k) if ((k & 3) < 2) { const f32x2 a = x[k], b = cmulc(mulw16c(x[k + 2], 4 * (k & 1)), W3); x[k] = a + b; x[k + 2] = a - b; }
#pragma unroll
                for (int k = 0; k < 16; ++k) if ((k & 7) < 4) { const f32x2 a = x[k], b = cmulc(mulw16c(x[k + 4], 2 * (k & 3)), W2); x[k] = a + b; x[k + 4] = a - b; }
#pragma unroll
                for (int k = 0; k < 8; ++k) { const f32x2 a = x[k], b = cmulc(mulw16c(x[k + 8], k), W1); x[k] = a + b; x[k + 8] = a - b; }
#pragma unroll
                for (int k = 0; k < 16; ++k) DP(base + k * st) = x[k];
            }
        }
        __syncthreads();
    }
    if (LOGN == 13 && !FOLD) {
#pragma unroll
        for (int qi = 0; qi < 8; ++qi) { const int q = tq + 512 * qi; const f32x2 u = DP(q), v = cmulc(DP(q + 4096), tw[q]); DP(q) = u + v; DP(q + 4096) = u - v; }
        __syncthreads();
    }
}
constexpr size_t FT_SET0_OFF = (size_t)2 * 512 * 4096;
__device__ __forceinline__ void phase_filter(ArgsP a, int l, LAS unsigned char* lds, float* FT) {
    LAS float* sh = (LAS float*)lds;
    LAS float* sw = (LAS float*)(lds + 64 * 65 * 4);
    const int tid = otid(), lane = tid & 63, wave = tid >> 6;
    const float min_decay = -3.0701134573253944f, max_decay = -15.350567286626972f;
    for (int it = blockIdx.x; it < 1536; it += gridDim.x) {
        const int set = it < 1024 ? 1 : 0, r = set ? it : it - 1024, L = set ? 4096 : 2048, tt0 = (r >> 4) * 64, cc0 = (r & 15) * 64;
        const float* h2 = (const float*)(a->ws + WS_H2) + ((size_t)l * 6144 + (set ? 2048 : 0) + tt0) * 64;
        const float* fw3 = a->in[I_FW3] + (size_t)l * 64 * 1024 + cc0;
        { const int rr = tid >> 3, c8 = (tid & 7) * 8;
          const f32x4 h0 = *(const f32x4*)(h2 + rr * 64 + c8), h1 = *(const f32x4*)(h2 + rr * 64 + c8 + 4);
          const f32x4 w0 = *(const f32x4*)(fw3 + (size_t)rr * 1024 + c8), w1 = *(const f32x4*)(fw3 + (size_t)rr * 1024 + c8 + 4);
#pragma unroll
          for (int e = 0; e < 4; ++e) { sh[rr * 65 + c8 + e] = h0[e]; sh[rr * 65 + c8 + 4 + e] = h1[e]; }
          *(LAS f32x4*)(sw + rr * 64 + c8) = w0; *(LAS f32x4*)(sw + rr * 64 + c8 + 4) = w1; }
        __syncthreads();
        float o[8];
#pragma unroll
        for (int k = 0; k < 8; ++k) o[k] = 0.f;
#pragma unroll 8
        for (int i = 0; i < 64; ++i) { const float hv = sh[lane * 65 + i]; const f32x4 w0 = *(const LAS f32x4*)(sw + i * 64 + wave * 8), w1 = *(const LAS f32x4*)(sw + i * 64 + wave * 8 + 4);
#pragma unroll
            for (int e = 0; e < 4; ++e) { o[e] += hv * w0[e]; o[4 + e] += hv * w1[e]; } }
        const int t = tt0 + lane; const float tl = (float)t / (float)(L - 1);
        float fb[8];
#pragma unroll
        for (int k = 0; k < 8; ++k) fb[k] = a->in[I_FB3][l * 1024 + cc0 + wave * 8 + k];
#pragma unroll
        for (int k = 0; k < 8; ++k) { const int cp = cc0 + wave * 8 + k, dir = cp >> 9, c = cp & 511;
            const float delta = fabsf(min_decay + (float)c * ((max_decay - min_decay) / 511.0f));
            FT[(set ? 0 : FT_SET0_OFF) + ((size_t)dir * 512 + c) * L + t] = (o[k] + fb[k]) * __expf(-tl * delta); }
        __syncthreads();
    }
}
template <int LOGN> __device__ __forceinline__ void hyena_conv_item(ArgsP a, int l, int c, LAS unsigned char* lds, const bf16_t* x1T, bf16_t* vT, const float* FT, int dry) {
    constexpr int N = 1 << LOGN, L = N / 2, SET = (LOGN == 13), NB = SET ? 4 : 8, TOK0 = SET ? TP : 0, TPA = SET ? 512 : 256, NPAR = 512 / TPA, NJ = L / TPA, NK = N / TPA;
    static_assert(NJ == 8 && NK == 16, "shape");
    LAS f32x2* d = (LAS f32x2*)lds;
    LAS f32x2* tw = (LAS f32x2*)(lds + 69632);
    const int tid = otid(), tl = tid % TPA;
    const float* hfT = FT + (SET ? 0 : FT_SET0_OFF) + (size_t)c * L; const float* hbT = hfT + (size_t)512 * L;
#pragma unroll
    for (int j = 0; j < L / 512; ++j) { const int t = tid + 512 * j;
        DP(t) = (f32x2){hfT[t], 0.f};
        if (t >= 1) DP(N - t) = (f32x2){hbT[t], 0.f};
    }
    if (tid == 0) DP(L) = (f32x2){0.f, 0.f};
    __syncthreads();
    fft_fwd<LOGN>(d, tw, tid);
    f32x2 kf[NK];
#pragma unroll
    for (int j = 0; j < NK; ++j) kf[j] = DP(tl + TPA * j) * (1.0f / (float)N);
    __syncthreads();
    const float* cw = a->in[I_HCW] + l * 3 * 1536; const float cb1 = a->in[I_HCB][l * 1536 + 512 + c], cbv = a->in[I_HCB][l * 1536 + 1024 + c];
    const float w10 = cw[512 + c], w11 = cw[1536 + 512 + c], w12 = cw[3072 + 512 + c], wv0 = cw[1024 + c], wv1 = cw[1536 + 1024 + c], wv2 = cw[3072 + 1024 + c];
    const float hbias = a->in[I_HBIAS][l * 512 + c];
    LAS f32x2* const d0 = d; d = d0 + (tid / TPA) * (N + N / 16);
#pragma unroll 1
    for (int bp0 = 0; bp0 < NB / 2; bp0 += NPAR) {
        const int bp = bp0 + tid / TPA;
        const size_t rowA = (size_t)c * T_ALL + TOK0 + (size_t)(2 * bp) * L, rowB = rowA + L;
        float zA[NJ], zB[NJ];
        {
            const int tb = tl * NJ;
            float x1a[NJ + 2], va[NJ + 2], x1b[NJ + 2], vb[NJ + 2];
            auto ldrow = [&](const bf16_t* p, float (&o)[NJ + 2]) {
                const u32x4 q = *(const u32x4*)(p + tb); o[1] = bflo(q.x); o[2] = bfhi(q.x); o[3] = bflo(q.y); o[4] = bfhi(q.y); o[5] = bflo(q.z); o[6] = bfhi(q.z); o[7] = bflo(q.w); o[8] = bfhi(q.w);
                o[0] = tb > 0 ? bf2f(p[tb - 1]) : 0.f; o[NJ + 1] = tb + NJ < L ? bf2f(p[tb + NJ]) : 0.f;
            };
            ldrow(x1T + rowA, x1a); ldrow(vT + rowA, va); ldrow(x1T + rowB, x1b); ldrow(vT + rowB, vb);
#pragma unroll
            for (int jj = 0; jj < NJ; ++jj) {
                zA[jj] = (cb1 + w10 * x1a[jj] + w11 * x1a[jj + 1] + w12 * x1a[jj + 2]) * (cbv + wv0 * va[jj] + wv1 * va[jj + 1] + wv2 * va[jj + 2]);
                zB[jj] = (cb1 + w10 * x1b[jj] + w11 * x1b[jj + 1] + w12 * x1b[jj + 2]) * (cbv + wv0 * vb[jj] + wv1 * vb[jj + 1] + wv2 * vb[jj + 2]);
                const f32x2 zz = {zA[jj], zB[jj]}; DP(tb + jj) = zz; DP(L + tb + jj) = (LOGN == 13) ? cmul(zz, tw[tb + jj]) : (f32x2){0.f, 0.f};
            }
        }
        __syncthreads();
        fft_fwd<LOGN, true, TPA>(d, tw, tl);
#pragma unroll
        for (int j = 0; j < NK; ++j) DP(tl + TPA * j) = cmul(DP(tl + TPA * j), kf[j]);
        __syncthreads();
        fft_inv<LOGN, true, TPA>(d, tw, tl);
        {   const int tb = tl * NJ; unsigned oa[NJ / 2], ob[NJ / 2];
#pragma unroll
            for (int jj = 0; jj < NJ; jj += 2) { f32x2 y0 = DP(tb + jj), y1 = DP(tb + jj + 1);
                if (LOGN == 13) { y0 = y0 + cmulc(DP(L + tb + jj), tw[tb + jj]); y1 = y1 + cmulc(DP(L + tb + jj + 1), tw[tb + jj + 1]); }
                oa[jj / 2] = pk2(y0.x + zA[jj] * hbias, y1.x + zA[jj + 1] * hbias); ob[jj / 2] = pk2(y0.y + zB[jj] * hbias, y1.y + zB[jj + 1] * hbias); }
            if (!dry) { u32x4 qa, qb; qa.x = oa[0]; qa.y = oa[1]; qa.z = oa[2]; qa.w = oa[3]; qb.x = ob[0]; qb.y = ob[1]; qb.z = ob[2]; qb.w = ob[3]; *(u32x4*)(vT + rowA + tb) = qa; *(u32x4*)(vT + rowB + tb) = qb; }
        }
        __syncthreads();
    }
}
__device__ __forceinline__ void phase_hyena_conv(ArgsP a, int l, LAS unsigned char* lds, const bf16_t* x1T, bf16_t* vT, const float* FT, int dry) {
    { LAS f32x2* tw = (LAS f32x2*)(lds + 69632); const f32x2* g = (const f32x2*)(a->ws + WS_TW); for (int i = otid(); i < 4096; i += 512) tw[i] = g[i]; }
    __syncthreads();
    for (int it = blockIdx.x; it < 1024; it += gridDim.x) {
        if (it < 512) hyena_conv_item<13>(a, l, it, lds, x1T, vT, FT, dry);
        else hyena_conv_item<12>(a, l, it - 512, lds, x1T, vT, FT, dry);
    }
}
__device__ __forceinline__ void phase_hyena_norm(ArgsP a, int l, LAS unsigned char* lds, const bf16_t* x0T, const bf16_t* yT, bf16_t* hyn) {
    constexpr int PLD = 513;
    LAS float* P = (LAS float*)lds;
    LAS float* part = (LAS float*)(lds + 64 * PLD * 4);
    const int tid = otid(), lane = tid & 63, wave = tid >> 6, tp = lane & 15, cq = lane >> 4;
    const float* cw = a->in[I_HCW] + l * 3 * 1536; const float* cb = a->in[I_HCB] + l * 1536;
    float hg[8];
#pragma unroll
    for (int j = 0; j < 4; ++j) { hg[2 * j] = a->in[I_HNORM][l * 512 + 2 * lane + 128 * j]; hg[2 * j + 1] = a->in[I_HNORM][l * 512 + 2 * lane + 128 * j + 1]; }
    for (int it = blockIdx.x; it < T_ALL / 64; it += gridDim.x) {
        const int tile0 = it * 64, t = tile0 + 4 * tp; int lo, hi; seq_bounds(tile0, lo, hi);
        const bool hasl = t > lo, hasr = t + 4 < hi;
        float ss0 = 0.f, ss1 = 0.f, ss2 = 0.f, ss3 = 0.f;
#pragma unroll 8
        for (int i = 0; i < 16; ++i) {
            const int c = wave * 64 + 4 * i + cq; const size_t row = (size_t)c * T_ALL;
            const u32x2 xc = *(const u32x2*)(x0T + row + t), yc = *(const u32x2*)(yT + row + t);
            const float xm = hasl ? bf2f(x0T[row + t - 1]) : 0.f, xp = hasr ? bf2f(x0T[row + t + 4]) : 0.f;
            const float x0 = bflo(xc.x), x1 = bfhi(xc.x), x2 = bflo(xc.y), x3 = bfhi(xc.y), w0 = cw[c], w1 = cw[1536 + c], w2 = cw[3072 + c], bb = cb[c];
            const float p0 = (bb + w0 * xm + w1 * x0 + w2 * x1) * bflo(yc.x), p1 = (bb + w0 * x0 + w1 * x1 + w2 * x2) * bfhi(yc.x);
            const float p2 = (bb + w0 * x1 + w1 * x2 + w2 * x3) * bflo(yc.y), p3 = (bb + w0 * x2 + w1 * x3 + w2 * xp) * bfhi(yc.y);
            P[(4 * tp) * PLD + c] = p0; P[(4 * tp + 1) * PLD + c] = p1; P[(4 * tp + 2) * PLD + c] = p2; P[(4 * tp + 3) * PLD + c] = p3;
            ss0 += p0 * p0; ss1 += p1 * p1; ss2 += p2 * p2; ss3 += p3 * p3;
        }
        ss0 += __shfl_xor(ss0, 16); ss1 += __shfl_xor(ss1, 16); ss2 += __shfl_xor(ss2, 16); ss3 += __shfl_xor(ss3, 16);
        ss0 += __shfl_xor(ss0, 32); ss1 += __shfl_xor(ss1, 32); ss2 += __shfl_xor(ss2, 32); ss3 += __shfl_xor(ss3, 32);
        if (lane < 16) { part[wave * 64 + 4 * lane] = ss0; part[wave * 64 + 4 * lane + 1] = ss1; part[wave * 64 + 4 * lane + 2] = ss2; part[wave * 64 + 4 * lane + 3] = ss3; }
        __syncthreads();
#pragma unroll 1
        for (int r = 0; r < 8; ++r) {
            const int tl = wave * 8 + r;
            float s = 0.f;
#pragma unroll
            for (int w = 0; w < 8; ++w) s += part[w * 64 + tl];
            const float rs = rsqrtf(s * (1.0f / 512.0f) + EPS);
            bf16_t* orow = hyn + (size_t)(tile0 + tl) * 512;
#pragma unroll
            for (int j = 0; j < 4; ++j) { const int c = 2 * lane + 128 * j;
                const float v0 = P[tl * PLD + c] * rs * hg[2 * j], v1 = P[tl * PLD + c + 1] * rs * hg[2 * j + 1];
                *(unsigned*)(orow + c) = pk2(v0, v1); }
        }
        __syncthreads();
    }
}
#define XB_TMO      128
#define XB_XCNT(j)  (256  + 64 * (j))
#define XB_XSUB(j)  (1280 + 64 * (j))
#define XB_XGEN(j)  (2304 + 64 * (j))
#define XB_TOP      3328
#define XB_TOPGEN   3392
#define XCD_BAR_WORDS 3456
#define XB_SPIN_CAP (1u << 22)
constexpr size_t WS_BAR = 106 * MiB + 524288;
__device__ __forceinline__ unsigned xb_ld(unsigned* p)              { return __hip_atomic_load(p, __ATOMIC_RELAXED, __HIP_MEMORY_SCOPE_AGENT); }
__device__ __forceinline__ unsigned xb_add(unsigned* p, unsigned v) { return __hip_atomic_fetch_add(p, v, __ATOMIC_RELAXED, __HIP_MEMORY_SCOPE_AGENT); }
__device__ __forceinline__ unsigned xb_xcc_id() { return (unsigned)__builtin_amdgcn_s_getreg((3 << 11) | 20) & 0xFu; }
#define XB_SPIN(cond, bar) do { unsigned _sp = 0; while (cond) { __builtin_amdgcn_s_sleep(1); \
    if ((++_sp & 255u) == 0u) { if (xb_ld(&(bar)[XB_TMO])) break; if (_sp > XB_SPIN_CAP) { atomicAdd(&(bar)[XB_TMO], 1u); break; } } } } while (0)
__device__ __forceinline__ void xcd_barrier_complete(unsigned* bar, unsigned x, unsigned& nloc, unsigned& nx) {
    const unsigned G = gridDim.x;
    unsigned sum, cnt, mine, sp = 0u;
    for (;;) {
        sum = 0u; cnt = 0u; mine = 0u;
#pragma unroll
        for (unsigned j = 0; j < 16; ++j) { const unsigned c = xb_ld(&bar[XB_XCNT(j)]); sum += c; cnt += (c > 0u) ? 1u : 0u; mine = (j == x) ? c : mine; }
        if (sum == G) break;
        __builtin_amdgcn_s_sleep(1);
        if ((++sp & 255u) == 0u) { if (xb_ld(&bar[XB_TMO])) break; if (sp > XB_SPIN_CAP) { atomicAdd(&bar[XB_TMO], 1u); break; } }
    }
    nloc = mine > 0u ? mine : 1u; nx = cnt > 0u ? cnt : 1u;
}
__device__ __forceinline__ void xcd_barrier(unsigned* bar, volatile LAS unsigned* st) {
    asm volatile("s_waitcnt vmcnt(0)" ::: "memory");
    __syncthreads();
    if (threadIdx.x == 0) {
        const unsigned x = xb_xcc_id();
        __builtin_amdgcn_s_waitcnt(0);
        unsigned nloc = st[0], nx = st[1];
        if (nloc == 0u) { xcd_barrier_complete(bar, x, nloc, nx); st[0] = nloc; st[1] = nx; }
        const unsigned old = xb_add(&bar[XB_XSUB(x)], 1u);
        const unsigned gen = old / nloc;
        if (old + 1u == (gen + 1u) * nloc) {
            __builtin_amdgcn_fence(__ATOMIC_RELEASE, "agent");
            asm volatile("s_waitcnt vmcnt(0)" ::: "memory");
            const unsigned og = xb_add(&bar[XB_TOP], 1u);
            const unsigned tg = og / nx;
            if (og + 1u == (tg + 1u) * nx) xb_add(&bar[XB_TOPGEN], 1u);
            else XB_SPIN(xb_ld(&bar[XB_TOPGEN]) == tg, bar);
            __builtin_amdgcn_fence(__ATOMIC_ACQUIRE, "agent");
            xb_add(&bar[XB_XGEN(x)], 1u);
            asm volatile("s_waitcnt vmcnt(0)" ::: "memory");
        } else {
            XB_SPIN(xb_ld(&bar[XB_XGEN(x)]) == gen, bar);
            __builtin_amdgcn_fence(__ATOMIC_ACQUIRE, "agent");
            asm volatile("s_waitcnt vmcnt(0)" ::: "memory");
        }
    }
    __syncthreads();
}
__device__ __forceinline__ void epi_cfg(int st, int gi, int l, unsigned char* ws, float* out, ArgsP a, Epi& E) {
    float* ssq = (float*)(ws + WS_SSQ); bf16_t* xb = (bf16_t*)(ws + WS_XB);
    bf16_t* r1a = (bf16_t*)(ws + WS_R1A); bf16_t* r1b = (bf16_t*)(ws + WS_R1B); bf16_t* r2 = (bf16_t*)(ws + WS_R2); bf16_t* r3 = (bf16_t*)(ws + WS_R3);
    bf16_t* kmat = (bf16_t*)(ws + WS_R4); bf16_t* vtm = (bf16_t*)(ws + WS_R4 + 6 * MiB);
    float* ssq_in = ssq + (size_t)(3 * l) * T_ALL; float* ssq_a = ssq_in + T_ALL; float* ssq_m = ssq_a + T_ALL; float* ssq_n = ssq_m + T_ALL;
    const int half = (st >= 16) ? ((st - 16) >> 1) : 0;
    E.kind = 0; E.O0 = r1a; E.d1 = 0; E.d2 = 0; E.ldc = 1024; E.csplit = 0; E.rsplit = 0; E.ssq = ssq_in; E.psum = (float*)(ws + WS_PSUM); E.row_off = 0; E.SCALE = 0; E.ACT = 0;
    E.X = out; E.rin0 = out; E.rin1 = out + (size_t)TP * DM; E.xb = xb; E.ssq_out = ssq_a; E.rin_bf16 = 0; E.write_x = 1; E.write_xb = 1;
    if (st == 1)       { E.O0 = r1b; E.d1 = r2 - r1b; E.d2 = r3 - r2; E.ldc = 512; E.csplit = 2; E.SCALE = 1; }
    else if (st == 8)  { E.O0 = r2; E.d1 = r1a - r2; E.d2 = r3 - r1a; E.ldc = T_ALL; E.rsplit = 2; E.SCALE = 2; }
    else if (st == 11) { E.kind = 1; E.write_x = 0; E.rin_bf16 = 1; }
    else if (st == 12) {
        if (gi == 0)      { E.SCALE = 1; E.ssq = ssq_a; }
        else              { E.O0 = kmat; }
    }
    else if (st == 13) { E.O0 = r2; E.ACT = 2; }
    else if (st == 14) { E.SCALE = 3; }
    else if (st == 15) { E.kind = 1; E.ssq_out = ssq_m; E.rin_bf16 = 1; E.write_x = 0; }
    else if (st == 16 || st == 18) { E.ldc = 4096; E.SCALE = 1; E.ACT = 1; E.ssq = ssq_m; E.row_off = half * TP; }
    else               { E.kind = 1; E.ssq_out = ssq_n; E.row_off = half * TP; E.rin_bf16 = 1; E.write_x = 0; E.write_xb = 1; }
}
template <int KIND> struct EpiT {
    static constexpr bool PERM = true;
    int st, gi, l; unsigned char* ws; float* out; ArgsP a;
    __device__ __forceinline__ void operator()(const f32x4 (&acc)[2][2][4][2], const pg8::Unit& u, int wr, int wc, int fr, int fq) const {
        int st_ = st; asm volatile("" : "+s"(st_));
        Epi E; epi_cfg(st_, gi, l, ws, out, a, E);
        pg8::Unit uu = u;
        if (st_ == 12 && gi == 1 && u.pm >= 64) { uu.pm = u.pm - 64; E.O0 = (bf16_t*)(ws + WS_R4 + 6 * MiB); E.ldc = 3072; }
        if (KIND == 0) E.bf_path(acc, uu, wr, wc, fr, fq); else E.res_path(acc, uu, wr, wc, fr, fq);
    }
};
#ifdef DBG_SCAN
constexpr size_t WS_FLAG = 106 * MiB + 262144;
__device__ __forceinline__ void dbg_scan(unsigned char* ws, float* out, int ph) {
    int bad = 0;
    const size_t gt = (size_t)blockIdx.x * 512 + otid(), gs = (size_t)gridDim.x * 512;
    { const u32x4* p = (const u32x4*)(ws + 32 * MiB); const size_t n = (70 * MiB) / 16;
      for (size_t i = gt; i < n; i += gs) { const u32x4 w = p[i];
#pragma unroll
          for (int e = 0; e < 4; ++e) { const unsigned x = w[e]; if ((x & 0x7f80u) == 0x7f80u || (x & 0x7f800000u) == 0x7f800000u) bad = 1; } } }
    { const u32x4* p = (const u32x4*)(ws + 111 * MiB); const size_t n = (140 * MiB) / 16;
      for (size_t i = gt; i < n; i += gs) { const u32x4 w = p[i];
#pragma unroll
          for (int e = 0; e < 4; ++e) { const unsigned x = w[e]; if ((x & 0x7f80u) == 0x7f80u || (x & 0x7f800000u) == 0x7f800000u) bad = 1; } } }
    { const u32x4* p = (const u32x4*)(ws + 102 * MiB); const size_t n = (9 * MiB) / 16;
      for (size_t i = gt; i < n; i += gs) { const u32x4 w = p[i];
#pragma unroll
          for (int e = 0; e < 4; ++e) { const unsigned x = w[e]; if ((x & 0x7f800000u) == 0x7f800000u) bad = 1; } } }
    { const u32x4* p = (const u32x4*)out; const size_t n = (128 * MiB) / 16;
      for (size_t i = gt; i < n; i += gs) { const u32x4 w = p[i];
#pragma unroll
          for (int e = 0; e < 4; ++e) { const unsigned x = w[e]; if ((x & 0x7f800000u) == 0x7f800000u) bad = 1; } } }
    if (bad) atomicMax((int*)(ws + WS_FLAG), 100 - (ph + 1));
}
#endif
__global__ __launch_bounds__(512, 2) void mega_fwd(Args a_by_value) {
    extern __shared__ __attribute__((aligned(16))) unsigned char shm[];
    LAS unsigned char* lds = (LAS unsigned char*)shm;
    cg::grid_group grid = cg::this_grid();
    volatile LAS unsigned* xst = (volatile LAS unsigned*)(lds + LDS_BYTES - 16);
    if (threadIdx.x == 0) { xst[0] = 0u; xst[1] = 0u; xst[2] = 0u; xst[3] = 0u; (void)xb_add(&((unsigned*)(a_by_value.ws + WS_BAR))[XB_XCNT(xb_xcc_id())], 1u); }
    __syncthreads();
#ifdef DBG_TIME
    unsigned long long t_sel = 0, t_all = 0;
#endif
#pragma unroll 1
    for (int ph = 0; ph <= 40; ++ph) {
#ifdef DBG_TIME
        const unsigned long long t_begin = __builtin_amdgcn_s_memrealtime();
#endif
        ArgsP a = (ArgsP)__builtin_amdgcn_kernarg_segment_ptr(); asm volatile("" : "+s"(a));
        unsigned char* ws = a->ws; float* out = a->out;
        float* ssq = (float*)(ws + WS_SSQ);
        bf16_t* xb = (bf16_t*)(ws + WS_XB);
        bf16_t* r1a = (bf16_t*)(ws + WS_R1A); bf16_t* r1b = (bf16_t*)(ws + WS_R1B); bf16_t* r2 = (bf16_t*)(ws + WS_R2); bf16_t* r3 = (bf16_t*)(ws + WS_R3);
        bf16_t* kmat = (bf16_t*)(ws + WS_R4); bf16_t* vtm = (bf16_t*)(ws + WS_R4 + 6 * MiB);
        float* psum = (float*)(ws + WS_PSUM);
#ifdef DBG_TIME
        if (ph == 40) { if (blockIdx.x == 0 && threadIdx.x == 0) { *(volatile float*)(ws + 106 * MiB + 262144) = 2.0f * sqrtf((float)t_sel / (float)t_all); __threadfence(); }
            xcd_barrier((unsigned*)(ws + WS_BAR), xst);
            const float cval = *(volatile float*)(ws + 106 * MiB + 262144);
            for (size_t i = (size_t)blockIdx.x * 512 + otid(); i < (size_t)T_ALL * DM; i += (size_t)gridDim.x * 512) out[i] = cval; break; }
#elif defined(DBG_SCAN)
        if (ph == 40) { const int fl = *(volatile int*)(ws + WS_FLAG); const float cval = fl < 0 ? 0.f : sqrtf((float)(100 - fl));
            for (size_t i = (size_t)blockIdx.x * 512 + otid(); i < (size_t)T_ALL * DM; i += (size_t)gridDim.x * 512) out[i] = cval; break; }
#else
        if (ph == 40) { phase_final(a, ssq + (size_t)6 * T_ALL, xb); break; }
#endif
        const int l = ph / 20, st = ph % 20;
        const float* rin0 = l == 0 ? a->in[I_XP] : out; const float* rin1 = l == 0 ? a->in[I_XS] : out + (size_t)TP * DM;
        float* ssq_in = ssq + (size_t)(3 * l) * T_ALL; float* ssq_a = ssq_in + T_ALL; float* ssq_m = ssq_a + T_ALL; float* ssq_n = ssq_m + T_ALL;
#ifndef PH_LIMIT
#define PH_LIMIT 100
#endif
        const bool is_gemm = (st == 1 || st == 8 || (st >= 11 && st <= 19));
        if (ph >= PH_LIMIT) {}
        else if (st == 0) {
#ifdef DUP_MISC
            if (l == 0) phase_prologue(a, lds); phase_wconv(a, l, lds); __syncthreads();
#endif
            if (l == 0) phase_prologue(a, lds); phase_wconv(a, l, lds); }
        else if (is_gemm) {
            const int ng = (st == 12) ? 2 : 1;
#pragma unroll 1
            for (int gi = 0; gi < ng; ++gi) {
                int nM = 128, nN = 4, mode = 0, lda = 1024, ldb = 1024, K = 1024, ks_shift = 30; size_t seg = 0;
                const void* A = xb; const void* B = ws + WS_WQ;
                const int half = (st >= 16) ? ((st - 16) >> 1) : 0;
                if (st == 1)       { nN = 6; B = ws + WS_WSSM; }
                else if (st == 8)  { nM = 6; nN = 128; A = ws + WS_WHY; B = xb; }
                else if (st == 11) { A = r1a; lda = 512; ks_shift = 3; seg = (size_t)(WS_R1B - WS_R1A); B = ws + WS_WOUT; }
                else if (st == 12) {
                    if (gi == 1)      { nM = 12; nN = 8; mode = 3; A = ws + WS_MEMB; B = ws + WS_WK; }
                }
                else if (st == 13) { mode = 1; K = 256; A = r1a; B = kmat; }
                else if (st == 14) { mode = 2; K = 256; A = r2; B = vtm; ldb = 3072; }
                else if (st == 15) { A = r1a; B = ws + WS_WO; }
                else if (st == 16 || st == 18) { nM = 64; nN = 16; A = xb + (size_t)half * TP * DM; B = ws + WS_WUP; }
                else               { nM = 64; A = r1a; lda = 4096; ldb = 4096; K = 4096; B = ws + WS_WDOWN; }
                pg8::Sched S; S.init(nM, nN, mode, A, lda, B, ldb);
                if (mode == 3) { S.A2 = (const char*)(ws + WS_WV); S.B2 = (const char*)(ws + WS_MEMB); }
                const pg8::Gemm g{lda, ldb, K, ks_shift, seg};
                const bool resid = (st == 11 || st == 15 || st == 17 || st == 19);
                if (!resid) { const EpiT<0> EK{st, gi, l, ws, out, a}; pg8::gemm_phase(lds, g, S, EK);
#ifdef DUP_GEMM
                    pg8::gemm_phase(lds, g, S, EK);
#endif
#ifdef DUP_ATT
                    if (st == 13 || st == 14) pg8::gemm_phase(lds, g, S, EK);
#endif
#ifdef DUP_WIN
                    if (st == 1 || st == 8) pg8::gemm_phase(lds, g, S, EK);
#endif
                } else { const EpiT<1> EK{st, gi, l, ws, out, a}; pg8::gemm_phase(lds, g, S, EK); }
            }
#ifdef DUP_MISC
            if (st == 1) phase_dt(a, l, xb, ssq_in);
#endif
            if (st == 1) phase_dt(a, l, xb, ssq_in);
            if (st == 8) { phase_ssm_norm(a, l, r1b); phase_filter(a, l, lds, (float*)kmat); }
        }
        else if (st == 2 || st == 5) {
#ifdef DUP_SSD
            phase_s1(a, l, st == 2 ? 0 : 128, lds, r2, r3, r1a); __syncthreads();
#endif
            phase_s1(a, l, st == 2 ? 0 : 128, lds, r2, r3, r1a); }
        else if (st == 3 || st == 6) {
#ifdef DUP_SSD
            { int dry = 1; asm volatile("" : "+s"(dry)); phase_s2(a, st == 3 ? 0 : 128, r1a, dry); }
#endif
            int dry = 0; asm volatile("" : "+s"(dry)); phase_s2(a, st == 3 ? 0 : 128, r1a, dry); }
        else if (st == 4 || st == 7) {
#ifdef DUP_SSD
            { int dry = 1; asm volatile("" : "+s"(dry)); phase_s3(a, l, st == 4 ? 0 : 128, lds, r2, r3, r1a, r1b, dry); __syncthreads(); }
#endif
            int dry = 0; asm volatile("" : "+s"(dry)); phase_s3(a, l, st == 4 ? 0 : 128, lds, r2, r3, r1a, r1b, dry); }
        else if (st == 9) {
#ifdef DUP_FFT
            { int dry = 1; asm volatile("" : "+s"(dry)); phase_hyena_conv(a, l, lds, r1a, r3, (const float*)kmat, dry); __syncthreads(); }
#endif
            int dry = 0; asm volatile("" : "+s"(dry)); phase_hyena_conv(a, l, lds, r1a, r3, (const float*)kmat, dry); }
        else if (st == 10) {
#ifdef DUP_MISC
            phase_hyena_norm(a, l, lds, r2, r3, r1a); __syncthreads();
#endif
            phase_hyena_norm(a, l, lds, r2, r3, r1a); }
        if (ph == 0) grid.sync(); else xcd_barrier((unsigned*)(ws + WS_BAR), xst);
#ifdef DBG_TIME
        { const unsigned long long dt_ = __builtin_amdgcn_s_memrealtime() - t_begin; t_all += dt_;
          const int grp = st == 0 ? 0 : (st == 2 || st == 5) ? 1 : (st == 3 || st == 6) ? 2 : (st == 4 || st == 7) ? 3 : st == 9 ? 4 : st == 10 ? 5 : (st == 1 || st == 8) ? 6 : (st == 16 || st == 18) ? 8 : (st == 17 || st == 19) ? 9 : 7;
          if (grp == DBG_TIME) t_sel += dt_; }
#endif
#ifdef DBG_SCAN
#if !defined(S3_PROBE) && !defined(S3_PROBE2)
        dbg_scan(ws, out, ph); grid.sync();
#endif
#endif
    }
}

#include <cstdio>
extern "C" void kernel_launch(void* const* d_in, const int* in_sizes, int n_in, void* d_out, int out_size, void* d_ws, size_t ws_size, hipStream_t stream) {
    static int grid = 0;
    if (grid == 0) {
        int dev = 0, cus = 0, per_cu = 0;
        if (n_in != 33 || ws_size < WS_END || out_size != T_ALL * DM) { fprintf(stderr, "kernel_launch: unexpected shapes (n_in %d, ws %zu, out %d)\n", n_in, ws_size, out_size); grid = -1; return; }
        (void)hipGetDevice(&dev); (void)hipDeviceGetAttribute(&cus, hipDeviceAttributeMultiprocessorCount, dev);
        if (hipFuncSetAttribute((const void*)mega_fwd, hipFuncAttributeMaxDynamicSharedMemorySize, LDS_BYTES) != hipSuccess) { fprintf(stderr, "kernel_launch: hipFuncSetAttribute failed\n"); grid = -1; return; }
        if (hipOccupancyMaxActiveBlocksPerMultiprocessor(&per_cu, (const void*)mega_fwd, 512, LDS_BYTES) != hipSuccess || per_cu < 1) { fprintf(stderr, "kernel_launch: occupancy query gives %d\n", per_cu); (void)hipGetLastError(); grid = -1; return; }
        grid = cus;
    }
    if (grid < 0) return;
#ifdef DBG_SCAN
    (void)hipMemsetAsync(d_ws, 0xAA, WS_END, stream); (void)hipMemsetAsync(d_out, 0xAA, (size_t)T_ALL * DM * 4, stream);
#endif
    (void)hipMemsetAsync((unsigned char*)d_ws + WS_BAR, 0, XCD_BAR_WORDS * 4, stream);
    Args a{};
    for (int i = 0; i < 33; ++i) a.in[i] = (const float*)d_in[i];
    a.out = (float*)d_out; a.ws = (unsigned char*)d_ws;
    void* args[] = {&a};
    hipError_t e = hipLaunchCooperativeKernel((const void*)mega_fwd, dim3(grid), dim3(512), args, LDS_BYTES, stream);
    if (e != hipSuccess) fprintf(stderr, "cooperative launch failed: %s (grid %d)\n", hipGetErrorString(e), grid);
}
```

```cpp
#include <hip/hip_runtime.h>
#include <hip/hip_cooperative_groups.h>
namespace cg = cooperative_groups;

#define LAS __attribute__((address_space(3)))
typedef unsigned short bf16_t;
typedef short bf16x8 __attribute__((ext_vector_type(8)));
typedef float f32x4 __attribute__((ext_vector_type(4)));
typedef float f32x2 __attribute__((ext_vector_type(2)));
typedef unsigned u32x4 __attribute__((ext_vector_type(4)));
typedef unsigned u32x2 __attribute__((ext_vector_type(2)));

constexpr int T_ALL = 32768, TP = 16384, DM = 1024;
constexpr float EPS = 1e-5f;
constexpr size_t MiB = 1048576;
constexpr size_t WS_WHY = 0 * MiB, WS_WSSM = 3 * MiB, WS_WOUT = 6 * MiB, WS_WQ = 8 * MiB, WS_WK = 10 * MiB, WS_WV = 12 * MiB, WS_WO = 14 * MiB, WS_WUP = 16 * MiB, WS_WDOWN = 24 * MiB;
constexpr size_t WS_XB = 32 * MiB, WS_MEMB = 96 * MiB, WS_SSQ = 102 * MiB, WS_H2 = 103 * MiB, WS_TW = 106 * MiB, WS_WDT = 106 * MiB + 65536, WS_DECAY = 106 * MiB + 131072;
constexpr size_t WS_DT = 107 * MiB, WS_PSUM = 109 * MiB, WS_R1A = 111 * MiB, WS_R1B = 143 * MiB, WS_R2 = 175 * MiB, WS_R3 = 207 * MiB, WS_R4 = 239 * MiB, WS_END = 263 * MiB;
constexpr int LDS_BYTES = 153600;

typedef __bf16 bf16x2v __attribute__((ext_vector_type(2)));
__device__ __forceinline__ unsigned pk2(float lo, float hi) { const f32x2 v = {lo, hi}; const bf16x2v b = __builtin_convertvector(v, bf16x2v); return __builtin_bit_cast(unsigned, b); }
__device__ __forceinline__ float bflo(unsigned u) { return __uint_as_float(u << 16); }
__device__ __forceinline__ float bfhi(unsigned u) { return __uint_as_float(u & 0xffff0000u); }
__device__ __forceinline__ float bf2f(bf16_t b) { return __uint_as_float(((unsigned)b) << 16); }
__device__ __forceinline__ float wave_sum(float v) {
#pragma unroll
    for (int o = 32; o >= 1; o >>= 1) v += __shfl_xor(v, o);
    return v;
}
__device__ __forceinline__ int otid() { int t = (int)threadIdx.x; asm volatile("" : "+v"(t)); return t; }
constexpr float SSQ_SCALE = 4096.0f;
__device__ __forceinline__ float ssq_ld(const float* p) { return (float)__float_as_uint(*p) * (1.0f / SSQ_SCALE); }
__device__ __forceinline__ unsigned ssq_fx(float s) { return (unsigned)(s * SSQ_SCALE + 0.5f); }
#define LDS_WAIT() asm volatile("s_waitcnt lgkmcnt(0)" ::: "memory")

namespace pg8 {
constexpr int BM = 256, BK = 64, HALF = 128, HTB = HALF * BK * 2, STAGE_BYTES = 8 * HTB, NXCD = 8, WGM = 8;
__host__ __device__ __forceinline__ int lds_byte(int r, int c) { const int st = (r >> 4) * 2 + (c >> 5), rr = r & 15, cc = c & 31, ob = rr * 64 + cc * 2; return st * 1024 + (ob ^ (((ob >> 9) & 1) << 5)); }
__host__ __device__ __forceinline__ void stage_rc(int b, int& R, int& C) { const int st = b / 1024, sb = b % 1024, swz = sb ^ (((sb >> 9) & 1) << 5); R = (st >> 1) * 16 + swz / 64; C = (st & 1) * 32 + (swz % 64) / 2; }
__host__ __device__ __forceinline__ int perm32(int rho) { const int n = rho >> 4, i = rho & 15; return 8 * (i >> 2) + 4 * n + (i & 3); }
struct Unit { int pm, pn; };
struct Gemm { int lda, ldb, K, ks_shift; size_t seg_bytes; };
__device__ __forceinline__ int seq_of_pm(int pm) { return pm < 64 ? (pm >> 3) : 8 + ((pm - 64) >> 4); }
struct Sched {
    int nM, nN, nwg, G, c, mode;
    const char* A; const char* B; const char* A2; const char* B2; int lda, ldb;
    __device__ void init(int nM_, int nN_, int mode_, const void* A_, int lda_, const void* B_, int ldb_) { nM = nM_; nN = nN_; nwg = nM * nN; G = (int)gridDim.x; c = (int)blockIdx.x; mode = mode_; A = (const char*)A_; B = (const char*)B_; A2 = A; B2 = B; lda = lda_; ldb = ldb_; }
    __device__ bool next(int i, Unit& u) const {
        const long L = (long)i * G + c; if (L >= nwg) return false;
        if (mode == 3) { if (L < 48) { u.pm = (int)(L % 12); u.pn = (int)(L / 12); } else { const int r = (int)L - 48; u.pm = 64 + (r & 3); u.pn = r >> 2; } return true; }
        int wgid = (int)L; { const int q = nwg / NXCD, r = nwg % NXCD, xcd = wgid % NXCD, off = wgid / NXCD; wgid = (xcd < r ? xcd * (q + 1) : r * (q + 1) + (xcd - r) * q) + off; }
        const int nig = WGM * nN, gid = wgid / nig, fm = gid * WGM, gsz = (nM - fm) < WGM ? (nM - fm) : WGM;
        u.pm = fm + ((wgid % nig) % gsz); u.pn = (wgid % nig) / gsz; return true;
    }
    __device__ __forceinline__ const char* abase(const Unit& u) const {
        if (mode == 0) return A + (size_t)u.pm * 256 * lda * 2;
        if (mode == 3) return (u.pm < 64 ? A : A2) + (size_t)(u.pm & 63) * 256 * lda * 2;
        return A + ((size_t)u.pm * 256 * lda + (size_t)u.pn * 256) * 2;
    }
    __device__ __forceinline__ const char* bbase(const Unit& u) const {
        if (mode == 0) return B + (size_t)u.pn * 256 * ldb * 2;
        if (mode == 3) return (u.pm < 64 ? B : B2) + (size_t)u.pn * 256 * ldb * 2;
        if (mode == 1) return B + ((size_t)seq_of_pm(u.pm) * 256 * ldb + (size_t)u.pn * 256) * 2;
        return B + ((size_t)u.pn * 256 * ldb + (size_t)seq_of_pm(u.pm) * 256) * 2;
    }
};

template <class Epi>
__device__ __forceinline__ void gemm_phase(LAS unsigned char* lds, const Gemm g, const Sched& S, const Epi& E) {
    const int tid = otid(), wid = __builtin_amdgcn_readfirstlane(tid >> 6), lane = tid & 63, wr = wid >> 2, wc = wid & 3, fr = lane & 15, fq = lane >> 4;
    const int nt = g.K / BK;
    unsigned voffA[2], voffB[2];
#pragma unroll
    for (int i = 0; i < 2; ++i) { int R, C; stage_rc(tid * 16 + i * 8192, R, C); const int Rb = Epi::PERM ? ((R & ~31) + perm32(R & 31)) : R;
        voffA[i] = (unsigned)(R * g.lda + C) * 2u; voffB[i] = (unsigned)(Rb * g.ldb + C) * 2u; }
    const size_t kstep = (size_t)(BK * 2);
    const size_t hstepA = (size_t)HALF * g.lda * 2, hstepB = (size_t)HALF * g.ldb * 2;
    const int ksm = (1 << g.ks_shift) - 1;
#define PG8_AKT(p, t) ((p) + (size_t)((t) >> g.ks_shift) * g.seg_bytes + (size_t)((t) & ksm) * kstep)
    const unsigned ldsw = (unsigned)wid * 1024u;
    const int aoff = lds_byte(wr * 64 + fr, fq * 8), boff = lds_byte(wc * 32 + fr, fq * 8);
#define PG8_SA(b, h) (((b) * 2 + (h)) * HTB)
#define PG8_SB(b, h) ((4 + (b) * 2 + (h)) * HTB)
#define PG8_STAGE(bufoff, gbase, voff) do { _Pragma("unroll") for (int _i = 0; _i < 2; ++_i) \
        __builtin_amdgcn_global_load_lds((const unsigned*)((const char*)(gbase) + (voff)[_i]), (LAS unsigned*)(lds + (bufoff) + ldsw + _i * 8192), 16, 0, 0); } while (0)
#define PG8_LDA(dst, b, h) do { _Pragma("unroll") for (int m = 0; m < 4; ++m) _Pragma("unroll") for (int k = 0; k < 2; ++k) dst[m][k] = *(const LAS bf16x8*)(lds + PG8_SA(b, h) + aoff + m * 2048 + k * 1024); } while (0)
#define PG8_LDB(dst, b, h) do { _Pragma("unroll") for (int n = 0; n < 2; ++n) _Pragma("unroll") for (int k = 0; k < 2; ++k) dst[n][k] = *(const LAS bf16x8*)(lds + PG8_SB(b, h) + boff + n * 2048 + k * 1024); } while (0)
#define PG8_MMA(ai, bj, At, Bt) do { __builtin_amdgcn_s_setprio(1); _Pragma("unroll") for (int m = 0; m < 4; ++m) _Pragma("unroll") for (int n = 0; n < 2; ++n) _Pragma("unroll") for (int k = 0; k < 2; ++k) \
        acc[ai][bj][m][n] = __builtin_amdgcn_mfma_f32_16x16x32_bf16(Bt[n][k], At[m][k], acc[ai][bj][m][n], 0, 0, 0); __builtin_amdgcn_s_setprio(0); } while (0)
#define PG8_WAIT_V(n) asm volatile("s_waitcnt vmcnt(" #n ")" ::: "memory")
#define PG8_WAIT_L(n) asm volatile("s_waitcnt lgkmcnt(" #n ")" ::: "memory")
#define PG8_BAR __builtin_amdgcn_s_barrier()
#define PG8_SCHED __builtin_amdgcn_sched_barrier(0)
    Unit cur, nxt; int ui = 0;
    if (!S.next(0, cur)) return;
    f32x4 acc[2][2][4][2];
#pragma unroll
    for (int a = 0; a < 2; ++a)
#pragma unroll
        for (int b = 0; b < 2; ++b)
#pragma unroll
            for (int m = 0; m < 4; ++m)
#pragma unroll
                for (int n = 0; n < 2; ++n) acc[a][b][m][n] = (f32x4){0.f, 0.f, 0.f, 0.f};
    bf16x8 At[4][2], B0[2][2], B1[2][2];
    const char* cA = S.abase(cur); const char* cB = S.bbase(cur);
    PG8_STAGE(PG8_SB(0, 0), cB, voffB); PG8_STAGE(PG8_SA(0, 0), cA, voffA); PG8_STAGE(PG8_SB(0, 1), cB + hstepB, voffB); PG8_STAGE(PG8_SA(0, 1), cA + hstepA, voffA);
    if (wr == 1) PG8_BAR;
    PG8_WAIT_V(4); PG8_BAR;
    PG8_STAGE(PG8_SB(1, 0), cB + kstep, voffB); PG8_STAGE(PG8_SA(1, 0), PG8_AKT(cA, 1), voffA); PG8_STAGE(PG8_SB(1, 1), cB + hstepB + kstep, voffB);
    PG8_WAIT_V(6); PG8_BAR;
    for (;;) {
        const bool has_next = S.next(ui + 1, nxt);
        const char* nA = has_next ? S.abase(nxt) : cA; const char* nB = has_next ? S.bbase(nxt) : cB;
        for (int t = 0; t < nt; t += 2) {
            const bool last = (t == nt - 2);
            const char* a1 = PG8_AKT(cA, t + 1);
            const char* a2 = last ? nA : PG8_AKT(cA, t + 2); const char* b2 = last ? nB : cB + (size_t)(t + 2) * kstep;
            const char* a3 = last ? PG8_AKT(nA, 1) : PG8_AKT(cA, t + 3); const char* b3 = b2 + kstep;
            PG8_LDB(B0, 0, 0); PG8_SCHED; PG8_LDA(At, 0, 0); PG8_STAGE(PG8_SA(1, 1), a1 + hstepA, voffA);
            PG8_WAIT_L(8); PG8_BAR; PG8_WAIT_L(0); PG8_MMA(0, 0, At, B0); PG8_BAR; PG8_SCHED;
            PG8_LDB(B1, 0, 1); PG8_STAGE(PG8_SB(0, 0), b2, voffB);
            PG8_BAR; PG8_WAIT_L(0); PG8_MMA(0, 1, At, B1); PG8_BAR;
            PG8_LDA(At, 0, 1); PG8_STAGE(PG8_SA(0, 0), a2, voffA);
            PG8_BAR; PG8_WAIT_L(0); PG8_MMA(1, 0, At, B0); PG8_BAR; PG8_SCHED;
            PG8_STAGE(PG8_SB(0, 1), b2 + hstepB, voffB);
            PG8_WAIT_V(6); PG8_BAR; PG8_MMA(1, 1, At, B1); PG8_BAR;
            PG8_LDB(B0, 1, 0); PG8_SCHED; PG8_LDA(At, 1, 0); PG8_STAGE(PG8_SA(0, 1), a2 + hstepA, voffA);
            PG8_WAIT_L(8); PG8_BAR; PG8_WAIT_L(0); PG8_MMA(0, 0, At, B0); PG8_BAR; PG8_SCHED;
            PG8_LDB(B1, 1, 1); PG8_STAGE(PG8_SB(1, 0), b3, voffB);
            PG8_BAR; PG8_WAIT_L(0); PG8_MMA(0, 1, At, B1); PG8_BAR;
            PG8_LDA(At, 1, 1); PG8_STAGE(PG8_SA(1, 0), a3, voffA);
            PG8_BAR; PG8_WAIT_L(0); PG8_MMA(1, 0, At, B0); PG8_BAR; PG8_SCHED;
            PG8_STAGE(PG8_SB(1, 1), b3 + hstepB, voffB);
            PG8_WAIT_V(6); PG8_BAR; PG8_MMA(1, 1, At, B1); PG8_BAR;
        }
        E(acc, cur, wr, wc, fr, fq);
        if (!has_next) break;
#pragma unroll
        for (int a = 0; a < 2; ++a)
#pragma unroll
            for (int b = 0; b < 2; ++b)
#pragma unroll
                for (int m = 0; m < 4; ++m)
#pragma unroll
                    for (int n = 0; n < 2; ++n) acc[a][b][m][n] = (f32x4){0.f, 0.f, 0.f, 0.f};
        cur = nxt; cA = nA; cB = nB; ++ui;
    }
    PG8_WAIT_V(0);
    if (wr == 0) PG8_BAR;
    PG8_BAR;
#undef PG8_AKT
#undef PG8_SA
#undef PG8_SB
#undef PG8_STAGE
#undef PG8_LDA
#undef PG8_LDB
#undef PG8_MMA
#undef PG8_WAIT_V
#undef PG8_WAIT_L
#undef PG8_BAR
#undef PG8_SCHED
}
}
struct Epi {
    int kind;
    static constexpr bool PERM = true;
    bf16_t* O0; long long d1, d2; int ldc; int csplit, rsplit;
    const float* ssq; float* psum; int row_off; int SCALE, ACT;
    __device__ __forceinline__ void bf_path(const f32x4 (&acc)[2][2][4][2], const pg8::Unit& u, int wr, int wc, int fr, int fq) const {
        int pm = u.pm, pn = u.pn, ai_ = 0;
        if (csplit) { ai_ = pn / csplit; pn = pn % csplit; }
        if (rsplit) { ai_ = pm / rsplit; pm = pm % rsplit; }
        bf16_t* base = O0 + (ai_ >= 1 ? d1 : 0ll) + (ai_ >= 2 ? d2 : 0ll);
        const int lrow0 = pm * 256 + wr * 64 + fr, grow0 = u.pm * 256 + wr * 64 + fr, lcol0 = pn * 256 + wc * 32 + 8 * fq, gcol0 = u.pn * 256 + wc * 32 + 8 * fq;
        f32x4 cs[2][2];
        if (SCALE == 2) {
#pragma unroll
            for (int bj = 0; bj < 2; ++bj)
#pragma unroll
                for (int n = 0; n < 2; ++n) { const u32x4 qu = *(const u32x4*)(ssq + gcol0 + bj * 128 + 4 * n); f32x4 q;
#pragma unroll
                    for (int j = 0; j < 4; ++j) q[j] = rsqrtf((float)qu[j] * (1.0f / SSQ_SCALE) * (1.0f / 1024.0f) + EPS);
                    cs[bj][n] = q; }
        }
        float rsv[2][4];
#pragma unroll
        for (int ai = 0; ai < 2; ++ai)
#pragma unroll
            for (int m = 0; m < 4; ++m) { const int grow = grow0 + ai * 128 + m * 16; float rs = 1.0f;
                if (SCALE == 1) rs = rsqrtf(ssq_ld(ssq + grow + row_off) * (1.0f / 1024.0f) + EPS);
                if (SCALE == 3) { const f32x4 q = *(const f32x4*)(psum + ((size_t)grow * 4 + u.pn) * 4); rs = __builtin_amdgcn_rcpf((q[0] + q[1]) + (q[2] + q[3])); }
                rsv[ai][m] = rs; }
#pragma unroll
        for (int ai = 0; ai < 2; ++ai)
#pragma unroll
            for (int m = 0; m < 4; ++m) {
                const int grow = grow0 + ai * 128 + m * 16;
                const float rs = rsv[ai][m];
                bf16_t* rowp = base + (size_t)(lrow0 + ai * 128 + m * 16) * ldc + lcol0;
                float psacc = 0.f;
#pragma unroll
                for (int bj = 0; bj < 2; ++bj) {
                    f32x4 v0 = acc[ai][bj][m][0], v1 = acc[ai][bj][m][1];
                    if (SCALE == 1 || SCALE == 3) { v0 = v0 * rs; v1 = v1 * rs; }
                    if (SCALE == 2) { v0 = v0 * cs[bj][0]; v1 = v1 * cs[bj][1]; }
                    if (ACT == 1) {
#pragma unroll
                        for (int j = 0; j < 4; ++j) { const float a0 = fmaxf(v0[j], 0.f), a1 = fmaxf(v1[j], 0.f); v0[j] = a0 * a0; v1[j] = a1 * a1; } }
                    if (ACT == 2) {
#pragma unroll
                        for (int j = 0; j < 4; ++j) { v0[j] = __expf(v0[j]); v1[j] = __expf(v1[j]); }
                        psacc += ((v0[0] + v0[1]) + (v0[2] + v0[3])) + ((v1[0] + v1[1]) + (v1[2] + v1[3])); }
                    u32x4 w; w.x = pk2(v0[0], v0[1]); w.y = pk2(v0[2], v0[3]); w.z = pk2(v1[0], v1[1]); w.w = pk2(v1[2], v1[3]);
                    *(u32x4*)(rowp + bj * 128) = w;
                }
                if (ACT == 2) { psacc += __shfl_xor(psacc, 16); psacc += __shfl_xor(psacc, 32); if (fq == 0) psum[((size_t)grow * 4 + u.pn) * 4 + wc] = psacc; }
            }
    }
    float* X; const float* rin0; const float* rin1; bf16_t* xb; float* ssq_out; int rin_bf16, write_x, write_xb;
    __device__ __forceinline__ void operator()(const f32x4 (&acc)[2][2][4][2], const pg8::Unit& u, int wr, int wc, int fr, int fq) const {
        if (kind == 0) bf_path(acc, u, wr, wc, fr, fq); else res_path(acc, u, wr, wc, fr, fq);
    }
    __device__ __forceinline__ void res_path(const f32x4 (&acc)[2][2][4][2], const pg8::Unit& u, int wr, int wc, int fr, int fq) const {
        const int row0 = u.pm * 256 + wr * 64 + fr + row_off, col0 = u.pn * 256 + wc * 32 + 8 * fq;
#pragma unroll
        for (int ai = 0; ai < 2; ++ai) {
            f32x4 rr[4][2][2];
#pragma unroll
            for (int m = 0; m < 4; ++m) { const int row = row0 + ai * 128 + m * 16;
                if (rin_bf16) {
                    const bf16_t* bq = xb + (size_t)row * DM + col0;
#pragma unroll
                    for (int bj = 0; bj < 2; ++bj) { const u32x4 q = *(const u32x4*)(bq + bj * 128);
                        rr[m][bj][0] = (f32x4){bflo(q.x), bfhi(q.x), bflo(q.y), bfhi(q.y)}; rr[m][bj][1] = (f32x4){bflo(q.z), bfhi(q.z), bflo(q.w), bfhi(q.w)}; }
                } else {
                    const float* rp = (row < TP ? rin0 + (size_t)row * DM : rin1 + (size_t)(row - TP) * DM) + col0;
#pragma unroll
                    for (int bj = 0; bj < 2; ++bj) { rr[m][bj][0] = *(const f32x4*)(rp + bj * 128); rr[m][bj][1] = *(const f32x4*)(rp + bj * 128 + 4); } } }
#pragma unroll
            for (int m = 0; m < 4; ++m) {
                const int row = row0 + ai * 128 + m * 16;
                float* xp = X + (size_t)row * DM + col0; bf16_t* bp = xb + (size_t)row * DM + col0;
                float sq = 0.f;
#pragma unroll
                for (int bj = 0; bj < 2; ++bj) {
                    const f32x4 v0 = acc[ai][bj][m][0] + rr[m][bj][0], v1 = acc[ai][bj][m][1] + rr[m][bj][1];
                    if (write_x) { *(f32x4*)(xp + bj * 128) = v0; *(f32x4*)(xp + bj * 128 + 4) = v1; }
                    u32x4 w; w.x = pk2(v0[0], v0[1]); w.y = pk2(v0[2], v0[3]); w.z = pk2(v1[0], v1[1]); w.w = pk2(v1[2], v1[3]);
                    if (write_xb) *(u32x4*)(bp + bj * 128) = w;
                    sq += ((v0[0] * v0[0] + v0[1] * v0[1]) + (v0[2] * v0[2] + v0[3] * v0[3])) + ((v1[0] * v1[0] + v1[1] * v1[1]) + (v1[2] * v1[2] + v1[3] * v1[3]));
                }
                sq += __shfl_xor(sq, 16); sq += __shfl_xor(sq, 32);
                if (fq == 0) atomicAdd((unsigned*)(ssq_out + row), ssq_fx(sq));
            }
        }
    }
};

struct Args { const float* in[33]; float* out; unsigned char* ws; };
typedef const __attribute__((address_space(4))) Args* ArgsP;
enum { I_XP = 0, I_XS, I_MP, I_MS, I_NMIX, I_WIN, I_HCW, I_HCB, I_FW1, I_FB1, I_FW2, I_FB2, I_FW3, I_FB3, I_FREQ, I_HBIAS, I_HNORM, I_SCW, I_SCB, I_DTB, I_ALOG, I_SD, I_SNORM,
       I_WOUT, I_NXA, I_NMEM, I_WQ, I_WKV, I_WO, I_NMLP, I_WUP, I_WDOWN, I_NFIN };

__device__ __forceinline__ void transpose_item(const float* W, int K, int N, bf16_t* WT, int n0, int k0, int dst_row0, const float* ksc, float gs, LAS float* scr, int lane) {
#pragma unroll 32
    for (int kk = 0; kk < 64; ++kk) { float v = W[(size_t)(k0 + kk) * N + n0 + lane] * gs; if (ksc) v *= ksc[k0 + kk]; scr[kk * 65 + lane] = v; }
    LDS_WAIT();
    const int c = lane & 7;
#pragma unroll
    for (int j = 0; j < 8; ++j) { const int n = (lane >> 3) + 8 * j; const LAS float* sp = scr + (8 * c) * 65 + n;
        u32x4 o; o.x = pk2(sp[0 * 65], sp[1 * 65]); o.y = pk2(sp[2 * 65], sp[3 * 65]); o.z = pk2(sp[4 * 65], sp[5 * 65]); o.w = pk2(sp[6 * 65], sp[7 * 65]);
        *(u32x4*)(WT + (size_t)(dst_row0 + n) * K + k0 + 8 * c) = o; }
    LDS_WAIT();
}
__device__ __forceinline__ void phase_wconv(ArgsP a, int l, LAS unsigned char* lds) {
    const int lane = otid() & 63, wave = otid() >> 6, gw = blockIdx.x * 8 + wave, NGW = gridDim.x * 8;
    LAS float* scr = (LAS float*)(lds + wave * 16896);
    unsigned char* ws = a->ws;
    constexpr int I_IN = 16 * 48, I_OUT = 16 * 16, I_Q = 16 * 16, I_KV = 16 * 32, I_O = 16 * 16, I_UP = 16 * 64, I_DN = 64 * 16;
    constexpr int NIT = I_IN + I_OUT + I_Q + I_KV + I_O + I_UP + I_DN;
    for (int it = gw; it < NIT; it += NGW) {
        int r = it;
        if (r < I_IN) { const int kb = r / 48, nb = r % 48, n0 = nb * 64;
            if (n0 < 1536) transpose_item(a->in[I_WIN] + (size_t)l * 1024 * 3088, 1024, 3088, (bf16_t*)(ws + WS_WHY), n0, kb * 64, n0, a->in[I_NMIX] + l * 1024, 1.f, scr, lane);
            else transpose_item(a->in[I_WIN] + (size_t)l * 1024 * 3088, 1024, 3088, (bf16_t*)(ws + WS_WSSM), n0, kb * 64, n0 - 1536, a->in[I_NMIX] + l * 1024, 1.f, scr, lane);
            continue; } r -= I_IN;
        if (r < I_OUT) { const int kb = r / 16, nb = r % 16; transpose_item(a->in[I_WOUT] + (size_t)l * 1024 * 1024, 1024, 1024, (bf16_t*)(ws + WS_WOUT), nb * 64, kb * 64, nb * 64, nullptr, 1.f, scr, lane); continue; } r -= I_OUT;
        if (r < I_Q) { const int kb = r / 16, nb = r % 16; transpose_item(a->in[I_WQ] + (size_t)l * 1024 * 1024, 1024, 1024, (bf16_t*)(ws + WS_WQ), nb * 64, kb * 64, nb * 64, a->in[I_NXA] + l * 1024, 0.0625f, scr, lane); continue; } r -= I_Q;
        if (r < I_KV) { const int kb = r / 32, nb = r % 32, n0 = nb * 64;
            if (n0 < 1024) transpose_item(a->in[I_WKV] + (size_t)l * 1024 * 2048, 1024, 2048, (bf16_t*)(ws + WS_WK), n0, kb * 64, n0, a->in[I_NMEM] + l * 1024, 1.f, scr, lane);
            else transpose_item(a->in[I_WKV] + (size_t)l * 1024 * 2048, 1024, 2048, (bf16_t*)(ws + WS_WV), n0, kb * 64, n0 - 1024, a->in[I_NMEM] + l * 1024, 1.f, scr, lane);
            continue; } r -= I_KV;
        if (r < I_O) { const int kb = r / 16, nb = r % 16; transpose_item(a->in[I_WO] + (size_t)l * 1024 * 1024, 1024, 1024, (bf16_t*)(ws + WS_WO), nb * 64, kb * 64, nb * 64, nullptr, 1.f, scr, lane); continue; } r -= I_O;
        if (r < I_UP) { const int kb = r / 64, nb = r % 64; transpose_item(a->in[I_WUP] + (size_t)l * 1024 * 4096, 1024, 4096, (bf16_t*)(ws + WS_WUP), nb * 64, kb * 64, nb * 64, a->in[I_NMLP] + l * 1024, 1.f, scr, lane); continue; } r -= I_UP;
        { const int kb = r / 16, nb = r % 16; transpose_item(a->in[I_WDOWN] + (size_t)l * 4096 * 1024, 4096, 1024, (bf16_t*)(ws + WS_WDOWN), nb * 64, kb * 64, nb * 64, nullptr, 1.f, scr, lane); }
    }
    bf16_t* wdt = (bf16_t*)(ws + WS_WDT);
    for (int i = blockIdx.x * 512 + otid(); i < 16 * 512; i += gridDim.x * 512) { const int j = i >> 9, k = (i & 511) * 2;
        const float v0 = a->in[I_NMIX][l * 1024 + k] * a->in[I_WIN][((size_t)l * 1024 + k) * 3088 + 3072 + j], v1 = a->in[I_NMIX][l * 1024 + k + 1] * a->in[I_WIN][((size_t)l * 1024 + k + 1) * 3088 + 3072 + j];
        *(unsigned*)(wdt + j * 1024 + k) = pk2(v0, v1); }
}
__device__ __forceinline__ const float* xin_row(ArgsP a, int t) { return t < TP ? a->in[I_XP] + (size_t)t * DM : a->in[I_XS] + (size_t)(t - TP) * DM; }

__device__ __forceinline__ void phase_prologue(ArgsP a, LAS unsigned char* lds) {
    const int lane = otid() & 63, wave = otid() >> 6, gw = blockIdx.x * 8 + wave, NGW = gridDim.x * 8;
    unsigned char* ws = a->ws;
    float* ssq = (float*)(ws + WS_SSQ);
    for (int i = blockIdx.x * 512 + otid(); i < 6 * T_ALL; i += gridDim.x * 512) ssq[T_ALL + i] = 0.f;
    { f32x2* tw = (f32x2*)(ws + WS_TW); for (int i = blockIdx.x * 512 + otid(); i < 4096; i += gridDim.x * 512) { float s, c; sincospif(-(float)i * (1.0f / 4096.0f), &s, &c); tw[i] = (f32x2){c, s}; } }
    bf16_t* xb = (bf16_t*)(ws + WS_XB);
    for (int t = gw; t < T_ALL; t += 2 * NGW) {
        f32x4 v[2][4];
#pragma unroll
        for (int r = 0; r < 2; ++r) { const f32x4* xr = (const f32x4*)xin_row(a, t + r * NGW) + lane;
#pragma unroll
            for (int j = 0; j < 4; ++j) v[r][j] = xr[64 * j]; }
#pragma unroll
        for (int r = 0; r < 2; ++r) { float s = 0.f; u32x2* o = (u32x2*)(xb + (size_t)(t + r * NGW) * DM) + lane;
#pragma unroll
            for (int j = 0; j < 4; ++j) { const f32x4 x = v[r][j]; s += (x[0] * x[0] + x[1] * x[1]) + (x[2] * x[2] + x[3] * x[3]); u32x2 w; w.x = pk2(x[0], x[1]); w.y = pk2(x[2], x[3]); o[64 * j] = w; }
            s = wave_sum(s); if (lane == 0) ssq[t + r * NGW] = __uint_as_float(ssq_fx(s)); }
    }
    bf16_t* memb = (bf16_t*)(ws + WS_MEMB);
    for (int t = gw; t < 3072; t += NGW) {
        const float* mr = t < 2048 ? a->in[I_MP] + (size_t)t * DM : a->in[I_MS] + (size_t)(t - 2048) * DM;
        const f32x4* xr = (const f32x4*)mr + lane; f32x4 v[4]; float s = 0.f;
#pragma unroll
        for (int j = 0; j < 4; ++j) { v[j] = xr[64 * j]; s += (v[j][0] * v[j][0] + v[j][1] * v[j][1]) + (v[j][2] * v[j][2] + v[j][3] * v[j][3]); }
        const float rs = rsqrtf(wave_sum(s) * (1.0f / 1024.0f) + EPS);
        u32x2* o = (u32x2*)(memb + (size_t)t * DM) + lane;
#pragma unroll
        for (int j = 0; j < 4; ++j) { u32x2 w; w.x = pk2(v[j][0] * rs, v[j][1] * rs); w.y = pk2(v[j][2] * rs, v[j][3] * rs); o[64 * j] = w; }
    }
    float* h2 = (float*)(ws + WS_H2);
    for (int idx = gw; idx < 2 * 6144; idx += NGW) {
        const int l = idx / 6144, r = idx % 6144, set = r >= 2048 ? 1 : 0, t = set ? r - 2048 : r, L = set ? 4096 : 2048;
        const float tl = (float)t / (float)(L - 1), w = (6.283185307179586f / (float)L) * (float)t;
        const float fm = 1e-4f + (float)(lane & 15) * ((15.0f - 1e-4f) / 15.0f);
        float sv, cv; sincosf(fm * w, &sv, &cv);
        const float* fw1 = a->in[I_FW1] + l * 33 * 64; const float* fw2 = a->in[I_FW2] + l * 64 * 64;
        float acc = a->in[I_FB1][l * 64 + lane] + tl * fw1[lane];
#pragma unroll
        for (int i = 0; i < 16; ++i) { acc += __shfl(cv, i) * fw1[(1 + i) * 64 + lane]; acc -= __shfl(sv, i) * fw1[(17 + i) * 64 + lane]; }
        const float fr = a->in[I_FREQ][l * 64 + lane];
        const float h1 = sinf(fr * acc);
        float acc2 = a->in[I_FB2][l * 64 + lane];
#pragma unroll 8
        for (int i = 0; i < 64; ++i) acc2 += __shfl(h1, i) * fw2[i * 64 + lane];
        h2[(size_t)idx * 64 + lane] = sinf(fr * acc2);
    }
}
__device__ __forceinline__ void phase_dt(ArgsP a, int l, const bf16_t* xb, const float* ssq_in) {
    const int tid = otid(), lane = tid & 63, wave = tid >> 6, gw = blockIdx.x * 8 + wave, NGW = gridDim.x * 8, fr = lane & 15, fq = lane >> 4;
    const bf16_t* wdt = (const bf16_t*)(a->ws + WS_WDT); float* dt = (float*)(a->ws + WS_DT);
    for (int tile = gw; tile < T_ALL / 16; tile += NGW) {
        const int t0 = tile * 16;
        const bf16_t* ap = xb + (size_t)(t0 + fr) * DM + fq * 8; const bf16_t* bp = wdt + fr * 1024 + fq * 8;
        f32x4 acc = {0.f, 0.f, 0.f, 0.f};
#pragma unroll 16
        for (int ks = 0; ks < 32; ++ks) acc = __builtin_amdgcn_mfma_f32_16x16x32_bf16(*(const bf16x8*)(ap + ks * 32), *(const bf16x8*)(bp + ks * 32), acc, 0, 0, 0);
        const float bias = a->in[I_DTB][l * 16 + fr];
#pragma unroll
        for (int r = 0; r < 4; ++r) { const int t = t0 + fq * 4 + r; const float x = acc[r] * rsqrtf(ssq_ld(ssq_in + t) * (1.0f / 1024.0f) + EPS) + bias; dt[(size_t)t * 16 + fr] = x > 20.f ? x : log1pf(expf(x)); }
    }
}
__device__ __forceinline__ void phase_final(ArgsP a, const float* ssq, const bf16_t* xb) {
    const int lane = otid() & 63, wave = otid() >> 6, gw = blockIdx.x * 8 + wave, NGW = gridDim.x * 8;
    f32x4 g[4];
#pragma unroll
    for (int j = 0; j < 4; ++j) g[j] = *((const f32x4*)a->in[I_NFIN] + lane + 64 * j);
    for (int t = gw; t < T_ALL; t += 4 * NGW) {
        u32x2 q[4][4]; float rs[4];
#pragma unroll
        for (int r = 0; r < 4; ++r) { const int tr = t + r * NGW; rs[r] = rsqrtf(ssq_ld(ssq + tr) * (1.0f / 1024.0f) + EPS);
            const u32x2* xr = (const u32x2*)(xb + (size_t)tr * DM) + lane;
#pragma unroll
            for (int j = 0; j < 4; ++j) q[r][j] = xr[64 * j]; }
#pragma unroll
        for (int r = 0; r < 4; ++r) { f32x4* orow = (f32x4*)(a->out + (size_t)(t + r * NGW) * DM) + lane;
#pragma unroll
            for (int j = 0; j < 4; ++j) orow[64 * j] = (f32x4){bflo(q[r][j].x), bfhi(q[r][j].x), bflo(q[r][j].y), bfhi(q[r][j].y)} * rs[r] * g[j]; }
    }
}
__device__ __forceinline__ void phase_ssm_norm(ArgsP a, int l, bf16_t* buf) {
    const int lane = otid() & 63, wave = otid() >> 6, gw = blockIdx.x * 8 + wave, NGW = gridDim.x * 8;
    const float* gn = a->in[I_SNORM] + l * 512 + lane * 8;
    float g[8];
#pragma unroll
    for (int j = 0; j < 8; ++j) g[j] = gn[j];
    for (int t = gw; t < T_ALL; t += 4 * NGW) {
        u32x4 wv[4];
#pragma unroll
        for (int q = 0; q < 4; ++q) wv[q] = *((const u32x4*)(buf + (size_t)(t + q * NGW) * 512) + lane);
#pragma unroll
        for (int q = 0; q < 4; ++q) { const u32x4 w = wv[q];
            float v[8] = {bflo(w.x), bfhi(w.x), bflo(w.y), bfhi(w.y), bflo(w.z), bfhi(w.z), bflo(w.w), bfhi(w.w)};
            float s = 0.f;
#pragma unroll
            for (int j = 0; j < 8; ++j) s += v[j] * v[j];
            const float rs = rsqrtf(wave_sum(s) * (1.0f / 512.0f) + EPS);
            u32x4 o; o.x = pk2(v[0] * rs * g[0], v[1] * rs * g[1]); o.y = pk2(v[2] * rs * g[2], v[3] * rs * g[3]); o.z = pk2(v[4] * rs * g[4], v[5] * rs * g[5]); o.w = pk2(v[6] * rs * g[6], v[7] * rs * g[7]);
            *((u32x4*)(buf + (size_t)(t + q * NGW) * 512) + lane) = o; }
    }
}
constexpr int SLD = 136;
__device__ __forceinline__ int tsw(int p, int s) { return p * SLD + ((((s >> 3) ^ ((p >> 4) & 7)) << 3) | (s & 7)); }
__device__ __forceinline__ void seq_bounds(int t0, int& lo, int& hi) { if (t0 < TP) { lo = t0 & ~2047; hi = lo + 2048; } else { lo = TP + ((t0 - TP) & ~4095); hi = lo + 4096; } }
__device__ __forceinline__ float silu_f(float x) { return x * __builtin_amdgcn_rcpf(1.0f + __expf(-x)); }

template <int NC, bool TRANS>
__device__ __forceinline__ void load_conv_tile(const bf16_t* src, int ldsrc, int col0, int t0, int lo, int hi, const float* cw, const float* cbias, int ch0, LAS bf16_t* dst) {
    constexpr int CGS = NC / 8, RUNS = 512 / CGS, R = 128 / RUNS;
    const int tid = otid(), cgi = tid % CGS, run = tid / CGS, c = cgi * 8, r0 = run * R;
    float w[5][8], bb[8];
#pragma unroll
    for (int k = 0; k < 5; ++k) { const f32x4 a0 = *(const f32x4*)(cw + k * 1024 + ch0 + c), a1 = *(const f32x4*)(cw + k * 1024 + ch0 + c + 4);
#pragma unroll
        for (int e = 0; e < 4; ++e) { w[k][e] = a0[e]; w[k][4 + e] = a1[e]; } }
    { const f32x4 a0 = *(const f32x4*)(cbias + ch0 + c), a1 = *(const f32x4*)(cbias + ch0 + c + 4);
#pragma unroll
      for (int e = 0; e < 4; ++e) { bb[e] = a0[e]; bb[4 + e] = a1[e]; } }
    u32x4 raw[R + 4];
#pragma unroll
    for (int i = 0; i < R + 4; ++i) { const int t = t0 + r0 - 2 + i, tc = t < lo ? lo : (t >= hi ? hi - 1 : t);
        u32x4 q = *(const u32x4*)(src + (size_t)tc * ldsrc + col0 + c);
        if (t < lo || t >= hi) q = (u32x4){0u, 0u, 0u, 0u};
        raw[i] = q; }
    float win[5][8];
    auto cvrow = [&](const u32x4 q, float (&o)[8]) { o[0] = bflo(q.x); o[1] = bfhi(q.x); o[2] = bflo(q.y); o[3] = bfhi(q.y); o[4] = bflo(q.z); o[5] = bfhi(q.z); o[6] = bflo(q.w); o[7] = bfhi(q.w); };
#pragma unroll
    for (int i = 0; i < 4; ++i) cvrow(raw[i], win[i]);
    unsigned outp[8][R / 2];
#pragma unroll
    for (int rr = 0; rr < R; ++rr) {
        cvrow(raw[rr + 4], win[(rr + 4) % 5]);
        float o[8];
#pragma unroll
        for (int e = 0; e < 8; ++e) { float s = bb[e];
#pragma unroll
            for (int k = 0; k < 5; ++k) s += w[k][e] * win[(rr + k) % 5][e];
            o[e] = silu_f(s); }
        if (!TRANS) { u32x4 q; q.x = pk2(o[0], o[1]); q.y = pk2(o[2], o[3]); q.z = pk2(o[4], o[5]); q.w = pk2(o[6], o[7]); *(LAS u32x4*)(dst + (r0 + rr) * SLD + c) = q; }
        else {
#pragma unroll
            for (int e = 0; e < 8; ++e) { if (rr & 1) outp[e][rr >> 1] = (outp[e][rr >> 1] & 0xffffu) | (pk2(0.f, o[e]) & 0xffff0000u); else outp[e][rr >> 1] = pk2(o[e], 0.f) & 0xffffu; } }
    }
    if (TRANS) {
#pragma unroll
        for (int e = 0; e < 8; ++e) {
            if (R == 8) { u32x4 q; q.x = outp[e][0]; q.y = outp[e][1]; q.z = outp[e][2]; q.w = outp[e][R / 2 - 1]; *(LAS u32x4*)(dst + tsw(c + e, r0)) = q; }
            else { u32x2 q; q.x = outp[e][0]; q.y = outp[e][R / 2 - 1]; *(LAS u32x2*)(dst + tsw(c + e, r0)) = q; }
        }
    }
}
__device__ __forceinline__ void chunk_scan(const float* dt, int t0, int col, float A, int dir, int lane, float& d0, float& d1, float& c0, float& c1, float& total) {
    d0 = dt[(size_t)(t0 + 2 * lane) * 16 + col]; d1 = dt[(size_t)(t0 + 2 * lane + 1) * 16 + col];
    const float a0 = d0 * A, a1 = d1 * A;
    float v = a0 + a1;
#pragma unroll
    for (int d = 1; d < 64; d <<= 1) { const float tt = __shfl_up(v, d); if (lane >= d) v += tt; }
    total = __shfl(v, 63);
    const float p0 = v - a1, p1 = v;
    if (dir == 0) { c0 = p0; c1 = p1; } else { c0 = total - p0 + a0; c1 = total - p1 + a1; }
}
__device__ __forceinline__ bf16x8 scale_frag8(bf16x8 f, const float (&sc)[8]) {
    union { bf16x8 v; unsigned u[4]; } in, out; in.v = f;
#pragma unroll
    for (int j = 0; j < 4; ++j) out.u[j] = pk2(bflo(in.u[j]) * sc[2 * j], bfhi(in.u[j]) * sc[2 * j + 1]);
    return out.v;
}
__device__ __forceinline__ void phase_s1(ArgsP a, int l, int cbase, LAS unsigned char* lds, const bf16_t* xs_raw, const bf16_t* bc_raw, bf16_t* states) {
    const int tid = otid(), lane = tid & 63, wave = __builtin_amdgcn_readfirstlane(tid >> 6);
    LAS bf16_t* xsT = (LAS bf16_t*)lds;
    LAS bf16_t* BT = (LAS bf16_t*)(lds + 256 * SLD * 2);
    LAS float* sW = (LAS float*)(lds + 384 * SLD * 2);
    const float* dt = (const float*)(a->ws + WS_DT); float* decay = (float*)(a->ws + WS_DECAY);
    const float* cw = a->in[I_SCW] + l * 5 * 1024; const float* cbs = a->in[I_SCB] + l * 1024;
    for (int it = blockIdx.x; it < 256; it += gridDim.x) {
        const int gc = cbase + (it >> 1), g = it & 1, t0 = gc * 128; int lo, hi; seq_bounds(t0, lo, hi);
        const int hh = wave >> 1, dir = wave & 1, h8 = g * 4 + hh;
        { float d0, d1, c0, c1, tot; const float A = -__expf(a->in[I_ALOG][l * 16 + dir * 8 + h8]);
          chunk_scan(dt, t0, dir * 8 + h8, A, dir, lane, d0, d1, c0, c1, tot);
          sW[wave * 128 + 2 * lane] = d0 * __expf(tot - c0); sW[wave * 128 + 2 * lane + 1] = d1 * __expf(tot - c1);
          if (lane == 0) decay[gc * 16 + h8 * 2 + dir] = __expf(tot); }
        load_conv_tile<256, true>(xs_raw, 512, g * 256, t0, lo, hi, cw, cbs, g * 256, xsT);
        load_conv_tile<128, true>(bc_raw, 512, g * 128, t0, lo, hi, cw, cbs, 512 + g * 128, BT);
        __syncthreads();
        f32x4 acc[8][4];
#pragma unroll
        for (int i = 0; i < 8; ++i)
#pragma unroll
            for (int j = 0; j < 4; ++j) acc[i][j] = (f32x4){0.f, 0.f, 0.f, 0.f};
        const int fr = lane & 15, fq = lane >> 4;
#pragma unroll 1
        for (int ks = 0; ks < 4; ++ks) {
            const int s0 = ks * 32 + fq * 8;
            float sc[8]; { const f32x4 q0 = *(const LAS f32x4*)(sW + wave * 128 + s0), q1 = *(const LAS f32x4*)(sW + wave * 128 + s0 + 4);
#pragma unroll
                for (int e = 0; e < 4; ++e) { sc[e] = q0[e]; sc[4 + e] = q1[e]; } }
            bf16x8 xf[4];
#pragma unroll
            for (int pt = 0; pt < 4; ++pt) xf[pt] = scale_frag8(*(const LAS bf16x8*)(xsT + tsw(hh * 64 + pt * 16 + fr, s0)), sc);
#pragma unroll
            for (int nt = 0; nt < 8; ++nt) { const bf16x8 bf = *(const LAS bf16x8*)(BT + tsw(32 * (nt >> 1) + 8 * (fr >> 2) + 4 * (nt & 1) + (fr & 3), s0));
#pragma unroll
                for (int pt = 0; pt < 4; ++pt) acc[nt][pt] = __builtin_amdgcn_mfma_f32_16x16x32_bf16(bf, xf[pt], acc[nt][pt], 0, 0, 0); }
        }
        bf16_t* st = states + ((size_t)((gc - cbase) * 8 + h8) * 2 + dir) * 8192;
#pragma unroll
        for (int m = 0; m < 4; ++m)
#pragma unroll
            for (int pt = 0; pt < 4; ++pt) { u32x4 q; q.x = pk2(acc[2 * m][pt][0], acc[2 * m][pt][1]); q.y = pk2(acc[2 * m][pt][2], acc[2 * m][pt][3]); q.z = pk2(acc[2 * m + 1][pt][0], acc[2 * m + 1][pt][1]); q.w = pk2(acc[2 * m + 1][pt][2], acc[2 * m + 1][pt][3]);
                *(u32x4*)(st + (pt * 16 + fr) * 128 + 32 * m + 8 * fq) = q; }
        __syncthreads();
    }
}
__device__ __forceinline__ void phase_s2(ArgsP a, int cbase, bf16_t* states, int dry) {
    const int nseq = cbase == 0 ? 8 : 4, cps = cbase == 0 ? 16 : 32;
    const float* decay = (const float*)(a->ws + WS_DECAY);
    const int total = nseq * 16 * 1024;
    for (int i = blockIdx.x * 512 + otid(); i < total; i += gridDim.x * 512) {
        const int e8 = i & 1023, hd = (i >> 10) & 15, sq = i >> 14, dir = hd & 1;
        float hs[8];
#pragma unroll
        for (int j = 0; j < 8; ++j) hs[j] = 0.f;
#pragma unroll 1
        for (int cc0 = 0; cc0 < cps; cc0 += 8) {
            u32x4 w[8]; float dcv[8]; u32x4* pp[8];
#pragma unroll
            for (int u = 0; u < 8; ++u) { const int cc = cc0 + u, crel = sq * cps + (dir ? cps - 1 - cc : cc);
                pp[u] = (u32x4*)(states + ((size_t)crel * 16 + hd) * 8192) + e8; w[u] = *pp[u]; dcv[u] = decay[(cbase + crel) * 16 + hd]; }
#pragma unroll
            for (int u = 0; u < 8; ++u) { const float dc = dcv[u];
                u32x4 o; o.x = pk2(hs[0], hs[1]); o.y = pk2(hs[2], hs[3]); o.z = pk2(hs[4], hs[5]); o.w = pk2(hs[6], hs[7]); if (!dry) *pp[u] = o;
                hs[0] = hs[0] * dc + bflo(w[u].x); hs[1] = hs[1] * dc + bfhi(w[u].x); hs[2] = hs[2] * dc + bflo(w[u].y); hs[3] = hs[3] * dc + bfhi(w[u].y);
                hs[4] = hs[4] * dc + bflo(w[u].z); hs[5] = hs[5] * dc + bfhi(w[u].z); hs[6] = hs[6] * dc + bflo(w[u].w); hs[7] = hs[7] * dc + bfhi(w[u].w); }
        }
    }
}
__device__ __forceinline__ void phase_s3(ArgsP a, int l, int cbase, LAS unsigned char* lds, const bf16_t* xs_raw, const bf16_t* bc_raw, const bf16_t* states, bf16_t* gate, int dry) {
    const int tid = otid(), lane = tid & 63, wave = __builtin_amdgcn_readfirstlane(tid >> 6), fr = lane & 15, fq = lane >> 4;
    LAS bf16_t* xsT = (LAS bf16_t*)lds;
    LAS bf16_t* sC = (LAS bf16_t*)(lds + 128 * SLD * 2);
    LAS bf16_t* sB = (LAS bf16_t*)(lds + 256 * SLD * 2);
    LAS float* sDt = (LAS float*)(lds + 384 * SLD * 2);
    LAS float* sCs = sDt + 1024;
    const float* dt = (const float*)(a->ws + WS_DT);
    const float* cw = a->in[I_SCW] + l * 5 * 1024; const float* cbs = a->in[I_SCB] + l * 1024;
    for (int it = blockIdx.x; it < 256; it += gridDim.x) {
        const int gc = cbase + (it >> 1), g = it & 1, t0 = gc * 128; int lo, hi; seq_bounds(t0, lo, hi);
        { const int w4 = wave, hh4 = w4 >> 1, dir = w4 & 1, h8 = g * 4 + hh4; float d0, d1, c0, c1, tot; const float A = -__expf(a->in[I_ALOG][l * 16 + dir * 8 + h8]);
          chunk_scan(dt, t0, dir * 8 + h8, A, dir, lane, d0, d1, c0, c1, tot);
          { sDt[w4 * 128 + 2 * lane] = d0; sDt[w4 * 128 + 2 * lane + 1] = d1; sCs[w4 * 128 + 2 * lane] = c0; sCs[w4 * 128 + 2 * lane + 1] = c1; } }
        load_conv_tile<128, false>(bc_raw, 512, g * 128, t0, lo, hi, cw, cbs, 512 + g * 128, sB);
        load_conv_tile<128, false>(bc_raw, 512, 256 + g * 128, t0, lo, hi, cw, cbs, 768 + g * 128, sC);
        __syncthreads();
        {
            f32x4 cacc[8];
#pragma unroll
            for (int i = 0; i < 8; ++i) cacc[i] = (f32x4){0.f, 0.f, 0.f, 0.f};
#pragma unroll
            for (int ks = 0; ks < 4; ++ks) { const bf16x8 cf = *(const LAS bf16x8*)(sC + (wave * 16 + fr) * SLD + ks * 32 + fq * 8);
#pragma unroll
                for (int st = 0; st < 8; ++st) { const bf16x8 bf = *(const LAS bf16x8*)(sB + (st * 16 + fr) * SLD + ks * 32 + fq * 8); cacc[st] = __builtin_amdgcn_mfma_f32_16x16x32_bf16(bf, cf, cacc[st], 0, 0, 0); } }
            __syncthreads();
#pragma unroll
            for (int st = 0; st < 8; ++st) { u32x2 q; q.x = pk2(cacc[st][0], cacc[st][1]); q.y = pk2(cacc[st][2], cacc[st][3]); *(LAS u32x2*)(sB + (wave * 16 + fr) * SLD + st * 16 + fq * 4) = q; }
            __syncthreads();
        }
#pragma unroll 1
        for (int hp = 0; hp < 2; ++hp) {
        load_conv_tile<128, true>(xs_raw, 512, g * 256 + hp * 128, t0, lo, hi, cw, cbs, g * 256 + hp * 128, xsT);
        __syncthreads();
        const int hh2 = wave >> 2, lq = wave & 3, h8 = g * 4 + hp * 2 + hh2;
        const float Dh = a->in[I_SD][l * 8 + h8];
        const int hq = hp * 2 + hh2; const LAS float* dtf = sDt + (hq * 2) * 128; const LAS float* dtb = sDt + (hq * 2 + 1) * 128; const LAS float* csf = sCs + (hq * 2) * 128; const LAS float* csb = sCs + (hq * 2 + 1) * 128;
        f32x4 acc[2][4];
#pragma unroll
        for (int i = 0; i < 2; ++i)
#pragma unroll
            for (int j = 0; j < 4; ++j) acc[i][j] = (f32x4){0.f, 0.f, 0.f, 0.f};
#pragma unroll 1
        for (int ks = 0; ks < 4; ++ks) {
            const int s0 = ks * 32 + fq * 8;
            bf16x8 xf[4];
#pragma unroll
            for (int pt = 0; pt < 4; ++pt) xf[pt] = *(const LAS bf16x8*)(xsT + tsw(hh2 * 64 + pt * 16 + fr, s0));
            float vdf[8], vdb[8], vcf[8], vcb[8];
            { const f32x4 q0 = *(const LAS f32x4*)(dtf + s0), q1 = *(const LAS f32x4*)(dtf + s0 + 4), r0 = *(const LAS f32x4*)(dtb + s0), r1 = *(const LAS f32x4*)(dtb + s0 + 4);
              const f32x4 u0 = *(const LAS f32x4*)(csf + s0), u1 = *(const LAS f32x4*)(csf + s0 + 4), w0 = *(const LAS f32x4*)(csb + s0), w1 = *(const LAS f32x4*)(csb + s0 + 4);
#pragma unroll
              for (int e = 0; e < 4; ++e) { vdf[e] = q0[e]; vdf[4 + e] = q1[e]; vdb[e] = r0[e]; vdb[4 + e] = r1[e]; vcf[e] = u0[e]; vcf[4 + e] = u1[e]; vcb[e] = w0[e]; vcb[4 + e] = w1[e]; } }
#pragma unroll
            for (int lt = 0; lt < 2; ++lt) {
                const int lrow = lq * 32 + lt * 16 + fr;
                const float csf_l = csf[lrow], csb_l = csb[lrow];
                const u32x4 cbq = *(const LAS u32x4*)(sB + lrow * SLD + s0);
                const float cbv[8] = {bflo(cbq.x), bfhi(cbq.x), bflo(cbq.y), bfhi(cbq.y), bflo(cbq.z), bfhi(cbq.z), bflo(cbq.w), bfhi(cbq.w)};
                float mv[8];
#pragma unroll
                for (int e = 0; e < 8; ++e) { const int s = s0 + e;
                    const float ex = s < lrow ? csf_l - vcf[e] : csb_l - vcb[e];
                    const float dd = s < lrow ? vdf[e] : vdb[e];
                    float mm = cbv[e] * __expf(ex) * dd;
                    if (s == lrow) mm = cbv[e] * (vdf[e] + vdb[e]) + Dh;
                    mv[e] = mm;
                    }
                union { bf16x8 v; unsigned u[4]; } mf;
#pragma unroll
                for (int j = 0; j < 4; ++j) mf.u[j] = pk2(mv[2 * j], mv[2 * j + 1]);
#pragma unroll
                for (int pt = 0; pt < 4; ++pt) acc[lt][pt] = __builtin_amdgcn_mfma_f32_16x16x32_bf16(xf[pt], mf.v, acc[lt][pt], 0, 0, 0);
            }
        }
#pragma unroll 1
        for (int dir = 0; dir < 2; ++dir) {
            const bf16_t* pv = states + ((size_t)((gc - cbase) * 8 + h8) * 2 + dir) * 8192;
            const LAS float* cs = dir ? csb : csf;
            float el[2];
#pragma unroll
            for (int lt = 0; lt < 2; ++lt) el[lt] = __expf(cs[lq * 32 + lt * 16 + fr]);
#pragma unroll
            for (int ks = 0; ks < 4; ++ks) {
                const int n0 = ks * 32 + fq * 8;
                bf16x8 pf[4];
#pragma unroll
                for (int pt = 0; pt < 4; ++pt) pf[pt] = *(const bf16x8*)(pv + (pt * 16 + fr) * 128 + n0);
#pragma unroll
                for (int lt = 0; lt < 2; ++lt) {
                    const float sc[8] = {el[lt], el[lt], el[lt], el[lt], el[lt], el[lt], el[lt], el[lt]};
                    const bf16x8 cf = scale_frag8(*(const LAS bf16x8*)(sC + (lq * 32 + lt * 16 + fr) * SLD + n0), sc);
#pragma unroll
                    for (int pt = 0; pt < 4; ++pt) acc[lt][pt] = __builtin_amdgcn_mfma_f32_16x16x32_bf16(pf[pt], cf, acc[lt][pt], 0, 0, 0);
                }
            }
        }
        u32x2 gqv[2][4];
#pragma unroll
        for (int lt = 0; lt < 2; ++lt)
#pragma unroll
            for (int pt = 0; pt < 4; ++pt) gqv[lt][pt] = *(const u32x2*)(gate + (size_t)(t0 + lq * 32 + lt * 16 + fr) * 512 + g * 256 + (hp * 2 + hh2) * 64 + pt * 16 + fq * 4);
#pragma unroll
        for (int lt = 0; lt < 2; ++lt)
#pragma unroll
            for (int pt = 0; pt < 4; ++pt) {
                u32x2* gp = (u32x2*)(gate + (size_t)(t0 + lq * 32 + lt * 16 + fr) * 512 + g * 256 + (hp * 2 + hh2) * 64 + pt * 16 + fq * 4);
                const u32x2 gq = gqv[lt][pt];
                u32x2 o; o.x = pk2(acc[lt][pt][0] * silu_f(bflo(gq.x)), acc[lt][pt][1] * silu_f(bfhi(gq.x))); o.y = pk2(acc[lt][pt][2] * silu_f(bflo(gq.y)), acc[lt][pt][3] * silu_f(bfhi(gq.y)));
                if (!dry) *gp = o;
            }
        __syncthreads();
        }
    }
}
__device__ __forceinline__ f32x2 cmul(f32x2 a, f32x2 b) { const f32x2 bx = {b.x, b.x}, by = {b.y, b.y}, ar = {-a.y, a.x}; return a * bx + ar * by; }
__device__ __forceinline__ f32x2 cmulc(f32x2 a, f32x2 b) { const f32x2 bx = {b.x, b.x}, by = {b.y, b.y}, ar = {a.y, -a.x}; return a * bx + ar * by; }
#define DP(e) d[(e) + ((e) >> 4)]
__device__ __forceinline__ f32x2 w16(int k) {
    constexpr float C[8] = {1.f, 0.9238795325112867f, 0.7071067811865476f, 0.3826834323650898f, 0.f, -0.3826834323650898f, -0.7071067811865476f, -0.9238795325112867f};
    constexpr float S[8] = {0.f, 0.3826834323650898f, 0.7071067811865476f, 0.9238795325112867f, 1.f, 0.9238795325112867f, 0.7071067811865476f, 0.3826834323650898f};
    return (f32x2){C[k], -S[k]};
}
__device__ __forceinline__ f32x2 mulw16(f32x2 v, int k) { if (k == 0) return v; if (k == 4) return (f32x2){v.y, -v.x}; return cmul(v, w16(k)); }
__device__ __forceinline__ f32x2 mulw16c(f32x2 v, int k) { if (k == 0) return v; if (k == 4) return (f32x2){-v.y, v.x}; return cmulc(v, w16(k)); }
template <int LOGN, bool FOLD = false, int TPA = 512> __device__ __forceinline__ void fft_fwd(LAS f32x2* d, const LAS f32x2* tw, const int tq) {
    constexpr int N = 1 << LOGN;
    if (LOGN == 13 && !FOLD) {
#pragma unroll
        for (int qi = 0; qi < 8; ++qi) { const int q = tq + 512 * qi; const f32x2 x0 = DP(q), x1 = DP(q + 4096); DP(q) = x0 + x1; DP(q + 4096) = cmul(x0 - x1, tw[q]); }
        __syncthreads();
    }
#pragma unroll 1
    for (int ls = 11; ls >= 7; ls -= 4) {
        const int st = 1 << (ls - 3);
#pragma unroll
        for (int gi = 0; gi < (N / 16 + TPA - 1) / TPA; ++gi) { const int g = tq + TPA * gi;
            if (g < N / 16) {
                const int j = g & (st - 1), blk = g >> (ls - 3), base = (blk << (ls + 1)) + j;
                const f32x2 W1 = tw[j << (12 - ls)], W2 = tw[j << (13 - ls)], W3 = tw[j << (14 - ls)], W4 = tw[j << (15 - ls)];
                f32x2 x[16];
#pragma unroll
                for (int k = 0; k < 16; ++k) x[k] = DP(base + k * st);
#pragma unroll
                for (int k = 0; k < 8; ++k) { const f32x2 a = x[k], b = x[k + 8]; x[k] = a + b; x[k + 8] = cmul(mulw16(a - b, k), W1); }
#pragma unroll
                for (int k = 0; k < 16; ++k) if ((k & 7) < 4) { const f32x2 a = x[k], b = x[k + 4]; x[k] = a + b; x[k + 4] = cmul(mulw16(a - b, 2 * (k & 3)), W2); }
#pragma unroll
                for (int k = 0; k < 16; ++k) if ((k & 3) < 2) { const f32x2 a = x[k], b = x[k + 2]; x[k] = a + b; x[k + 2] = cmul(mulw16(a - b, 4 * (k & 1)), W3); }
#pragma unroll
                for (int k = 0; k < 16; k += 2) { const f32x2 a = x[k], b = x[k + 1]; x[k] = a + b; x[k + 1] = cmul(a - b, W4); }
#pragma unroll
                for (int k = 0; k < 16; ++k) DP(base + k * st) = x[k];
            }
        }
        __syncthreads();
    }
#pragma unroll
    for (int gi = 0; gi < (N / 16 + TPA - 1) / TPA; ++gi) { const int g = tq + TPA * gi;
        if (g < N / 16) {
            f32x2 x[16];
#pragma unroll
            for (int i = 0; i < 16; ++i) x[i] = d[17 * g + i];
#pragma unroll
            for (int i = 0; i < 8; ++i) { const f32x2 a = x[i], b = x[i + 8]; x[i] = a + b; x[i + 8] = mulw16(a - b, i); }
#pragma unroll
            for (int i = 0; i < 16; ++i) if ((i & 7) < 4) { const f32x2 a = x[i], b = x[i + 4]; x[i] = a + b; x[i + 4] = mulw16(a - b, 2 * (i & 3)); }
#pragma unroll
            for (int i = 0; i < 16; ++i) if ((i & 3) < 2) { const f32x2 a = x[i], b = x[i + 2]; x[i] = a + b; x[i + 2] = mulw16(a - b, 4 * (i & 1)); }
#pragma unroll
            for (int i = 0; i < 16; i += 2) { const f32x2 a = x[i], b = x[i + 1]; x[i] = a + b; x[i + 1] = a - b; }
#pragma unroll
            for (int i = 0; i < 16; ++i) d[17 * g + i] = x[i];
        }
    }
    __syncthreads();
}
template <int LOGN, bool FOLD = false, int TPA = 512> __device__ __forceinline__ void fft_inv(LAS f32x2* d, const LAS f32x2* tw, const int tq) {
    constexpr int N = 1 << LOGN;
#pragma unroll
    for (int gi = 0; gi < (N / 16 + TPA - 1) / TPA; ++gi) { const int g = tq + TPA * gi;
        if (g < N / 16) {
            f32x2 x[16];
#pragma unroll
            for (int i = 0; i < 16; ++i) x[i] = d[17 * g + i];
#pragma unroll
            for (int i = 0; i < 16; i += 2) { const f32x2 a = x[i], b = x[i + 1]; x[i] = a + b; x[i + 1] = a - b; }
#pragma unroll
            for (int i = 0; i < 16; ++i) if ((i & 3) < 2) { const f32x2 a = x[i], b = mulw16c(x[i + 2], 4 * (i & 1)); x[i] = a + b; x[i + 2] = a - b; }
#pragma unroll
            for (int i = 0; i < 16; ++i) if ((i & 7) < 4) { const f32x2 a = x[i], b = mulw16c(x[i + 4], 2 * (i & 3)); x[i] = a + b; x[i + 4] = a - b; }
#pragma unroll
            for (int i = 0; i < 8; ++i) { const f32x2 a = x[i], b = mulw16c(x[i + 8], i); x[i] = a + b; x[i + 8] = a - b; }
#pragma unroll
            for (int i = 0; i < 16; ++i) d[17 * g + i] = x[i];
        }
    }
    __syncthreads();
#pragma unroll 1
    for (int ls = 7; ls <= 11; ls += 4) {
        const int st = 1 << (ls - 3);
#pragma unroll
        for (int gi = 0; gi < (N / 16 + TPA - 1) / TPA; ++gi) { const int g = tq + TPA * gi;
            if (g < N / 16) {
                const int j = g & (st - 1), blk = g >> (ls - 3), base = (blk << (ls + 1)) + j;
                const f32x2 W1 = tw[j << (12 - ls)], W2 = tw[j << (13 - ls)], W3 = tw[j << (14 - ls)], W4 = tw[j << (15 - ls)];
                f32x2 x[16];
#pragma unroll
                for (int k = 0; k < 16; ++k) x[k] = DP(base + k * st);
#pragma unroll
                for (int k = 0; k < 16; k += 2) { const f32x2 a = x[k], b = cmulc(x[k + 1], W4); x[k] = a + b; x[k + 1] = a - b; }
#pragma unroll
                for (int k = 0; k < 16; ++k) if ((k & 3) < 2) { const f32x2 a = x[k], b = cmulc(mulw16c(x[k + 2], 4 * (k & 1)), W3); x[k] = a + b; x[k + 2] = a - b; }
#pragma unroll
                for (int k = 0; k < 16; ++k) if ((k & 7) < 4) { const f32x2 a = x[k], b = cmulc(mulw16c(x[k + 4], 2 * (k & 3)), W2); x[k] = a + b; x[k + 4] = a - b; }
#pragma unroll
                for (int k = 0; k < 8; ++k) { const f32x2 a = x[k], b = cmulc(mulw16c(x[k + 8], k), W1); x[k] = a + b; x[k + 8] = a - b; }
#pragma unroll
                for (int k = 0; k < 16; ++k) DP(base + k * st) = x[k];
            }
        }
        __syncthreads();
    }
    if (LOGN == 13 && !FOLD) {
#pragma unroll
        for (int qi = 0; qi < 8; ++qi) { const int q = tq + 512 * qi; const f32x2 u = DP(q), v = cmulc(DP(q + 4096), tw[q]); DP(q) = u + v; DP(q + 4096) = u - v; }
        __syncthreads();
    }
}
constexpr size_t FT_SET0_OFF = (size_t)2 * 512 * 4096;
__device__ __forceinline__ void phase_filter(ArgsP a, int l, LAS unsigned char* lds, float* FT) {
    LAS float* sh = (LAS float*)lds;
    LAS float* sw = (LAS float*)(lds + 64 * 65 * 4);
    const int tid = otid(), lane = tid & 63, wave = tid >> 6;
    const float min_decay = -3.0701134573253944f, max_decay = -15.350567286626972f;
    for (int it = blockIdx.x; it < 1536; it += gridDim.x) {
        const int set = it < 1024 ? 1 : 0, r = set ? it : it - 1024, L = set ? 4096 : 2048, tt0 = (r >> 4) * 64, cc0 = (r & 15) * 64;
        const float* h2 = (const float*)(a->ws + WS_H2) + ((size_t)l * 6144 + (set ? 2048 : 0) + tt0) * 64;
        const float* fw3 = a->in[I_FW3] + (size_t)l * 64 * 1024 + cc0;
        { const int rr = tid >> 3, c8 = (tid & 7) * 8;
          const f32x4 h0 = *(const f32x4*)(h2 + rr * 64 + c8), h1 = *(const f32x4*)(h2 + rr * 64 + c8 + 4);
          const f32x4 w0 = *(const f32x4*)(fw3 + (size_t)rr * 1024 + c8), w1 = *(const f32x4*)(fw3 + (size_t)rr * 1024 + c8 + 4);
#pragma unroll
          for (int e = 0; e < 4; ++e) { sh[rr * 65 + c8 + e] = h0[e]; sh[rr * 65 + c8 + 4 + e] = h1[e]; }
          *(LAS f32x4*)(sw + rr * 64 + c8) = w0; *(LAS f32x4*)(sw + rr * 64 + c8 + 4) = w1; }
        __syncthreads();
        float o[8];
#pragma unroll
        for (int k = 0; k < 8; ++k) o[k] = 0.f;
#pragma unroll 8
        for (int i = 0; i < 64; ++i) { const float hv = sh[lane * 65 + i]; const f32x4 w0 = *(const LAS f32x4*)(sw + i * 64 + wave * 8), w1 = *(const LAS f32x4*)(sw + i * 64 + wave * 8 + 4);
#pragma unroll
            for (int e = 0; e < 4; ++e) { o[e] += hv * w0[e]; o[4 + e] += hv * w1[e]; } }
        const int t = tt0 + lane; const float tl = (float)t / (float)(L - 1);
        float fb[8];
#pragma unroll
        for (int k = 0; k < 8; ++k) fb[k] = a->in[I_FB3][l * 1024 + cc0 + wave * 8 + k];
#pragma unroll
        for (int k = 0; k < 8; ++k) { const int cp = cc0 + wave * 8 + k, dir = cp >> 9, c = cp & 511;
            const float delta = fabsf(min_decay + (float)c * ((max_decay - min_decay) / 511.0f));
            FT[(set ? 0 : FT_SET0_OFF) + ((size_t)dir * 512 + c) * L + t] = (o[k] + fb[k]) * __expf(-tl * delta); }
        __syncthreads();
    }
}
template <int LOGN> __device__ __forceinline__ void hyena_conv_item(ArgsP a, int l, int c, LAS unsigned char* lds, const bf16_t* x1T, bf16_t* vT, const float* FT, int dry) {
    constexpr int N = 1 << LOGN, L = N / 2, SET = (LOGN == 13), NB = SET ? 4 : 8, TOK0 = SET ? TP : 0, TPA = SET ? 512 : 256, NPAR = 512 / TPA, NJ = L / TPA, NK = N / TPA;
    static_assert(NJ == 8 && NK == 16, "shape");
    LAS f32x2* d = (LAS f32x2*)lds;
    LAS f32x2* tw = (LAS f32x2*)(lds + 69632);
    const int tid = otid(), tl = tid % TPA;
    const float* hfT = FT + (SET ? 0 : FT_SET0_OFF) + (size_t)c * L; const float* hbT = hfT + (size_t)512 * L;
#pragma unroll
    for (int j = 0; j < L / 512; ++j) { const int t = tid + 512 * j;
        DP(t) = (f32x2){hfT[t], 0.f};
        if (t >= 1) DP(N - t) = (f32x2){hbT[t], 0.f};
    }
    if (tid == 0) DP(L) = (f32x2){0.f, 0.f};
    __syncthreads();
    fft_fwd<LOGN>(d, tw, tid);
    f32x2 kf[NK];
#pragma unroll
    for (int j = 0; j < NK; ++j) kf[j] = DP(tl + TPA * j) * (1.0f / (float)N);
    __syncthreads();
    const float* cw = a->in[I_HCW] + l * 3 * 1536; const float cb1 = a->in[I_HCB][l * 1536 + 512 + c], cbv = a->in[I_HCB][l * 1536 + 1024 + c];
    const float w10 = cw[512 + c], w11 = cw[1536 + 512 + c], w12 = cw[3072 + 512 + c], wv0 = cw[1024 + c], wv1 = cw[1536 + 1024 + c], wv2 = cw[3072 + 1024 + c];
    const float hbias = a->in[I_HBIAS][l * 512 + c];
    LAS f32x2* const d0 = d; d = d0 + (tid / TPA) * (N + N / 16);
#pragma unroll 1
    for (int bp0 = 0; bp0 < NB / 2; bp0 += NPAR) {
        const int bp = bp0 + tid / TPA;
        const size_t rowA = (size_t)c * T_ALL + TOK0 + (size_t)(2 * bp) * L, rowB = rowA + L;
        float zA[NJ], zB[NJ];
        {
            const int tb = tl * NJ;
            float x1a[NJ + 2], va[NJ + 2], x1b[NJ + 2], vb[NJ + 2];
            auto ldrow = [&](const bf16_t* p, float (&o)[NJ + 2]) {
                const u32x4 q = *(const u32x4*)(p + tb); o[1] = bflo(q.x); o[2] = bfhi(q.x); o[3] = bflo(q.y); o[4] = bfhi(q.y); o[5] = bflo(q.z); o[6] = bfhi(q.z); o[7] = bflo(q.w); o[8] = bfhi(q.w);
                o[0] = tb > 0 ? bf2f(p[tb - 1]) : 0.f; o[NJ + 1] = tb + NJ < L ? bf2f(p[tb + NJ]) : 0.f;
            };
            ldrow(x1T + rowA, x1a); ldrow(vT + rowA, va); ldrow(x1T + rowB, x1b); ldrow(vT + rowB, vb);
#pragma unroll
            for (int jj = 0; jj < NJ; ++jj) {
                zA[jj] = (cb1 + w10 * x1a[jj] + w11 * x1a[jj + 1] + w12 * x1a[jj + 2]) * (cbv + wv0 * va[jj] + wv1 * va[jj + 1] + wv2 * va[jj + 2]);
                zB[jj] = (cb1 + w10 * x1b[jj] + w11 * x1b[jj + 1] + w12 * x1b[jj + 2]) * (cbv + wv0 * vb[jj] + wv1 * vb[jj + 1] + wv2 * vb[jj + 2]);
                const f32x2 zz = {zA[jj], zB[jj]}; DP(tb + jj) = zz; DP(L + tb + jj) = (LOGN == 13) ? cmul(zz, tw[tb + jj]) : (f32x2){0.f, 0.f};
            }
        }
        __syncthreads();
        fft_fwd<LOGN, true, TPA>(d, tw, tl);
#pragma unroll
        for (int j = 0; j < NK; ++j) DP(tl + TPA * j) = cmul(DP(tl + TPA * j), kf[j]);
        __syncthreads();
        fft_inv<LOGN, true, TPA>(d, tw, tl);
        {   const int tb = tl * NJ; unsigned oa[NJ / 2], ob[NJ / 2];
#pragma unroll
            for (int jj = 0; jj < NJ; jj += 2) { f32x2 y0 = DP(tb + jj), y1 = DP(tb + jj + 1);
                if (LOGN == 13) { y0 = y0 + cmulc(DP(L + tb + jj), tw[tb + jj]); y1 = y1 + cmulc(DP(L + tb + jj + 1), tw[tb + jj + 1]); }
                oa[jj / 2] = pk2(y0.x + zA[jj] * hbias, y1.x + zA[jj + 1] * hbias); ob[jj / 2] = pk2(y0.y + zB[jj] * hbias, y1.y + zB[jj + 1] * hbias); }
            if (!dry) { u32x4 qa, qb; qa.x = oa[0]; qa.y = oa[1]; qa.z = oa[2]; qa.w = oa[3]; qb.x = ob[0]; qb.y = ob[1]; qb.z = ob[2]; qb.w = ob[3]; *(u32x4*)(vT + rowA + tb) = qa; *(u32x4*)(vT + rowB + tb) = qb; }
        }
        __syncthreads();
    }
}
__device__ __forceinline__ void phase_hyena_conv(ArgsP a, int l, LAS unsigned char* lds, const bf16_t* x1T, bf16_t* vT, const float* FT, int dry) {
    { LAS f32x2* tw = (LAS f32x2*)(lds + 69632); const f32x2* g = (const f32x2*)(a->ws + WS_TW); for (int i = otid(); i < 4096; i += 512) tw[i] = g[i]; }
    __syncthreads();
    for (int it = blockIdx.x; it < 1024; it += gridDim.x) {
        if (it < 512) hyena_conv_item<13>(a, l, it, lds, x1T, vT, FT, dry);
        else hyena_conv_item<12>(a, l, it - 512, lds, x1T, vT, FT, dry);
    }
}
__device__ __forceinline__ void phase_hyena_norm(ArgsP a, int l, LAS unsigned char* lds, const bf16_t* x0T, const bf16_t* yT, bf16_t* hyn) {
    constexpr int PLD = 513;
    LAS float* P = (LAS float*)lds;
    LAS float* part = (LAS float*)(lds + 64 * PLD * 4);
    const int tid = otid(), lane = tid & 63, wave = tid >> 6, tp = lane & 15, cq = lane >> 4;
    const float* cw = a->in[I_HCW] + l * 3 * 1536; const float* cb = a->in[I_HCB] + l * 1536;
    float hg[8];
#pragma unroll
    for (int j = 0; j < 4; ++j) { hg[2 * j] = a->in[I_HNORM][l * 512 + 2 * lane + 128 * j]; hg[2 * j + 1] = a->in[I_HNORM][l * 512 + 2 * lane + 128 * j + 1]; }
    for (int it = blockIdx.x; it < T_ALL / 64; it += gridDim.x) {
        const int tile0 = it * 64, t = tile0 + 4 * tp; int lo, hi; seq_bounds(tile0, lo, hi);
        const bool hasl = t > lo, hasr = t + 4 < hi;
        float ss0 = 0.f, ss1 = 0.f, ss2 = 0.f, ss3 = 0.f;
#pragma unroll 8
        for (int i = 0; i < 16; ++i) {
            const int c = wave * 64 + 4 * i + cq; const size_t row = (size_t)c * T_ALL;
            const u32x2 xc = *(const u32x2*)(x0T + row + t), yc = *(const u32x2*)(yT + row + t);
            const float xm = hasl ? bf2f(x0T[row + t - 1]) : 0.f, xp = hasr ? bf2f(x0T[row + t + 4]) : 0.f;
            const float x0 = bflo(xc.x), x1 = bfhi(xc.x), x2 = bflo(xc.y), x3 = bfhi(xc.y), w0 = cw[c], w1 = cw[1536 + c], w2 = cw[3072 + c], bb = cb[c];
            const float p0 = (bb + w0 * xm + w1 * x0 + w2 * x1) * bflo(yc.x), p1 = (bb + w0 * x0 + w1 * x1 + w2 * x2) * bfhi(yc.x);
            const float p2 = (bb + w0 * x1 + w1 * x2 + w2 * x3) * bflo(yc.y), p3 = (bb + w0 * x2 + w1 * x3 + w2 * xp) * bfhi(yc.y);
            P[(4 * tp) * PLD + c] = p0; P[(4 * tp + 1) * PLD + c] = p1; P[(4 * tp + 2) * PLD + c] = p2; P[(4 * tp + 3) * PLD + c] = p3;
            ss0 += p0 * p0; ss1 += p1 * p1; ss2 += p2 * p2; ss3 += p3 * p3;
        }
        ss0 += __shfl_xor(ss0, 16); ss1 += __shfl_xor(ss1, 16); ss2 += __shfl_xor(ss2, 16); ss3 += __shfl_xor(ss3, 16);
        ss0 += __shfl_xor(ss0, 32); ss1 += __shfl_xor(ss1, 32); ss2 += __shfl_xor(ss2, 32); ss3 += __shfl_xor(ss3, 32);
        if (lane < 16) { part[wave * 64 + 4 * lane] = ss0; part[wave * 64 + 4 * lane + 1] = ss1; part[wave * 64 + 4 * lane + 2] = ss2; part[wave * 64 + 4 * lane + 3] = ss3; }
        __syncthreads();
#pragma unroll 1
        for (int r = 0; r < 8; ++r) {
            const int tl = wave * 8 + r;
            float s = 0.f;
#pragma unroll
            for (int w = 0; w < 8; ++w) s += part[w * 64 + tl];
            const float rs = rsqrtf(s * (1.0f / 512.0f) + EPS);
            bf16_t* orow = hyn + (size_t)(tile0 + tl) * 512;
#pragma unroll
            for (int j = 0; j < 4; ++j) { const int c = 2 * lane + 128 * j;
                const float v0 = P[tl * PLD + c] * rs * hg[2 * j], v1 = P[tl * PLD + c + 1] * rs * hg[2 * j + 1];
                *(unsigned*)(orow + c) = pk2(v0, v1); }
        }
        __syncthreads();
    }
}
#define XB_TMO      128
#define XB_XCNT(j)  (256  + 64 * (j))
#define XB_XSUB(j)  (1280 + 64 * (j))
#define XB_XGEN(j)  (2304 + 64 * (j))
#define XB_TOP      3328
#define XB_TOPGEN   3392
#define XCD_BAR_WORDS 3456
#define XB_SPIN_CAP (1u << 22)
constexpr size_t WS_BAR = 106 * MiB + 524288;
__device__ __forceinline__ unsigned xb_ld(unsigned* p)              { return __hip_atomic_load(p, __ATOMIC_RELAXED, __HIP_MEMORY_SCOPE_AGENT); }
__device__ __forceinline__ unsigned xb_add(unsigned* p, unsigned v) { return __hip_atomic_fetch_add(p, v, __ATOMIC_RELAXED, __HIP_MEMORY_SCOPE_AGENT); }
__device__ __forceinline__ unsigned xb_xcc_id() { return (unsigned)__builtin_amdgcn_s_getreg((3 << 11) | 20) & 0xFu; }
#define XB_SPIN(cond, bar) do { unsigned _sp = 0; while (cond) { __builtin_amdgcn_s_sleep(1); \
    if ((++_sp & 255u) == 0u) { if (xb_ld(&(bar)[XB_TMO])) break; if (_sp > XB_SPIN_CAP) { atomicAdd(&(bar)[XB_TMO], 1u); break; } } } } while (0)
__device__ __forceinline__ void xcd_barrier_complete(unsigned* bar, unsigned x, unsigned& nloc, unsigned& nx) {
    const unsigned G = gridDim.x;
    unsigned sum, cnt, mine, sp = 0u;
    for (;;) {
        sum = 0u; cnt = 0u; mine = 0u;
#pragma unroll
        for (unsigned j = 0; j < 16; ++j) { const unsigned c = xb_ld(&bar[XB_XCNT(j)]); sum += c; cnt += (c > 0u) ? 1u : 0u; mine = (j == x) ? c : mine; }
        if (sum == G) break;
        __builtin_amdgcn_s_sleep(1);
        if ((++sp & 255u) == 0u) { if (xb_ld(&bar[XB_TMO])) break; if (sp > XB_SPIN_CAP) { atomicAdd(&bar[XB_TMO], 1u); break; } }
    }
    nloc = mine > 0u ? mine : 1u; nx = cnt > 0u ? cnt : 1u;
}
__device__ __forceinline__ void xcd_barrier(unsigned* bar, volatile LAS unsigned* st) {
    asm volatile("s_waitcnt vmcnt(0)" ::: "memory");
    __syncthreads();
    if (threadIdx.x == 0) {
        const unsigned x = xb_xcc_id();
        __builtin_amdgcn_s_waitcnt(0);
        unsigned nloc = st[0], nx = st[1];
        if (nloc == 0u) { xcd_barrier_complete(bar, x, nloc, nx); st[0] = nloc; st[1] = nx; }
        const unsigned old = xb_add(&bar[XB_XSUB(x)], 1u);
        const unsigned gen = old / nloc;
        if (old + 1u == (gen + 1u) * nloc) {
            __builtin_amdgcn_fence(__ATOMIC_RELEASE, "agent");
            asm volatile("s_waitcnt vmcnt(0)" ::: "memory");
            const unsigned og = xb_add(&bar[XB_TOP], 1u);
            const unsigned tg = og / nx;
            if (og + 1u == (tg + 1u) * nx) xb_add(&bar[XB_TOPGEN], 1u);
            else XB_SPIN(xb_ld(&bar[XB_TOPGEN]) == tg, bar);
            __builtin_amdgcn_fence(__ATOMIC_ACQUIRE, "agent");
            xb_add(&bar[XB_XGEN(x)], 1u);
            asm volatile("s_waitcnt vmcnt(0)" ::: "memory");
        } else {
            XB_SPIN(xb_ld(&bar[XB_XGEN(x)]) == gen, bar);
            __builtin_amdgcn_fence(__ATOMIC_ACQUIRE, "agent");
            asm volatile("s_waitcnt vmcnt(0)" ::: "memory");
        }
    }
    __syncthreads();
}
__device__ __forceinline__ void epi_cfg(int st, int gi, int l, unsigned char* ws, float* out, ArgsP a, Epi& E) {
    float* ssq = (float*)(ws + WS_SSQ); bf16_t* xb = (bf16_t*)(ws + WS_XB);
    bf16_t* r1a = (bf16_t*)(ws + WS_R1A); bf16_t* r1b = (bf16_t*)(ws + WS_R1B); bf16_t* r2 = (bf16_t*)(ws + WS_R2); bf16_t* r3 = (bf16_t*)(ws + WS_R3);
    bf16_t* kmat = (bf16_t*)(ws + WS_R4); bf16_t* vtm = (bf16_t*)(ws + WS_R4 + 6 * MiB);
    float* ssq_in = ssq + (size_t)(3 * l) * T_ALL; float* ssq_a = ssq_in + T_ALL; float* ssq_m = ssq_a + T_ALL; float* ssq_n = ssq_m + T_ALL;
    const int half = (st >= 16) ? ((st - 16) >> 1) : 0;
    E.kind = 0; E.O0 = r1a; E.d1 = 0; E.d2 = 0; E.ldc = 1024; E.csplit = 0; E.rsplit = 0; E.ssq = ssq_in; E.psum = (float*)(ws + WS_PSUM); E.row_off = 0; E.SCALE = 0; E.ACT = 0;
    E.X = out; E.rin0 = out; E.rin1 = out + (size_t)TP * DM; E.xb = xb; E.ssq_out = ssq_a; E.rin_bf16 = 0; E.write_x = 1; E.write_xb = 1;
    if (st == 1)       { E.O0 = r1b; E.d1 = r2 - r1b; E.d2 = r3 - r2; E.ldc = 512; E.csplit = 2; E.SCALE = 1; }
    else if (st == 8)  { E.O0 = r2; E.d1 = r1a - r2; E.d2 = r3 - r1a; E.ldc = T_ALL; E.rsplit = 2; E.SCALE = 2; }
    else if (st == 11) { E.kind = 1; E.write_x = 0; E.rin_bf16 = 1; }
    else if (st == 12) {
        if (gi == 0)      { E.SCALE = 1; E.ssq = ssq_a; }
        else              { E.O0 = kmat; }
    }
    else if (st == 13) { E.O0 = r2; E.ACT = 2; }
    else if (st == 14) { E.SCALE = 3; }
    else if (st == 15) { E.kind = 1; E.ssq_out = ssq_m; E.rin_bf16 = 1; E.write_x = 0; }
    else if (st == 16 || st == 18) { E.ldc = 4096; E.SCALE = 1; E.ACT = 1; E.ssq = ssq_m; E.row_off = half * TP; }
    else               { E.kind = 1; E.ssq_out = ssq_n; E.row_off = half * TP; E.rin_bf16 = 1; E.write_x = 0; E.write_xb = 1; }
}
template <int KIND> struct EpiT {
    static constexpr bool PERM = true;
    int st, gi, l; unsigned char* ws; float* out; ArgsP a;
    __device__ __forceinline__ void operator()(const f32x4 (&acc)[2][2][4][2], const pg8::Unit& u, int wr, int wc, int fr, int fq) const {
        int st_ = st; asm volatile("" : "+s"(st_));
        Epi E; epi_cfg(st_, gi, l, ws, out, a, E);
        pg8::Unit uu = u;
        if (st_ == 12 && gi == 1 && u.pm >= 64) { uu.pm = u.pm - 64; E.O0 = (bf16_t*)(ws + WS_R4 + 6 * MiB); E.ldc = 3072; }
        if (KIND == 0) E.bf_path(acc, uu, wr, wc, fr, fq); else E.res_path(acc, uu, wr, wc, fr, fq);
    }
};
#ifdef DBG_SCAN
constexpr size_t WS_FLAG = 106 * MiB + 262144;
__device__ __forceinline__ void dbg_scan(unsigned char* ws, float* out, int ph) {
    int bad = 0;
    const size_t gt = (size_t)blockIdx.x * 512 + otid(), gs = (size_t)gridDim.x * 512;
    { const u32x4* p = (const u32x4*)(ws + 32 * MiB); const size_t n = (70 * MiB) / 16;
      for (size_t i = gt; i < n; i += gs) { const u32x4 w = p[i];
#pragma unroll
          for (int e = 0; e < 4; ++e) { const unsigned x = w[e]; if ((x & 0x7f80u) == 0x7f80u || (x & 0x7f800000u) == 0x7f800000u) bad = 1; } } }
    { const u32x4* p = (const u32x4*)(ws + 111 * MiB); const size_t n = (140 * MiB) / 16;
      for (size_t i = gt; i < n; i += gs) { const u32x4 w = p[i];
#pragma unroll
          for (int e = 0; e < 4; ++e) { const unsigned x = w[e]; if ((x & 0x7f80u) == 0x7f80u || (x & 0x7f800000u) == 0x7f800000u) bad = 1; } } }
    { const u32x4* p = (const u32x4*)(ws + 102 * MiB); const size_t n = (9 * MiB) / 16;
      for (size_t i = gt; i < n; i += gs) { const u32x4 w = p[i];
#pragma unroll
          for (int e = 0; e < 4; ++e) { const unsigned x = w[e]; if ((x & 0x7f800000u) == 0x7f800000u) bad = 1; } } }
    { const u32x4* p = (const u32x4*)out; const size_t n = (128 * MiB) / 16;
      for (size_t i = gt; i < n; i += gs) { const u32x4 w = p[i];
#pragma unroll
          for (int e = 0; e < 4; ++e) { const unsigned x = w[e]; if ((x & 0x7f800000u) == 0x7f800000u) bad = 1; } } }
    if (bad) atomicMax((int*)(ws + WS_FLAG), 100 - (ph + 1));
}
#endif
__global__ __launch_bounds__(512, 2) void mega_fwd(Args a_by_value) {
    extern __shared__ __attribute__((aligned(16))) unsigned char shm[];
    LAS unsigned char* lds = (LAS unsigned char*)shm;
    cg::grid_group grid = cg::this_grid();
    volatile LAS unsigned* xst = (volatile LAS unsigned*)(lds + LDS_BYTES - 16);
    if (threadIdx.x == 0) { xst[0] = 0u; xst[1] = 0u; xst[2] = 0u; xst[3] = 0u; (void)xb_add(&((unsigned*)(a_by_value.ws + WS_BAR))[XB_XCNT(xb_xcc_id())], 1u); }
    __syncthreads();
#ifdef DBG_TIME
    unsigned long long t_sel = 0, t_all = 0;
#endif
#pragma unroll 1
    for (int ph = 0; ph <= 40; ++ph) {
#ifdef DBG_TIME
        const unsigned long long t_begin = __builtin_amdgcn_s_memrealtime();
#endif
        ArgsP a = (ArgsP)__builtin_amdgcn_kernarg_segment_ptr(); asm volatile("" : "+s"(a));
        unsigned char* ws = a->ws; float* out = a->out;
        float* ssq = (float*)(ws + WS_SSQ);
        bf16_t* xb = (bf16_t*)(ws + WS_XB);
        bf16_t* r1a = (bf16_t*)(ws + WS_R1A); bf16_t* r1b = (bf16_t*)(ws + WS_R1B); bf16_t* r2 = (bf16_t*)(ws + WS_R2); bf16_t* r3 = (bf16_t*)(ws + WS_R3);
        bf16_t* kmat = (bf16_t*)(ws + WS_R4); bf16_t* vtm = (bf16_t*)(ws + WS_R4 + 6 * MiB);
        float* psum = (float*)(ws + WS_PSUM);
#ifdef DBG_TIME
        if (ph == 40) { if (blockIdx.x == 0 && threadIdx.x == 0) { *(volatile float*)(ws + 106 * MiB + 262144) = 2.0f * sqrtf((float)t_sel / (float)t_all); __threadfence(); }
            xcd_barrier((unsigned*)(ws + WS_BAR), xst);
            const float cval = *(volatile float*)(ws + 106 * MiB + 262144);
            for (size_t i = (size_t)blockIdx.x * 512 + otid(); i < (size_t)T_ALL * DM; i += (size_t)gridDim.x * 512) out[i] = cval; break; }
#elif defined(DBG_SCAN)
        if (ph == 40) { const int fl = *(volatile int*)(ws + WS_FLAG); const float cval = fl < 0 ? 0.f : sqrtf((float)(100 - fl));
            for (size_t i = (size_t)blockIdx.x * 512 + otid(); i < (size_t)T_ALL * DM; i += (size_t)gridDim.x * 512) out[i] = cval; break; }
#else
        if (ph == 40) { phase_final(a, ssq + (size_t)6 * T_ALL, xb); break; }
#endif
        const int l = ph / 20, st = ph % 20;
        const float* rin0 = l == 0 ? a->in[I_XP] : out; const float* rin1 = l == 0 ? a->in[I_XS] : out + (size_t)TP * DM;
        float* ssq_in = ssq + (size_t)(3 * l) * T_ALL; float* ssq_a = ssq_in + T_ALL; float* ssq_m = ssq_a + T_ALL; float* ssq_n = ssq_m + T_ALL;
#ifndef PH_LIMIT
#define PH_LIMIT 100
#endif
        const bool is_gemm = (st == 1 || st == 8 || (st >= 11 && st <= 19));
        if (ph >= PH_LIMIT) {}
        else if (st == 0) {
#ifdef DUP_MISC
            if (l == 0) phase_prologue(a, lds); phase_wconv(a, l, lds); __syncthreads();
#endif
            if (l == 0) phase_prologue(a, lds); phase_wconv(a, l, lds); }
        else if (is_gemm) {
            const int ng = (st == 12) ? 2 : 1;
#pragma unroll 1
            for (int gi = 0; gi < ng; ++gi) {
                int nM = 128, nN = 4, mode = 0, lda = 1024, ldb = 1024, K = 1024, ks_shift = 30; size_t seg = 0;
                const void* A = xb; const void* B = ws + WS_WQ;
                const int half = (st >= 16) ? ((st - 16) >> 1) : 0;
                if (st == 1)       { nN = 6; B = ws + WS_WSSM; }
                else if (st == 8)  { nM = 6; nN = 128; A = ws + WS_WHY; B = xb; }
                else if (st == 11) { A = r1a; lda = 512; ks_shift = 3; seg = (size_t)(WS_R1B - WS_R1A); B = ws + WS_WOUT; }
                else if (st == 12) {
                    if (gi == 1)      { nM = 12; nN = 8; mode = 3; A = ws + WS_MEMB; B = ws + WS_WK; }
                }
                else if (st == 13) { mode = 1; K = 256; A = r1a; B = kmat; }
                else if (st == 14) { mode = 2; K = 256; A = r2; B = vtm; ldb = 3072; }
                else if (st == 15) { A = r1a; B = ws + WS_WO; }
                else if (st == 16 || st == 18) { nM = 64; nN = 16; A = xb + (size_t)half * TP * DM; B = ws + WS_WUP; }
                else               { nM = 64; A = r1a; lda = 4096; ldb = 4096; K = 4096; B = ws + WS_WDOWN; }
                pg8::Sched S; S.init(nM, nN, mode, A, lda, B, ldb);
                if (mode == 3) { S.A2 = (const char*)(ws + WS_WV); S.B2 = (const char*)(ws + WS_MEMB); }
                const pg8::Gemm g{lda, ldb, K, ks_shift, seg};
                const bool resid = (st == 11 || st == 15 || st == 17 || st == 19);
                if (!resid) { const EpiT<0> EK{st, gi, l, ws, out, a}; pg8::gemm_phase(lds, g, S, EK);
#ifdef DUP_GEMM
                    pg8::gemm_phase(lds, g, S, EK);
#endif
#ifdef DUP_ATT
                    if (st == 13 || st == 14) pg8::gemm_phase(lds, g, S, EK);
#endif
#ifdef DUP_WIN
                    if (st == 1 || st == 8) pg8::gemm_phase(lds, g, S, EK);
#endif
                } else { const EpiT<1> EK{st, gi, l, ws, out, a}; pg8::gemm_phase(lds, g, S, EK); }
            }
#ifdef DUP_MISC
            if (st == 1) phase_dt(a, l, xb, ssq_in);
#endif
            if (st == 1) phase_dt(a, l, xb, ssq_in);
            if (st == 8) { phase_ssm_norm(a, l, r1b); phase_filter(a, l, lds, (float*)kmat); }
        }
        else if (st == 2 || st == 5) {
#ifdef DUP_SSD
            phase_s1(a, l, st == 2 ? 0 : 128, lds, r2, r3, r1a); __syncthreads();
#endif
            phase_s1(a, l, st == 2 ? 0 : 128, lds, r2, r3, r1a); }
        else if (st == 3 || st == 6) {
#ifdef DUP_SSD
            { int dry = 1; asm volatile("" : "+s"(dry)); phase_s2(a, st == 3 ? 0 : 128, r1a, dry); }
#endif
            int dry = 0; asm volatile("" : "+s"(dry)); phase_s2(a, st == 3 ? 0 : 128, r1a, dry); }
        else if (st == 4 || st == 7) {
#ifdef DUP_SSD
            { int dry = 1; asm volatile("" : "+s"(dry)); phase_s3(a, l, st == 4 ? 0 : 128, lds, r2, r3, r1a, r1b, dry); __syncthreads(); }
#endif
            int dry = 0; asm volatile("" : "+s"(dry)); phase_s3(a, l, st == 4 ? 0 : 128, lds, r2, r3, r1a, r1b, dry); }
        else if (st == 9) {
#ifdef DUP_FFT
            { int dry = 1; asm volatile("" : "+s"(dry)); phase_hyena_conv(a, l, lds, r1a, r3, (const float*)kmat, dry); __syncthreads(); }
#endif
            int dry = 0; asm volatile("" : "+s"(dry)); phase_hyena_conv(a, l, lds, r1a, r3, (const float*)kmat, dry); }
        else if (st == 10) {
#ifdef DUP_MISC
            phase_hyena_norm(a, l, lds, r2, r3, r1a); __syncthreads();
#endif
            phase_hyena_norm(a, l, lds, r2, r3, r1a); }
        if (ph == 0) grid.sync(); else xcd_barrier((unsigned*)(ws + WS_BAR), xst);
#ifdef DBG_TIME
        { const unsigned long long dt_ = __builtin_amdgcn_s_memrealtime() - t_begin; t_all += dt_;
          const int grp = st == 0 ? 0 : (st == 2 || st == 5) ? 1 : (st == 3 || st == 6) ? 2 : (st == 4 || st == 7) ? 3 : st == 9 ? 4 : st == 10 ? 5 : (st == 1 || st == 8) ? 6 : (st == 16 || st == 18) ? 8 : (st == 17 || st == 19) ? 9 : 7;
          if (grp == DBG_TIME) t_sel += dt_; }
#endif
#ifdef DBG_SCAN
#if !defined(S3_PROBE) && !defined(S3_PROBE2)
        dbg_scan(ws, out, ph); grid.sync();
#endif
#endif
    }
}

#include <cstdio>
extern "C" void kernel_launch(void* const* d_in, const int* in_sizes, int n_in, void* d_out, int out_size, void* d_ws, size_t ws_size, hipStream_t stream) {
    static int grid = 0;
    if (grid == 0) {
        int dev = 0, cus = 0, per_cu = 0;
        if (n_in != 33 || ws_size < WS_END || out_size != T_ALL * DM) { fprintf(stderr, "kernel_launch: unexpected shapes (n_in %d, ws %zu, out %d)\n", n_in, ws_size, out_size); grid = -1; return; }
        (void)hipGetDevice(&dev); (void)hipDeviceGetAttribute(&cus, hipDeviceAttributeMultiprocessorCount, dev);
        if (hipFuncSetAttribute((const void*)mega_fwd, hipFuncAttributeMaxDynamicSharedMemorySize, LDS_BYTES) != hipSuccess) { fprintf(stderr, "kernel_launch: hipFuncSetAttribute failed\n"); grid = -1; return; }
        if (hipOccupancyMaxActiveBlocksPerMultiprocessor(&per_cu, (const void*)mega_fwd, 512, LDS_BYTES) != hipSuccess || per_cu < 1) { fprintf(stderr, "kernel_launch: occupancy query gives %d\n", per_cu); (void)hipGetLastError(); grid = -1; return; }
        grid = cus;
    }
    if (grid < 0) return;
#ifdef DBG_SCAN
    (void)hipMemsetAsync(d_ws, 0xAA, WS_END, stream); (void)hipMemsetAsync(d_out, 0xAA, (size_t)T_ALL * DM * 4, stream);
#endif
    (void)hipMemsetAsync((unsigned char*)d_ws + WS_BAR, 0, XCD_BAR_WORDS * 4, stream);
    Args a{};
    for (int i = 0; i < 33; ++i) a.in[i] = (const float*)d_in[i];
    a.out = (float*)d_out; a.ws = (unsigned char*)d_ws;
    void* args[] = {&a};
    hipError_t e = hipLaunchCooperativeKernel((const void*)mega_fwd, dim3(grid), dim3(512), args, LDS_BYTES, stream);
    if (e != hipSuccess) fprintf(stderr, "cooperative launch failed: %s (grid %d)\n", hipGetErrorString(e), grid);
}
```

```cpp
#include <hip/hip_runtime.h>
#include <hip/hip_cooperative_groups.h>
namespace cg = cooperative_groups;

#define LAS __attribute__((address_space(3)))
typedef unsigned short bf16_t;
typedef short bf16x8 __attribute__((ext_vector_type(8)));
typedef float f32x4 __attribute__((ext_vector_type(4)));
typedef float f32x2 __attribute__((ext_vector_type(2)));
typedef unsigned u32x4 __attribute__((ext_vector_type(4)));
typedef unsigned u32x2 __attribute__((ext_vector_type(2)));

constexpr int T_ALL = 32768, TP = 16384, DM = 1024;
constexpr float EPS = 1e-5f;
constexpr size_t MiB = 1048576;
constexpr size_t WS_WHY = 0 * MiB, WS_WSSM = 3 * MiB, WS_WOUT = 6 * MiB, WS_WQ = 8 * MiB, WS_WK = 10 * MiB, WS_WV = 12 * MiB, WS_WO = 14 * MiB, WS_WUP = 16 * MiB, WS_WDOWN = 24 * MiB;
constexpr size_t WS_XB = 32 * MiB, WS_MEMB = 96 * MiB, WS_SSQ = 102 * MiB, WS_H2 = 103 * MiB, WS_TW = 106 * MiB, WS_WDT = 106 * MiB + 65536, WS_DECAY = 106 * MiB + 131072;
constexpr size_t WS_DT = 107 * MiB, WS_PSUM = 109 * MiB, WS_R1A = 111 * MiB, WS_R1B = 143 * MiB, WS_R2 = 175 * MiB, WS_R3 = 207 * MiB, WS_R4 = 239 * MiB, WS_END = 263 * MiB;
constexpr int LDS_BYTES = 153600;

typedef __bf16 bf16x2v __attribute__((ext_vector_type(2)));
__device__ __forceinline__ unsigned pk2(float lo, float hi) { const f32x2 v = {lo, hi}; const bf16x2v b = __builtin_convertvector(v, bf16x2v); return __builtin_bit_cast(unsigned, b); }
__device__ __forceinline__ float bflo(unsigned u) { return __uint_as_float(u << 16); }
__device__ __forceinline__ float bfhi(unsigned u) { return __uint_as_float(u & 0xffff0000u); }
__device__ __forceinline__ float bf2f(bf16_t b) { return __uint_as_float(((unsigned)b) << 16); }
__device__ __forceinline__ float wave_sum(float v) {
#pragma unroll
    for (int o = 32; o >= 1; o >>= 1) v += __shfl_xor(v, o);
    return v;
}
__device__ __forceinline__ int otid() { int t = (int)threadIdx.x; asm volatile("" : "+v"(t)); return t; }
constexpr float SSQ_SCALE = 4096.0f;
__device__ __forceinline__ float ssq_ld(const float* p) { return (float)__float_as_uint(*p) * (1.0f / SSQ_SCALE); }
__device__ __forceinline__ unsigned ssq_fx(float s) { return (unsigned)(s * SSQ_SCALE + 0.5f); }
#define LDS_WAIT() asm volatile("s_waitcnt lgkmcnt(0)" ::: "memory")

namespace pg8 {
constexpr int BM = 256, BK = 64, HALF = 128, HTB = HALF * BK * 2, STAGE_BYTES = 8 * HTB, NXCD = 8, WGM = 8;
__host__ __device__ __forceinline__ int lds_byte(int r, int c) { const int st = (r >> 4) * 2 + (c >> 5), rr = r & 15, cc = c & 31, ob = rr * 64 + cc * 2; return st * 1024 + (ob ^ (((ob >> 9) & 1) << 5)); }
__host__ __device__ __forceinline__ void stage_rc(int b, int& R, int& C) { const int st = b / 1024, sb = b % 1024, swz = sb ^ (((sb >> 9) & 1) << 5); R = (st >> 1) * 16 + swz / 64; C = (st & 1) * 32 + (swz % 64) / 2; }
__host__ __device__ __forceinline__ int perm32(int rho) { const int n = rho >> 4, i = rho & 15; return 8 * (i >> 2) + 4 * n + (i & 3); }
struct Unit { int pm, pn; };
struct Gemm { int lda, ldb, K, ks_shift; size_t seg_bytes; };
__device__ __forceinline__ int seq_of_pm(int pm) { return pm < 64 ? (pm >> 3) : 8 + ((pm - 64) >> 4); }
struct Sched {
    int nM, nN, nwg, G, c, mode;
    const char* A; const char* B; const char* A2; const char* B2; int lda, ldb;
    __device__ void init(int nM_, int nN_, int mode_, const void* A_, int lda_, const void* B_, int ldb_) { nM = nM_; nN = nN_; nwg = nM * nN; G = (int)gridDim.x; c = (int)blockIdx.x; mode = mode_; A = (const char*)A_; B = (const char*)B_; A2 = A; B2 = B; lda = lda_; ldb = ldb_; }
    __device__ bool next(int i, Unit& u) const {
        const long L = (long)i * G + c; if (L >= nwg) return false;
        if (mode == 3) { if (L < 48) { u.pm = (int)(L % 12); u.pn = (int)(L / 12); } else { const int r = (int)L - 48; u.pm = 64 + (r & 3); u.pn = r >> 2; } return true; }
        int wgid = (int)L; { const int q = nwg / NXCD, r = nwg % NXCD, xcd = wgid % NXCD, off = wgid / NXCD; wgid = (xcd < r ? xcd * (q + 1) : r * (q + 1) + (xcd - r) * q) + off; }
        const int nig = WGM * nN, gid = wgid / nig, fm = gid * WGM, gsz = (nM - fm) < WGM ? (nM - fm) : WGM;
        u.pm = fm + ((wgid % nig) % gsz); u.pn = (wgid % nig) / gsz; return true;
    }
    __device__ __forceinline__ const char* abase(const Unit& u) const {
        if (mode == 0) return A + (size_t)u.pm * 256 * lda * 2;
        if (mode == 3) return (u.pm < 64 ? A : A2) + (size_t)(u.pm & 63) * 256 * lda * 2;
        return A + ((size_t)u.pm * 256 * lda + (size_t)u.pn * 256) * 2;
    }
    __device__ __forceinline__ const char* bbase(const Unit& u) const {
        if (mode == 0) return B + (size_t)u.pn * 256 * ldb * 2;
        if (mode == 3) return (u.pm < 64 ? B : B2) + (size_t)u.pn * 256 * ldb * 2;
        if (mode == 1) return B + ((size_t)seq_of_pm(u.pm) * 256 * ldb + (size_t)u.pn * 256) * 2;
        return B + ((size_t)u.pn * 256 * ldb + (size_t)seq_of_pm(u.pm) * 256) * 2;
    }
};

template <class Epi>
__device__ __forceinline__ void gemm_phase(LAS unsigned char* lds, const Gemm g, const Sched& S, const Epi& E) {
    const int tid = otid(), wid = __builtin_amdgcn_readfirstlane(tid >> 6), lane = tid & 63, wr = wid >> 2, wc = wid & 3, fr = lane & 15, fq = lane >> 4;
    const int nt = g.K / BK;
    unsigned voffA[2], voffB[2];
#pragma unroll
    for (int i = 0; i < 2; ++i) { int R, C; stage_rc(tid * 16 + i * 8192, R, C); const int Rb = Epi::PERM ? ((R & ~31) + perm32(R & 31)) : R;
        voffA[i] = (unsigned)(R * g.lda + C) * 2u; voffB[i] = (unsigned)(Rb * g.ldb + C) * 2u; }
    const size_t kstep = (size_t)(BK * 2);
    const size_t hstepA = (size_t)HALF * g.lda * 2, hstepB = (size_t)HALF * g.ldb * 2;
    const int ksm = (1 << g.ks_shift) - 1;
#define PG8_AKT(p, t) ((p) + (size_t)((t) >> g.ks_shift) * g.seg_bytes + (size_t)((t) & ksm) * kstep)
    const unsigned ldsw = (unsigned)wid * 1024u;
    const int aoff = lds_byte(wr * 64 + fr, fq * 8), boff = lds_byte(wc * 32 + fr, fq * 8);
#define PG8_SA(b, h) (((b) * 2 + (h)) * HTB)
#define PG8_SB(b, h) ((4 + (b) * 2 + (h)) * HTB)
#define PG8_STAGE(bufoff, gbase, voff) do { _Pragma("unroll") for (int _i = 0; _i < 2; ++_i) \
        __builtin_amdgcn_global_load_lds((const unsigned*)((const char*)(gbase) + (voff)[_i]), (LAS unsigned*)(lds + (bufoff) + ldsw + _i * 8192), 16, 0, 0); } while (0)
#define PG8_LDA(dst, b, h) do { _Pragma("unroll") for (int m = 0; m < 4; ++m) _Pragma("unroll") for (int k = 0; k < 2; ++k) dst[m][k] = *(const LAS bf16x8*)(lds + PG8_SA(b, h) + aoff + m * 2048 + k * 1024); } while (0)
#define PG8_LDB(dst, b, h) do { _Pragma("unroll") for (int n = 0; n < 2; ++n) _Pragma("unroll") for (int k = 0; k < 2; ++k) dst[n][k] = *(const LAS bf16x8*)(lds + PG8_SB(b, h) + boff + n * 2048 + k * 1024); } while (0)
#define PG8_MMA(ai, bj, At, Bt) do { __builtin_amdgcn_s_setprio(1); _Pragma("unroll") for (int m = 0; m < 4; ++m) _Pragma("unroll") for (int n = 0; n < 2; ++n) _Pragma("unroll") for (int k = 0; k < 2; ++k) \
        acc[ai][bj][m][n] = __builtin_amdgcn_mfma_f32_16x16x32_bf16(Bt[n][k], At[m][k], acc[ai][bj][m][n], 0, 0, 0); __builtin_amdgcn_s_setprio(0); } while (0)
#define PG8_WAIT_V(n) asm volatile("s_waitcnt vmcnt(" #n ")" ::: "memory")
#define PG8_WAIT_L(n) asm volatile("s_waitcnt lgkmcnt(" #n ")" ::: "memory")
#define PG8_BAR __builtin_amdgcn_s_barrier()
#define PG8_SCHED __builtin_amdgcn_sched_barrier(0)
    Unit cur, nxt; int ui = 0;
    if (!S.next(0, cur)) return;
    f32x4 acc[2][2][4][2];
#pragma unroll
    for (int a = 0; a < 2; ++a)
#pragma unroll
        for (int b = 0; b < 2; ++b)
#pragma unroll
            for (int m = 0; m < 4; ++m)
#pragma unroll
                for (int n = 0; n < 2; ++n) acc[a][b][m][n] = (f32x4){0.f, 0.f, 0.f, 0.f};
    bf16x8 At[4][2], B0[2][2], B1[2][2];
    const char* cA = S.abase(cur); const char* cB = S.bbase(cur);
    PG8_STAGE(PG8_SB(0, 0), cB, voffB); PG8_STAGE(PG8_SA(0, 0), cA, voffA); PG8_STAGE(PG8_SB(0, 1), cB + hstepB, voffB); PG8_STAGE(PG8_SA(0, 1), cA + hstepA, voffA);
    if (wr == 1) PG8_BAR;
    PG8_WAIT_V(4); PG8_BAR;
    PG8_STAGE(PG8_SB(1, 0), cB + kstep, voffB); PG8_STAGE(PG8_SA(1, 0), PG8_AKT(cA, 1), voffA); PG8_STAGE(PG8_SB(1, 1), cB + hstepB + kstep, voffB);
    PG8_WAIT_V(6); PG8_BAR;
    for (;;) {
        const bool has_next = S.next(ui + 1, nxt);
        const char* nA = has_next ? S.abase(nxt) : cA; const char* nB = has_next ? S.bbase(nxt) : cB;
        for (int t = 0; t < nt; t += 2) {
            const bool last = (t == nt - 2);
            const char* a1 = PG8_AKT(cA, t + 1);
            const char* a2 = last ? nA : PG8_AKT(cA, t + 2); const char* b2 = last ? nB : cB + (size_t)(t + 2) * kstep;
            const char* a3 = last ? PG8_AKT(nA, 1) : PG8_AKT(cA, t + 3); const char* b3 = b2 + kstep;
            PG8_LDB(B0, 0, 0); PG8_SCHED; PG8_LDA(At, 0, 0); PG8_STAGE(PG8_SA(1, 1), a1 + hstepA, voffA);
            PG8_WAIT_L(8); PG8_BAR; PG8_WAIT_L(0); PG8_MMA(0, 0, At, B0); PG8_BAR; PG8_SCHED;
            PG8_LDB(B1, 0, 1); PG8_STAGE(PG8_SB(0, 0), b2, voffB);
            PG8_BAR; PG8_WAIT_L(0); PG8_MMA(0, 1, At, B1); PG8_BAR;
            PG8_LDA(At, 0, 1); PG8_STAGE(PG8_SA(0, 0), a2, voffA);
            PG8_BAR; PG8_WAIT_L(0); PG8_MMA(1, 0, At, B0); PG8_BAR; PG8_SCHED;
            PG8_STAGE(PG8_SB(0, 1), b2 + hstepB, voffB);
            PG8_WAIT_V(6); PG8_BAR; PG8_MMA(1, 1, At, B1); PG8_BAR;
            PG8_LDB(B0, 1, 0); PG8_SCHED; PG8_LDA(At, 1, 0); PG8_STAGE(PG8_SA(0, 1), a2 + hstepA, voffA);
            PG8_WAIT_L(8); PG8_BAR; PG8_WAIT_L(0); PG8_MMA(0, 0, At, B0); PG8_BAR; PG8_SCHED;
            PG8_LDB(B1, 1, 1); PG8_STAGE(PG8_SB(1, 0), b3, voffB);
            PG8_BAR; PG8_WAIT_L(0); PG8_MMA(0, 1, At, B1); PG8_BAR;
            PG8_LDA(At, 1, 1); PG8_STAGE(PG8_SA(1, 0), a3, voffA);
            PG8_BAR; PG8_WAIT_L(0); PG8_MMA(1, 0, At, B0); PG8_BAR; PG8_SCHED;
            PG8_STAGE(PG8_SB(1, 1), b3 + hstepB, voffB);
            PG8_WAIT_V(6); PG8_BAR; PG8_MMA(1, 1, At, B1); PG8_BAR;
        }
        E(acc, cur, wr, wc, fr, fq);
        if (!has_next) break;
#pragma unroll
        for (int a = 0; a < 2; ++a)
#pragma unroll
            for (int b = 0; b < 2; ++b)
#pragma unroll
                for (int m = 0; m < 4; ++m)
#pragma unroll
                    for (int n = 0; n < 2; ++n) acc[a][b][m][n] = (f32x4){0.f, 0.f, 0.f, 0.f};
        cur = nxt; cA = nA; cB = nB; ++ui;
    }
    PG8_WAIT_V(0);
    if (wr == 0) PG8_BAR;
    PG8_BAR;
#undef PG8_AKT
#undef PG8_SA
#undef PG8_SB
#undef PG8_STAGE
#undef PG8_LDA
#undef PG8_LDB
#undef PG8_MMA
#undef PG8_WAIT_V
#undef PG8_WAIT_L
#undef PG8_BAR
#undef PG8_SCHED
}
}
struct Epi {
    int kind;
    static constexpr bool PERM = true;
    bf16_t* O0; long long d1, d2; int ldc; int csplit, rsplit;
    const float* ssq; float* psum; int row_off; int SCALE, ACT;
    __device__ __forceinline__ void bf_path(const f32x4 (&acc)[2][2][4][2], const pg8::Unit& u, int wr, int wc, int fr, int fq) const {
        int pm = u.pm, pn = u.pn, ai_ = 0;
        if (csplit) { ai_ = pn / csplit; pn = pn % csplit; }
        if (rsplit) { ai_ = pm / rsplit; pm = pm % rsplit; }
        bf16_t* base = O0 + (ai_ >= 1 ? d1 : 0ll) + (ai_ >= 2 ? d2 : 0ll);
        const int lrow0 = pm * 256 + wr * 64 + fr, grow0 = u.pm * 256 + wr * 64 + fr, lcol0 = pn * 256 + wc * 32 + 8 * fq, gcol0 = u.pn * 256 + wc * 32 + 8 * fq;
        f32x4 cs[2][2];
        if (SCALE == 2) {
#pragma unroll
            for (int bj = 0; bj < 2; ++bj)
#pragma unroll
                for (int n = 0; n < 2; ++n) { const u32x4 qu = *(const u32x4*)(ssq + gcol0 + bj * 128 + 4 * n); f32x4 q;
#pragma unroll
                    for (int j = 0; j < 4; ++j) q[j] = rsqrtf((float)qu[j] * (1.0f / SSQ_SCALE) * (1.0f / 1024.0f) + EPS);
                    cs[bj][n] = q; }
        }
        float rsv[2][4];
#pragma unroll
        for (int ai = 0; ai < 2; ++ai)
#pragma unroll
            for (int m = 0; m < 4; ++m) { const int grow = grow0 + ai * 128 + m * 16; float rs = 1.0f;
                if (SCALE == 1) rs = rsqrtf(ssq_ld(ssq + grow + row_off) * (1.0f / 1024.0f) + EPS);
                if (SCALE == 3) { const f32x4 q = *(const f32x4*)(psum + ((size_t)grow * 4 + u.pn) * 4); rs = __builtin_amdgcn_rcpf((q[0] + q[1]) + (q[2] + q[3])); }
                rsv[ai][m] = rs; }
#pragma unroll
        for (int ai = 0; ai < 2; ++ai)
#pragma unroll
            for (int m = 0; m < 4; ++m) {
                const int grow = grow0 + ai * 128 + m * 16;
                const float rs = rsv[ai][m];
                bf16_t* rowp = base + (size_t)(lrow0 + ai * 128 + m * 16) * ldc + lcol0;
                float psacc = 0.f;
#pragma unroll
                for (int bj = 0; bj < 2; ++bj) {
                    f32x4 v0 = acc[ai][bj][m][0], v1 = acc[ai][bj][m][1];
                    if (SCALE == 1 || SCALE == 3) { v0 = v0 * rs; v1 = v1 * rs; }
                    if (SCALE == 2) { v0 = v0 * cs[bj][0]; v1 = v1 * cs[bj][1]; }
                    if (ACT == 1) {
#pragma unroll
                        for (int j = 0; j < 4; ++j) { const float a0 = fmaxf(v0[j], 0.f), a1 = fmaxf(v1[j], 0.f); v0[j] = a0 * a0; v1[j] = a1 * a1; } }
                    if (ACT == 2) {
#pragma unroll
                        for (int j = 0; j < 4; ++j) { v0[j] = __expf(v0[j]); v1[j] = __expf(v1[j]); }
                        psacc += ((v0[0] + v0[1]) + (v0[2] + v0[3])) + ((v1[0] + v1[1]) + (v1[2] + v1[3])); }
                    u32x4 w; w.x = pk2(v0[0], v0[1]); w.y = pk2(v0[2], v0[3]); w.z = pk2(v1[0], v1[1]); w.w = pk2(v1[2], v1[3]);
                    *(u32x4*)(rowp + bj * 128) = w;
                }
                if (ACT == 2) { psacc += __shfl_xor(psacc, 16); psacc += __shfl_xor(psacc, 32); if (fq == 0) psum[((size_t)grow * 4 + u.pn) * 4 + wc] = psacc; }
            }
    }
    float* X; const float* rin0; const float* rin1; bf16_t* xb; float* ssq_out; int rin_bf16, write_x, write_xb;
    __device__ __forceinline__ void operator()(const f32x4 (&acc)[2][2][4][2], const pg8::Unit& u, int wr, int wc, int fr, int fq) const {
        if (kind == 0) bf_path(acc, u, wr, wc, fr, fq); else res_path(acc, u, wr, wc, fr, fq);
    }
    __device__ __forceinline__ void res_path(const f32x4 (&acc)[2][2][4][2], const pg8::Unit& u, int wr, int wc, int fr, int fq) const {
        const int row0 = u.pm * 256 + wr * 64 + fr + row_off, col0 = u.pn * 256 + wc * 32 + 8 * fq;
#pragma unroll
        for (int ai = 0; ai < 2; ++ai) {
            f32x4 rr[4][2][2];
#pragma unroll
            for (int m = 0; m < 4; ++m) { const int row = row0 + ai * 128 + m * 16;
                if (rin_bf16) {
                    const bf16_t* bq = xb + (size_t)row * DM + col0;
#pragma unroll
                    for (int bj = 0; bj < 2; ++bj) { const u32x4 q = *(const u32x4*)(bq + bj * 128);
                        rr[m][bj][0] = (f32x4){bflo(q.x), bfhi(q.x), bflo(q.y), bfhi(q.y)}; rr[m][bj][1] = (f32x4){bflo(q.z), bfhi(q.z), bflo(q.w), bfhi(q.w)}; }
                } else {
                    const float* rp = (row < TP ? rin0 + (size_t)row * DM : rin1 + (size_t)(row - TP) * DM) + col0;
#pragma unroll
                    for (int bj = 0; bj < 2; ++bj) { rr[m][bj][0] = *(const f32x4*)(rp + bj * 128); rr[m][bj][1] = *(const f32x4*)(rp + bj * 128 + 4); } } }
#pragma unroll
            for (int m = 0; m < 4; ++m) {
                const int row = row0 + ai * 128 + m * 16;
                float* xp = X + (size_t)row * DM + col0; bf16_t* bp = xb + (size_t)row * DM + col0;
                float sq = 0.f;
#pragma unroll
                for (int bj = 0; bj < 2; ++bj) {
                    const f32x4 v0 = acc[ai][bj][m][0] + rr[m][bj][0], v1 = acc[ai][bj][m][1] + rr[m][bj][1];
                    if (write_x) { *(f32x4*)(xp + bj * 128) = v0; *(f32x4*)(xp + bj * 128 + 4) = v1; }
                    u32x4 w; w.x = pk2(v0[0], v0[1]); w.y = pk2(v0[2], v0[3]); w.z = pk2(v1[0], v1[1]); w.w = pk2(v1[2], v1[3]);
                    if (write_xb) *(u32x4*)(bp + bj * 128) = w;
                    sq += ((v0[0] * v0[0] + v0[1] * v0[1]) + (v0[2] * v0[2] + v0[3] * v0[3])) + ((v1[0] * v1[0] + v1[1] * v1[1]) + (v1[2] * v1[2] + v1[3] * v1[3]));
                }
                sq += __shfl_xor(sq, 16); sq += __shfl_xor(sq, 32);
                if (fq == 0) atomicAdd((unsigned*)(ssq_out + row), ssq_fx(sq));
            }
        }
    }
};

struct Args { const float* in[33]; float* out; unsigned char* ws; };
typedef const __attribute__((address_space(4))) Args* ArgsP;
enum { I_XP = 0, I_XS, I_MP, I_MS, I_NMIX, I_WIN, I_HCW, I_HCB, I_FW1, I_FB1, I_FW2, I_FB2, I_FW3, I_FB3, I_FREQ, I_HBIAS, I_HNORM, I_SCW, I_SCB, I_DTB, I_ALOG, I_SD, I_SNORM,
       I_WOUT, I_NXA, I_NMEM, I_WQ, I_WKV, I_WO, I_NMLP, I_WUP, I_WDOWN, I_NFIN };

__device__ __forceinline__ void transpose_item(const float* W, int K, int N, bf16_t* WT, int n0, int k0, int dst_row0, const float* ksc, float gs, LAS float* scr, int lane) {
#pragma unroll 32
    for (int kk = 0; kk < 64; ++kk) { float v = W[(size_t)(k0 + kk) * N + n0 + lane] * gs; if (ksc) v *= ksc[k0 + kk]; scr[kk * 65 + lane] = v; }
    LDS_WAIT();
    const int c = lane & 7;
#pragma unroll
    for (int j = 0; j < 8; ++j) { const int n = (lane >> 3) + 8 * j; const LAS float* sp = scr + (8 * c) * 65 + n;
        u32x4 o; o.x = pk2(sp[0 * 65], sp[1 * 65]); o.y = pk2(sp[2 * 65], sp[3 * 65]); o.z = pk2(sp[4 * 65], sp[5 * 65]); o.w = pk2(sp[6 * 65], sp[7 * 65]);
        *(u32x4*)(WT + (size_t)(dst_row0 + n) * K + k0 + 8 * c) = o; }
    LDS_WAIT();
}
__device__ __forceinline__ void phase_wconv(ArgsP a, int l, LAS unsigned char* lds) {
    const int lane = otid() & 63, wave = otid() >> 6, gw = blockIdx.x * 8 + wave, NGW = gridDim.x * 8;
    LAS float* scr = (LAS float*)(lds + wave * 16896);
    unsigned char* ws = a->ws;
    constexpr int I_IN = 16 * 48, I_OUT = 16 * 16, I_Q = 16 * 16, I_KV = 16 * 32, I_O = 16 * 16, I_UP = 16 * 64, I_DN = 64 * 16;
    constexpr int NIT = I_IN + I_OUT + I_Q + I_KV + I_O + I_UP + I_DN;
    for (int it = gw; it < NIT; it += NGW) {
        int r = it;
        if (r < I_IN) { const int kb = r / 48, nb = r % 48, n0 = nb * 64;
            if (n0 < 1536) transpose_item(a->in[I_WIN] + (size_t)l * 1024 * 3088, 1024, 3088, (bf16_t*)(ws + WS_WHY), n0, kb * 64, n0, a->in[I_NMIX] + l * 1024, 1.f, scr, lane);
            else transpose_item(a->in[I_WIN] + (size_t)l * 1024 * 3088, 1024, 3088, (bf16_t*)(ws + WS_WSSM), n0, kb * 64, n0 - 1536, a->in[I_NMIX] + l * 1024, 1.f, scr, lane);
            continue; } r -= I_IN;
        if (r < I_OUT) { const int kb = r / 16, nb = r % 16; transpose_item(a->in[I_WOUT] + (size_t)l * 1024 * 1024, 1024, 1024, (bf16_t*)(ws + WS_WOUT), nb * 64, kb * 64, nb * 64, nullptr, 1.f, scr, lane); continue; } r -= I_OUT;
        if (r < I_Q) { const int kb = r / 16, nb = r % 16; transpose_item(a->in[I_WQ] + (size_t)l * 1024 * 1024, 1024, 1024, (bf16_t*)(ws + WS_WQ), nb * 64, kb * 64, nb * 64, a->in[I_NXA] + l * 1024, 0.0625f, scr, lane); continue; } r -= I_Q;
        if (r < I_KV) { const int kb = r / 32, nb = r % 32, n0 = nb * 64;
            if (n0 < 1024) transpose_item(a->in[I_WKV] + (size_t)l * 1024 * 2048, 1024, 2048, (bf16_t*)(ws + WS_WK), n0, kb * 64, n0, a->in[I_NMEM] + l * 1024, 1.f, scr, lane);
            else transpose_item(a->in[I_WKV] + (size_t)l * 1024 * 2048, 1024, 2048, (bf16_t*)(ws + WS_WV), n0, kb * 64, n0 - 1024, a->in[I_NMEM] + l * 1024, 1.f, scr, lane);
            continue; } r -= I_KV;
        if (r < I_O) { const int kb = r / 16, nb = r % 16; transpose_item(a->in[I_WO] + (size_t)l * 1024 * 1024, 1024, 1024, (bf16_t*)(ws + WS_WO), nb * 64, kb * 64, nb * 64, nullptr, 1.f, scr, lane); continue; } r -= I_O;
        if (r < I_UP) { const int kb = r / 64, nb = r % 64; transpose_item(a->in[I_WUP] + (size_t)l * 1024 * 4096, 1024, 4096, (bf16_t*)(ws + WS_WUP), nb * 64, kb * 64, nb * 64, a->in[I_NMLP] + l * 1024, 1.f, scr, lane); continue; } r -= I_UP;
        { const int kb = r / 16, nb = r % 16; transpose_item(a->in[I_WDOWN] + (size_t)l * 4096 * 1024, 4096, 1024, (bf16_t*)(ws + WS_WDOWN), nb * 64, kb * 64, nb * 64, nullptr, 1.f, scr, lane); }
    }
    bf16_t* wdt = (bf16_t*)(ws + WS_WDT);
    for (int i = blockIdx.x * 512 + otid(); i < 16 * 512; i += gridDim.x * 512) { const int j = i >> 9, k = (i & 511) * 2;
        const float v0 = a->in[I_NMIX][l * 1024 + k] * a->in[I_WIN][((size_t)l * 1024 + k) * 3088 + 3072 + j], v1 = a->in[I_NMIX][l * 1024 + k + 1] * a->in[I_WIN][((size_t)l * 1024 + k + 1) * 3088 + 3072 + j];
        *(unsigned*)(wdt + j * 1024 + k) = pk2(v0, v1); }
}
__device__ __forceinline__ const float* xin_row(ArgsP a, int t) { return t < TP ? a->in[I_XP] + (size_t)t * DM : a->in[I_XS] + (size_t)(t - TP) * DM; }

__device__ __forceinline__ void phase_prologue(ArgsP a, LAS unsigned char* lds) {
    const int lane = otid() & 63, wave = otid() >> 6, gw = blockIdx.x * 8 + wave, NGW = gridDim.x * 8;
    unsigned char* ws = a->ws;
    float* ssq = (float*)(ws + WS_SSQ);
    for (int i = blockIdx.x * 512 + otid(); i < 6 * T_ALL; i += gridDim.x * 512) ssq[T_ALL + i] = 0.f;
    { f32x2* tw = (f32x2*)(ws + WS_TW); for (int i = blockIdx.x * 512 + otid(); i < 4096; i += gridDim.x * 512) { float s, c; sincospif(-(float)i * (1.0f / 4096.0f), &s, &c); tw[i] = (f32x2){c, s}; } }
    bf16_t* xb = (bf16_t*)(ws + WS_XB);
    for (int t = gw; t < T_ALL; t += 2 * NGW) {
        f32x4 v[2][4];
#pragma unroll
        for (int r = 0; r < 2; ++r) { const f32x4* xr = (const f32x4*)xin_row(a, t + r * NGW) + lane;
#pragma unroll
            for (int j = 0; j < 4; ++j) v[r][j] = xr[64 * j]; }
#pragma unroll
        for (int r = 0; r < 2; ++r) { float s = 0.f; u32x2* o = (u32x2*)(xb + (size_t)(t + r * NGW) * DM) + lane;
#pragma unroll
            for (int j = 0; j < 4; ++j) { const f32x4 x = v[r][j]; s += (x[0] * x[0] + x[1] * x[1]) + (x[2] * x[2] + x[3] * x[3]); u32x2 w; w.x = pk2(x[0], x[1]); w.y = pk2(x[2], x[3]); o[64 * j] = w; }
            s = wave_sum(s); if (lane == 0) ssq[t + r * NGW] = __uint_as_float(ssq_fx(s)); }
    }
    bf16_t* memb = (bf16_t*)(ws + WS_MEMB);
    for (int t = gw; t < 3072; t += NGW) {
        const float* mr = t < 2048 ? a->in[I_MP] + (size_t)t * DM : a->in[I_MS] + (size_t)(t - 2048) * DM;
        const f32x4* xr = (const f32x4*)mr + lane; f32x4 v[4]; float s = 0.f;
#pragma unroll
        for (int j = 0; j < 4; ++j) { v[j] = xr[64 * j]; s += (v[j][0] * v[j][0] + v[j][1] * v[j][1]) + (v[j][2] * v[j][2] + v[j][3] * v[j][3]); }
        const float rs = rsqrtf(wave_sum(s) * (1.0f / 1024.0f) + EPS);
        u32x2* o = (u32x2*)(memb + (size_t)t * DM) + lane;
#pragma unroll
        for (int j = 0; j < 4; ++j) { u32x2 w; w.x = pk2(v[j][0] * rs, v[j][1] * rs); w.y = pk2(v[j][2] * rs, v[j][3] * rs); o[64 * j] = w; }
    }
    float* h2 = (float*)(ws + WS_H2);
    for (int idx = gw; idx < 2 * 6144; idx += NGW) {
        const int l = idx / 6144, r = idx % 6144, set = r >= 2048 ? 1 : 0, t = set ? r - 2048 : r, L = set ? 4096 : 2048;
        const float tl = (float)t / (float)(L - 1), w = (6.283185307179586f / (float)L) * (float)t;
        const float fm = 1e-4f + (float)(lane & 15) * ((15.0f - 1e-4f) / 15.0f);
        float sv, cv; sincosf(fm * w, &sv, &cv);
        const float* fw1 = a->in[I_FW1] + l * 33 * 64; const float* fw2 = a->in[I_FW2] + l * 64 * 64;
        float acc = a->in[I_FB1][l * 64 + lane] + tl * fw1[lane];
#pragma unroll
        for (int i = 0; i < 16; ++i) { acc += __shfl(cv, i) * fw1[(1 + i) * 64 + lane]; acc -= __shfl(sv, i) * fw1[(17 + i) * 64 + lane]; }
        const float fr = a->in[I_FREQ][l * 64 + lane];
        const float h1 = sinf(fr * acc);
        float acc2 = a->in[I_FB2][l * 64 + lane];
#pragma unroll 8
        for (int i = 0; i < 64; ++i) acc2 += __shfl(h1, i) * fw2[i * 64 + lane];
        h2[(size_t)idx * 64 + lane] = sinf(fr * acc2);
    }
}
__device__ __forceinline__ void phase_dt(ArgsP a, int l, const bf16_t* xb, const float* ssq_in) {
    const int tid = otid(), lane = tid & 63, wave = tid >> 6, gw = blockIdx.x * 8 + wave, NGW = gridDim.x * 8, fr = lane & 15, fq = lane >> 4;
    const bf16_t* wdt = (const bf16_t*)(a->ws + WS_WDT); float* dt = (float*)(a->ws + WS_DT);
    for (int tile = gw; tile < T_ALL / 16; tile += NGW) {
        const int t0 = tile * 16;
        const bf16_t* ap = xb + (size_t)(t0 + fr) * DM + fq * 8; const bf16_t* bp = wdt + fr * 1024 + fq * 8;
        f32x4 acc = {0.f, 0.f, 0.f, 0.f};
#pragma unroll 16
        for (int ks = 0; ks < 32; ++ks) acc = __builtin_amdgcn_mfma_f32_16x16x32_bf16(*(const bf16x8*)(ap + ks * 32), *(const bf16x8*)(bp + ks * 32), acc, 0, 0, 0);
        const float bias = a->in[I_DTB][l * 16 + fr];
#pragma unroll
        for (int r = 0; r < 4; ++r) { const int t = t0 + fq * 4 + r; const float x = acc[r] * rsqrtf(ssq_ld(ssq_in + t) * (1.0f / 1024.0f) + EPS) + bias; dt[(size_t)t * 16 + fr] = x > 20.f ? x : log1pf(expf(x)); }
    }
}
__device__ __forceinline__ void phase_final(ArgsP a, const float* ssq, const bf16_t* xb) {
    const int lane = otid() & 63, wave = otid() >> 6, gw = blockIdx.x * 8 + wave, NGW = gridDim.x * 8;
    f32x4 g[4];
#pragma unroll
    for (int j = 0; j < 4; ++j) g[j] = *((const f32x4*)a->in[I_NFIN] + lane + 64 * j);
    for (int t = gw; t < T_ALL; t += 4 * NGW) {
        u32x2 q[4][4]; float rs[4];
#pragma unroll
        for (int r = 0; r < 4; ++r) { const int tr = t + r * NGW; rs[r] = rsqrtf(ssq_ld(ssq + tr) * (1.0f / 1024.0f) + EPS);
            const u32x2* xr = (const u32x2*)(xb + (size_t)tr * DM) + lane;
#pragma unroll
            for (int j = 0; j < 4; ++j) q[r][j] = xr[64 * j]; }
#pragma unroll
        for (int r = 0; r < 4; ++r) { f32x4* orow = (f32x4*)(a->out + (size_t)(t + r * NGW) * DM) + lane;
#pragma unroll
            for (int j = 0; j < 4; ++j) orow[64 * j] = (f32x4){bflo(q[r][j].x), bfhi(q[r][j].x), bflo(q[r][j].y), bfhi(q[r][j].y)} * rs[r] * g[j]; }
    }
}
__device__ __forceinline__ void phase_ssm_norm(ArgsP a, int l, bf16_t* buf) {
    const int lane = otid() & 63, wave = otid() >> 6, gw = blockIdx.x * 8 + wave, NGW = gridDim.x * 8;
    const float* gn = a->in[I_SNORM] + l * 512 + lane * 8;
    float g[8];
#pragma unroll
    for (int j = 0; j < 8; ++j) g[j] = gn[j];
    for (int t = gw; t < T_ALL; t += 4 * NGW) {
        u32x4 wv[4];
#pragma unroll
        for (int q = 0; q < 4; ++q) wv[q] = *((const u32x4*)(buf + (size_t)(t + q * NGW) * 512) + lane);
#pragma unroll
        for (int q = 0; q < 4; ++q) { const u32x4 w = wv[q];
            float v[8] = {bflo(w.x), bfhi(w.x), bflo(w.y), bfhi(w.y), bflo(w.z), bfhi(w.z), bflo(w.w), bfhi(w.w)};
            float s = 0.f;
#pragma unroll
            for (int j = 0; j < 8; ++j) s += v[j] * v[j];
            const float rs = rsqrtf(wave_sum(s) * (1.0f / 512.0f) + EPS);
            u32x4 o; o.x = pk2(v[0] * rs * g[0], v[1] * rs * g[1]); o.y = pk2(v[2] * rs * g[2], v[3] * rs * g[3]); o.z = pk2(v[4] * rs * g[4], v[5] * rs * g[5]); o.w = pk2(v[6] * rs * g[6], v[7] * rs * g[7]);
            *((u32x4*)(buf + (size_t)(t + q * NGW) * 512) + lane) = o; }
    }
}
constexpr int SLD = 136;
__device__ __forceinline__ int tsw(int p, int s) { return p * SLD + ((((s >> 3) ^ ((p >> 4) & 7)) << 3) | (s & 7)); }
__device__ __forceinline__ void seq_bounds(int t0, int& lo, int& hi) { if (t0 < TP) { lo = t0 & ~2047; hi = lo + 2048; } else { lo = TP + ((t0 - TP) & ~4095); hi = lo + 4096; } }
__device__ __forceinline__ float silu_f(float x) { return x * __builtin_amdgcn_rcpf(1.0f + __expf(-x)); }

template <int NC, bool TRANS>
__device__ __forceinline__ void load_conv_tile(const bf16_t* src, int ldsrc, int col0, int t0, int lo, int hi, const float* cw, const float* cbias, int ch0, LAS bf16_t* dst) {
    constexpr int CGS = NC / 8, RUNS = 512 / CGS, R = 128 / RUNS;
    const int tid = otid(), cgi = tid % CGS, run = tid / CGS, c = cgi * 8, r0 = run * R;
    float w[5][8], bb[8];
#pragma unroll
    for (int k = 0; k < 5; ++k) { const f32x4 a0 = *(const f32x4*)(cw + k * 1024 + ch0 + c), a1 = *(const f32x4*)(cw + k * 1024 + ch0 + c + 4);
#pragma unroll
        for (int e = 0; e < 4; ++e) { w[k][e] = a0[e]; w[k][4 + e] = a1[e]; } }
    { const f32x4 a0 = *(const f32x4*)(cbias + ch0 + c), a1 = *(const f32x4*)(cbias + ch0 + c + 4);
#pragma unroll
      for (int e = 0; e < 4; ++e) { bb[e] = a0[e]; bb[4 + e] = a1[e]; } }
    u32x4 raw[R + 4];
#pragma unroll
    for (int i = 0; i < R + 4; ++i) { const int t = t0 + r0 - 2 + i, tc = t < lo ? lo : (t >= hi ? hi - 1 : t);
        u32x4 q = *(const u32x4*)(src + (size_t)tc * ldsrc + col0 + c);
        if (t < lo || t >= hi) q = (u32x4){0u, 0u, 0u, 0u};
        raw[i] = q; }
    float win[5][8];
    auto cvrow = [&](const u32x4 q, float (&o)[8]) { o[0] = bflo(q.x); o[1] = bfhi(q.x); o[2] = bflo(q.y); o[3] = bfhi(q.y); o[4] = bflo(q.z); o[5] = bfhi(q.z); o[6] = bflo(q.w); o[7] = bfhi(q.w); };
#pragma unroll
    for (int i = 0; i < 4; ++i) cvrow(raw[i], win[i]);
    unsigned outp[8][R / 2];
#pragma unroll
    for (int rr = 0; rr < R; ++rr) {
        cvrow(raw[rr + 4], win[(rr + 4) % 5]);
        float o[8];
#pragma unroll
        for (int e = 0; e < 8; ++e) { float s = bb[e];
#pragma unroll
            for (int k = 0; k < 5; ++k) s += w[k][e] * win[(rr + k) % 5][e];
            o[e] = silu_f(s); }
        if (!TRANS) { u32x4 q; q.x = pk2(o[0], o[1]); q.y = pk2(o[2], o[3]); q.z = pk2(o[4], o[5]); q.w = pk2(o[6], o[7]); *(LAS u32x4*)(dst + (r0 + rr) * SLD + c) = q; }
        else {
#pragma unroll
            for (int e = 0; e < 8; ++e) { if (rr & 1) outp[e][rr >> 1] = (outp[e][rr >> 1] & 0xffffu) | (pk2(0.f, o[e]) & 0xffff0000u); else outp[e][rr >> 1] = pk2(o[e], 0.f) & 0xffffu; } }
    }
    if (TRANS) {
#pragma unroll
        for (int e = 0; e < 8; ++e) {
            if (R == 8) { u32x4 q; q.x = outp[e][0]; q.y = outp[e][1]; q.z = outp[e][2]; q.w = outp[e][R / 2 - 1]; *(LAS u32x4*)(dst + tsw(c + e, r0)) = q; }
            else { u32x2 q; q.x = outp[e][0]; q.y = outp[e][R / 2 - 1]; *(LAS u32x2*)(dst + tsw(c + e, r0)) = q; }
        }
    }
}
__device__ __forceinline__ void chunk_scan(const float* dt, int t0, int col, float A, int dir, int lane, float& d0, float& d1, float& c0, float& c1, float& total) {
    d0 = dt[(size_t)(t0 + 2 * lane) * 16 + col]; d1 = dt[(size_t)(t0 + 2 * lane + 1) * 16 + col];
    const float a0 = d0 * A, a1 = d1 * A;
    float v = a0 + a1;
#pragma unroll
    for (int d = 1; d < 64; d <<= 1) { const float tt = __shfl_up(v, d); if (lane >= d) v += tt; }
    total = __shfl(v, 63);
    const float p0 = v - a1, p1 = v;
    if (dir == 0) { c0 = p0; c1 = p1; } else { c0 = total - p0 + a0; c1 = total - p1 + a1; }
}
__device__ __forceinline__ bf16x8 scale_frag8(bf16x8 f, const float (&sc)[8]) {
    union { bf16x8 v; unsigned u[4]; } in, out; in.v = f;
#pragma unroll
    for (int j = 0; j < 4; ++j) out.u[j] = pk2(bflo(in.u[j]) * sc[2 * j], bfhi(in.u[j]) * sc[2 * j + 1]);
    return out.v;
}
__device__ __forceinline__ void phase_s1(ArgsP a, int l, int cbase, LAS unsigned char* lds, const bf16_t* xs_raw, const bf16_t* bc_raw, bf16_t* states) {
    const int tid = otid(), lane = tid & 63, wave = __builtin_amdgcn_readfirstlane(tid >> 6);
    LAS bf16_t* xsT = (LAS bf16_t*)lds;
    LAS bf16_t* BT = (LAS bf16_t*)(lds + 256 * SLD * 2);
    LAS float* sW = (LAS float*)(lds + 384 * SLD * 2);
    const float* dt = (const float*)(a->ws + WS_DT); float* decay = (float*)(a->ws + WS_DECAY);
    const float* cw = a->in[I_SCW] + l * 5 * 1024; const float* cbs = a->in[I_SCB] + l * 1024;
    for (int it = blockIdx.x; it < 256; it += gridDim.x) {
        const int gc = cbase + (it >> 1), g = it & 1, t0 = gc * 128; int lo, hi; seq_bounds(t0, lo, hi);
        const int hh = wave >> 1, dir = wave & 1, h8 = g * 4 + hh;
        { float d0, d1, c0, c1, tot; const float A = -__expf(a->in[I_ALOG][l * 16 + dir * 8 + h8]);
          chunk_scan(dt, t0, dir * 8 + h8, A, dir, lane, d0, d1, c0, c1, tot);
          sW[wave * 128 + 2 * lane] = d0 * __expf(tot - c0); sW[wave * 128 + 2 * lane + 1] = d1 * __expf(tot - c1);
          if (lane == 0) decay[gc * 16 + h8 * 2 + dir] = __expf(tot); }
        load_conv_tile<256, true>(xs_raw, 512, g * 256, t0, lo, hi, cw, cbs, g * 256, xsT);
        load_conv_tile<128, true>(bc_raw, 512, g * 128, t0, lo, hi, cw, cbs, 512 + g * 128, BT);
        __syncthreads();
        f32x4 acc[8][4];
#pragma unroll
        for (int i = 0; i < 8; ++i)
#pragma unroll
            for (int j = 0; j < 4; ++j) acc[i][j] = (f32x4){0.f, 0.f, 0.f, 0.f};
        const int fr = lane & 15, fq = lane >> 4;
#pragma unroll 1
        for (int ks = 0; ks < 4; ++ks) {
            const int s0 = ks * 32 + fq * 8;
            float sc[8]; { const f32x4 q0 = *(const LAS f32x4*)(sW + wave * 128 + s0), q1 = *(const LAS f32x4*)(sW + wave * 128 + s0 + 4);
#pragma unroll
                for (int e = 0; e < 4; ++e) { sc[e] = q0[e]; sc[4 + e] = q1[e]; } }
            bf16x8 xf[4];
#pragma unroll
            for (int pt = 0; pt < 4; ++pt) xf[pt] = scale_frag8(*(const LAS bf16x8*)(xsT + tsw(hh * 64 + pt * 16 + fr, s0)), sc);
#pragma unroll
            for (int nt = 0; nt < 8; ++nt) { const bf16x8 bf = *(const LAS bf16x8*)(BT + tsw(32 * (nt >> 1) + 8 * (fr >> 2) + 4 * (nt & 1) + (fr & 3), s0));
#pragma unroll
                for (int pt = 0; pt < 4; ++pt) acc[nt][pt] = __builtin_amdgcn_mfma_f32_16x16x32_bf16(bf, xf[pt], acc[nt][pt], 0, 0, 0); }
        }
        bf16_t* st = states + ((size_t)((gc - cbase) * 8 + h8) * 2 + dir) * 8192;
#pragma unroll
        for (int m = 0; m < 4; ++m)
#pragma unroll
            for (int pt = 0; pt < 4; ++pt) { u32x4 q; q.x = pk2(acc[2 * m][pt][0], acc[2 * m][pt][1]); q.y = pk2(acc[2 * m][pt][2], acc[2 * m][pt][3]); q.z = pk2(acc[2 * m + 1][pt][0], acc[2 * m + 1][pt][1]); q.w = pk2(acc[2 * m + 1][pt][2], acc[2 * m + 1][pt][3]);
                *(u32x4*)(st + (pt * 16 + fr) * 128 + 32 * m + 8 * fq) = q; }
        __syncthreads();
    }
}
__device__ __forceinline__ void phase_s2(ArgsP a, int cbase, bf16_t* states, int dry) {
    const int nseq = cbase == 0 ? 8 : 4, cps = cbase == 0 ? 16 : 32;
    const float* decay = (const float*)(a->ws + WS_DECAY);
    const int total = nseq * 16 * 1024;
    for (int i = blockIdx.x * 512 + otid(); i < total; i += gridDim.x * 512) {
        const int e8 = i & 1023, hd = (i >> 10) & 15, sq = i >> 14, dir = hd & 1;
        float hs[8];
#pragma unroll
        for (int j = 0; j < 8; ++j) hs[j] = 0.f;
#pragma unroll 1
        for (int cc0 = 0; cc0 < cps; cc0 += 8) {
            u32x4 w[8]; float dcv[8]; u32x4* pp[8];
#pragma unroll
            for (int u = 0; u < 8; ++u) { const int cc = cc0 + u, crel = sq * cps + (dir ? cps - 1 - cc : cc);
                pp[u] = (u32x4*)(states + ((size_t)crel * 16 + hd) * 8192) + e8; w[u] = *pp[u]; dcv[u] = decay[(cbase + crel) * 16 + hd]; }
#pragma unroll
            for (int u = 0; u < 8; ++u) { const float dc = dcv[u];
                u32x4 o; o.x = pk2(hs[0], hs[1]); o.y = pk2(hs[2], hs[3]); o.z = pk2(hs[4], hs[5]); o.w = pk2(hs[6], hs[7]); if (!dry) *pp[u] = o;
                hs[0] = hs[0] * dc + bflo(w[u].x); hs[1] = hs[1] * dc + bfhi(w[u].x); hs[2] = hs[2] * dc + bflo(w[u].y); hs[3] = hs[3] * dc + bfhi(w[u].y);
                hs[4] = hs[4] * dc + bflo(w[u].z); hs[5] = hs[5] * dc + bfhi(w[u].z); hs[6] = hs[6] * dc + bflo(w[u].w); hs[7] = hs[7] * dc + bfhi(w[u].w); }
        }
    }
}
__device__ __forceinline__ void phase_s3(ArgsP a, int l, int cbase, LAS unsigned char* lds, const bf16_t* xs_raw, const bf16_t* bc_raw, const bf16_t* states, bf16_t* gate, int dry) {
    const int tid = otid(), lane = tid & 63, wave = __builtin_amdgcn_readfirstlane(tid >> 6), fr = lane & 15, fq = lane >> 4;
    LAS bf16_t* xsT = (LAS bf16_t*)lds;
    LAS bf16_t* sC = (LAS bf16_t*)(lds + 128 * SLD * 2);
    LAS bf16_t* sB = (LAS bf16_t*)(lds + 256 * SLD * 2);
    LAS float* sDt = (LAS float*)(lds + 384 * SLD * 2);
    LAS float* sCs = sDt + 1024;
    const float* dt = (const float*)(a->ws + WS_DT);
    const float* cw = a->in[I_SCW] + l * 5 * 1024; const float* cbs = a->in[I_SCB] + l * 1024;
    for (int it = blockIdx.x; it < 256; it += gridDim.x) {
        const int gc = cbase + (it >> 1), g = it & 1, t0 = gc * 128; int lo, hi; seq_bounds(t0, lo, hi);
        { const int w4 = wave, hh4 = w4 >> 1, dir = w4 & 1, h8 = g * 4 + hh4; float d0, d1, c0, c1, tot; const float A = -__expf(a->in[I_ALOG][l * 16 + dir * 8 + h8]);
          chunk_scan(dt, t0, dir * 8 + h8, A, dir, lane, d0, d1, c0, c1, tot);
          { sDt[w4 * 128 + 2 * lane] = d0; sDt[w4 * 128 + 2 * lane + 1] = d1; sCs[w4 * 128 + 2 * lane] = c0; sCs[w4 * 128 + 2 * lane + 1] = c1; } }
        load_conv_tile<128, false>(bc_raw, 512, g * 128, t0, lo, hi, cw, cbs, 512 + g * 128, sB);
        load_conv_tile<128, false>(bc_raw, 512, 256 + g * 128, t0, lo, hi, cw, cbs, 768 + g * 128, sC);
        __syncthreads();
        {
            f32x4 cacc[8];
#pragma unroll
            for (int i = 0; i < 8; ++i) cacc[i] = (f32x4){0.f, 0.f, 0.f, 0.f};
#pragma unroll
            for (int ks = 0; ks < 4; ++ks) { const bf16x8 cf = *(const LAS bf16x8*)(sC + (wave * 16 + fr) * SLD + ks * 32 + fq * 8);
#pragma unroll
                for (int st = 0; st < 8; ++st) { const bf16x8 bf = *(const LAS bf16x8*)(sB + (st * 16 + fr) * SLD + ks * 32 + fq * 8); cacc[st] = __builtin_amdgcn_mfma_f32_16x16x32_bf16(bf, cf, cacc[st], 0, 0, 0); } }
            __syncthreads();
#pragma unroll
            for (int st = 0; st < 8; ++st) { u32x2 q; q.x = pk2(cacc[st][0], cacc[st][1]); q.y = pk2(cacc[st][2], cacc[st][3]); *(LAS u32x2*)(sB + (wave * 16 + fr) * SLD + st * 16 + fq * 4) = q; }
            __syncthreads();
        }
#pragma unroll 1
        for (int hp = 0; hp < 2; ++hp) {
        load_conv_tile<128, true>(xs_raw, 512, g * 256 + hp * 128, t0, lo, hi, cw, cbs, g * 256 + hp * 128, xsT);
        __syncthreads();
        const int hh2 = wave >> 2, lq = wave & 3, h8 = g * 4 + hp * 2 + hh2;
        const float Dh = a->in[I_SD][l * 8 + h8];
        const int hq = hp * 2 + hh2; const LAS float* dtf = sDt + (hq * 2) * 128; const LAS float* dtb = sDt + (hq * 2 + 1) * 128; const LAS float* csf = sCs + (hq * 2) * 128; const LAS float* csb = sCs + (hq * 2 + 1) * 128;
        f32x4 acc[2][4];
#pragma unroll
        for (int i = 0; i < 2; ++i)
#pragma unroll
            for (int j = 0; j < 4; ++j) acc[i][j] = (f32x4){0.f, 0.f, 0.f, 0.f};
#pragma unroll 1
        for (int ks = 0; ks < 4; ++ks) {
            const int s0 = ks * 32 + fq * 8;
            bf16x8 xf[4];
#pragma unroll
            for (int pt = 0; pt < 4; ++pt) xf[pt] = *(const LAS bf16x8*)(xsT + tsw(hh2 * 64 + 32 * (pt >> 1) + 8 * (fr >> 2) + 4 * (pt & 1) + (fr & 3), s0));
            float vdf[8], vdb[8], vcf[8], vcb[8];
            { const f32x4 q0 = *(const LAS f32x4*)(dtf + s0), q1 = *(const LAS f32x4*)(dtf + s0 + 4), r0 = *(const LAS f32x4*)(dtb + s0), r1 = *(const LAS f32x4*)(dtb + s0 + 4);
              const f32x4 u0 = *(const LAS f32x4*)(csf + s0), u1 = *(const LAS f32x4*)(csf + s0 + 4), w0 = *(const LAS f32x4*)(csb + s0), w1 = *(const LAS f32x4*)(csb + s0 + 4);
#pragma unroll
              for (int e = 0; e < 4; ++e) { vdf[e] = q0[e]; vdf[4 + e] = q1[e]; vdb[e] = r0[e]; vdb[4 + e] = r1[e]; vcf[e] = u0[e]; vcf[4 + e] = u1[e]; vcb[e] = w0[e]; vcb[4 + e] = w1[e]; } }
#pragma unroll
            for (int lt = 0; lt < 2; ++lt) {
                const int lrow = lq * 32 + lt * 16 + fr;
                const float csf_l = csf[lrow], csb_l = csb[lrow];
                const u32x4 cbq = *(const LAS u32x4*)(sB + lrow * SLD + s0);
                const float cbv[8] = {bflo(cbq.x), bfhi(cbq.x), bflo(cbq.y), bfhi(cbq.y), bflo(cbq.z), bfhi(cbq.z), bflo(cbq.w), bfhi(cbq.w)};
                float mv[8];
#pragma unroll
                for (int e = 0; e < 8; ++e) { const int s = s0 + e;
                    const float ex = s < lrow ? csf_l - vcf[e] : csb_l - vcb[e];
                    const float dd = s < lrow ? vdf[e] : vdb[e];
                    float mm = cbv[e] * __expf(ex) * dd;
                    if (s == lrow) mm = cbv[e] * (vdf[e] + vdb[e]) + Dh;
                    mv[e] = mm;
                    }
                union { bf16x8 v; unsigned u[4]; } mf;
#pragma unroll
                for (int j = 0; j < 4; ++j) mf.u[j] = pk2(mv[2 * j], mv[2 * j + 1]);
#pragma unroll
                for (int pt = 0; pt < 4; ++pt) acc[lt][pt] = __builtin_amdgcn_mfma_f32_16x16x32_bf16(xf[pt], mf.v, acc[lt][pt], 0, 0, 0);
            }
        }
#pragma unroll 1
        for (int dir = 0; dir < 2; ++dir) {
            const bf16_t* pv = states + ((size_t)((gc - cbase) * 8 + h8) * 2 + dir) * 8192;
            const LAS float* cs = dir ? csb : csf;
            float el[2];
#pragma unroll
            for (int lt = 0; lt < 2; ++lt) el[lt] = __expf(cs[lq * 32 + lt * 16 + fr]);
#pragma unroll
            for (int ks = 0; ks < 4; ++ks) {
                const int n0 = ks * 32 + fq * 8;
                bf16x8 pf[4];
#pragma unroll
                for (int pt = 0; pt < 4; ++pt) pf[pt] = *(const bf16x8*)(pv + (32 * (pt >> 1) + 8 * (fr >> 2) + 4 * (pt & 1) + (fr & 3)) * 128 + n0);
#pragma unroll
                for (int lt = 0; lt < 2; ++lt) {
                    const float sc[8] = {el[lt], el[lt], el[lt], el[lt], el[lt], el[lt], el[lt], el[lt]};
                    const bf16x8 cf = scale_frag8(*(const LAS bf16x8*)(sC + (lq * 32 + lt * 16 + fr) * SLD + n0), sc);
#pragma unroll
                    for (int pt = 0; pt < 4; ++pt) acc[lt][pt] = __builtin_amdgcn_mfma_f32_16x16x32_bf16(pf[pt], cf, acc[lt][pt], 0, 0, 0);
                }
            }
        }
        u32x4 gqv[2][2];
#pragma unroll
        for (int lt = 0; lt < 2; ++lt)
#pragma unroll
            for (int m = 0; m < 2; ++m) gqv[lt][m] = *(const u32x4*)(gate + (size_t)(t0 + lq * 32 + lt * 16 + fr) * 512 + g * 256 + (hp * 2 + hh2) * 64 + 32 * m + 8 * fq);
#pragma unroll
        for (int lt = 0; lt < 2; ++lt)
#pragma unroll
            for (int m = 0; m < 2; ++m) {
                u32x4* gp = (u32x4*)(gate + (size_t)(t0 + lq * 32 + lt * 16 + fr) * 512 + g * 256 + (hp * 2 + hh2) * 64 + 32 * m + 8 * fq);
                const u32x4 gq = gqv[lt][m]; const f32x4 a0 = acc[lt][2 * m], a1 = acc[lt][2 * m + 1];
                u32x4 o; o.x = pk2(a0[0] * silu_f(bflo(gq.x)), a0[1] * silu_f(bfhi(gq.x))); o.y = pk2(a0[2] * silu_f(bflo(gq.y)), a0[3] * silu_f(bfhi(gq.y)));
                o.z = pk2(a1[0] * silu_f(bflo(gq.z)), a1[1] * silu_f(bfhi(gq.z))); o.w = pk2(a1[2] * silu_f(bflo(gq.w)), a1[3] * silu_f(bfhi(gq.w)));
                if (!dry) *gp = o;
            }
        __syncthreads();
        }
    }
}
__device__ __forceinline__ f32x2 cmul(f32x2 a, f32x2 b) { const f32x2 bx = {b.x, b.x}, by = {b.y, b.y}, ar = {-a.y, a.x}; return a * bx + ar * by; }
__device__ __forceinline__ f32x2 cmulc(f32x2 a, f32x2 b) { const f32x2 bx = {b.x, b.x}, by = {b.y, b.y}, ar = {a.y, -a.x}; return a * bx + ar * by; }
#define DP(e) d[(e) + ((e) >> 4)]
__device__ __forceinline__ f32x2 w16(int k) {
    constexpr float C[8] = {1.f, 0.9238795325112867f, 0.7071067811865476f, 0.3826834323650898f, 0.f, -0.3826834323650898f, -0.7071067811865476f, -0.9238795325112867f};
    constexpr float S[8] = {0.f, 0.3826834323650898f, 0.7071067811865476f, 0.9238795325112867f, 1.f, 0.9238795325112867f, 0.7071067811865476f, 0.3826834323650898f};
    return (f32x2){C[k], -S[k]};
}
__device__ __forceinline__ f32x2 mulw16(f32x2 v, int k) { if (k == 0) return v; if (k == 4) return (f32x2){v.y, -v.x}; return cmul(v, w16(k)); }
__device__ __forceinline__ f32x2 mulw16c(f32x2 v, int k) { if (k == 0) return v; if (k == 4) return (f32x2){-v.y, v.x}; return cmulc(v, w16(k)); }
template <int LOGN, bool FOLD = false, int TPA = 512> __device__ __forceinline__ void fft_fwd(LAS f32x2* d, const LAS f32x2* tw, const int tq) {
    constexpr int N = 1 << LOGN;
    if (LOGN == 13 && !FOLD) {
#pragma unroll
        for (int qi = 0; qi < 8; ++qi) { const int q = tq + 512 * qi; const f32x2 x0 = DP(q), x1 = DP(q + 4096); DP(q) = x0 + x1; DP(q + 4096) = cmul(x0 - x1, tw[q]); }
        __syncthreads();
    }
#pragma unroll 1
    for (int ls = 11; ls >= 7; ls -= 4) {
        const int st = 1 << (ls - 3);
#pragma unroll
        for (int gi = 0; gi < (N / 16 + TPA - 1) / TPA; ++gi) { const int g = tq + TPA * gi;
            if (g < N / 16) {
                const int j = g & (st - 1), blk = g >> (ls - 3), base = (blk << (ls + 1)) + j;
                const f32x2 W1 = tw[j << (12 - ls)], W2 = tw[j << (13 - ls)], W3 = tw[j << (14 - ls)], W4 = tw[j << (15 - ls)];
                f32x2 x[16];
#pragma unroll
                for (int k = 0; k < 16; ++k) x[k] = DP(base + k * st);
#pragma unroll
                for (int k = 0; k < 8; ++k) { const f32x2 a = x[k], b = x[k + 8]; x[k] = a + b; x[k + 8] = cmul(mulw16(a - b, k), W1); }
#pragma unroll
                for (int k = 0; k < 16; ++k) if ((k & 7) < 4) { const f32x2 a = x[k], b = x[k + 4]; x[k] = a + b; x[k + 4] = cmul(mulw16(a - b, 2 * (k & 3)), W2); }
#pragma unroll
                for (int k = 0; k < 16; ++k) if ((k & 3) < 2) { const f32x2 a = x[k], b = x[k + 2]; x[k] = a + b; x[k + 2] = cmul(mulw16(a - b, 4 * (k & 1)), W3); }
#pragma unroll
                for (int k = 0; k < 16; k += 2) { const f32x2 a = x[k], b = x[k + 1]; x[k] = a + b; x[k + 1] = cmul(a - b, W4); }
#pragma unroll
                for (int k = 0; k < 16; ++k) DP(base + k * st) = x[k];
            }
        }
        __syncthreads();
    }
#pragma unroll
    for (int gi = 0; gi < (N / 16 + TPA - 1) / TPA; ++gi) { const int g = tq + TPA * gi;
        if (g < N / 16) {
            f32x2 x[16];
#pragma unroll
            for (int i = 0; i < 16; ++i) x[i] = d[17 * g + i];
#pragma unroll
            for (int i = 0; i < 8; ++i) { const f32x2 a = x[i], b = x[i + 8]; x[i] = a + b; x[i + 8] = mulw16(a - b, i); }
#pragma unroll
            for (int i = 0; i < 16; ++i) if ((i & 7) < 4) { const f32x2 a = x[i], b = x[i + 4]; x[i] = a + b; x[i + 4] = mulw16(a - b, 2 * (i & 3)); }
#pragma unroll
            for (int i = 0; i < 16; ++i) if ((i & 3) < 2) { const f32x2 a = x[i], b = x[i + 2]; x[i] = a + b; x[i + 2] = mulw16(a - b, 4 * (i & 1)); }
#pragma unroll
            for (int i = 0; i < 16; i += 2) { const f32x2 a = x[i], b = x[i + 1]; x[i] = a + b; x[i + 1] = a - b; }
#pragma unroll
            for (int i = 0; i < 16; ++i) d[17 * g + i] = x[i];
        }
    }
    __syncthreads();
}
template <int LOGN, bool FOLD = false, int TPA = 512> __device__ __forceinline__ void fft_inv(LAS f32x2* d, const LAS f32x2* tw, const int tq) {
    constexpr int N = 1 << LOGN;
#pragma unroll
    for (int gi = 0; gi < (N / 16 + TPA - 1) / TPA; ++gi) { const int g = tq + TPA * gi;
        if (g < N / 16) {
            f32x2 x[16];
#pragma unroll
            for (int i = 0; i < 16; ++i) x[i] = d[17 * g + i];
#pragma unroll
            for (int i = 0; i < 16; i += 2) { const f32x2 a = x[i], b = x[i + 1]; x[i] = a + b; x[i + 1] = a - b; }
#pragma unroll
            for (int i = 0; i < 16; ++i) if ((i & 3) < 2) { const f32x2 a = x[i], b = mulw16c(x[i + 2], 4 * (i & 1)); x[i] = a + b; x[i + 2] = a - b; }
#pragma unroll
            for (int i = 0; i < 16; ++i) if ((i & 7) < 4) { const f32x2 a = x[i], b = mulw16c(x[i + 4], 2 * (i & 3)); x[i] = a + b; x[i + 4] = a - b; }
#pragma unroll
            for (int i = 0; i < 8; ++i) { const f32x2 a = x[i], b = mulw16c(x[i + 8], i); x[i] = a + b; x[i + 8] = a - b; }
#pragma unroll
            for (int i = 0; i < 16; ++i) d[17 * g + i] = x[i];
        }
    }
    __syncthreads();
#pragma unroll 1
    for (int ls = 7; ls <= 11; ls += 4) {
        const int st = 1 << (ls - 3);
#pragma unroll
        for (int gi = 0; gi < (N / 16 + TPA - 1) / TPA; ++gi) { const int g = tq + TPA * gi;
            if (g < N / 16) {
                const int j = g & (st - 1), blk = g >> (ls - 3), base = (blk << (ls + 1)) + j;
                const f32x2 W1 = tw[j << (12 - ls)], W2 = tw[j << (13 - ls)], W3 = tw[j << (14 - ls)], W4 = tw[j << (15 - ls)];
                f32x2 x[16];
#pragma unroll
                for (int k = 0; k < 16; ++k) x[k] = DP(base + k * st);
#pragma unroll
                for (int k = 0; k < 16; k += 2) { const f32x2 a = x[k], b = cmulc(x[k + 1], W4); x[k] = a + b; x[k + 1] = a - b; }
#pragma unroll
                for (int k = 0; k < 16; ++k) if ((k & 3) < 2) { const f32x2 a = x[k], b = cmulc(mulw16c(x[k + 2], 4 * (k & 1)), W3); x[k] = a + b; x[k + 2] = a - b; }
#pragma unroll
                for (int k = 0; k < 16; ++k) if ((k & 7) < 4) { const f32x2 a = x[k], b = cmulc(mulw16c(x[k + 4], 2 * (k & 3)), W2); x[k] = a + b; x[k + 4] = a - b; }
#pragma unroll
                for (int k = 0; k < 8; ++k) { const f32x2 a = x[k], b = cmulc(mulw16c(x[k + 8], k), W1); x[k] = a + b; x[k + 8] = a - b; }
#pragma unroll
                for (int k = 0; k < 16; ++k) DP(base + k * st) = x[k];
            }
        }
        __syncthreads();
    }
    if (LOGN == 13 && !FOLD) {
#pragma unroll
        for (int qi = 0; qi < 8; ++qi) { const int q = tq + 512 * qi; const f32x2 u = DP(q), v = cmulc(DP(q + 4096), tw[q]); DP(q) = u + v; DP(q + 4096) = u - v; }
        __syncthreads();
    }
}
constexpr size_t FT_SET0_OFF = (size_t)2 * 512 * 4096;
__device__ __forceinline__ void phase_filter(ArgsP a, int l, LAS unsigned char* lds, float* FT) {
    LAS float* sh = (LAS float*)lds;
    LAS float* sw = (LAS float*)(lds + 64 * 65 * 4);
    const int tid = otid(), lane = tid & 63, wave = tid >> 6;
    const float min_decay = -3.0701134573253944f, max_decay = -15.350567286626972f;
    for (int it = blockIdx.x; it < 1536; it += gridDim.x) {
        const int set = it < 1024 ? 1 : 0, r = set ? it : it - 1024, L = set ? 4096 : 2048, tt0 = (r >> 4) * 64, cc0 = (r & 15) * 64;
        const float* h2 = (const float*)(a->ws + WS_H2) + ((size_t)l * 6144 + (set ? 2048 : 0) + tt0) * 64;
        const float* fw3 = a->in[I_FW3] + (size_t)l * 64 * 1024 + cc0;
        { const int rr = tid >> 3, c8 = (tid & 7) * 8;
          const f32x4 h0 = *(const f32x4*)(h2 + rr * 64 + c8), h1 = *(const f32x4*)(h2 + rr * 64 + c8 + 4);
          const f32x4 w0 = *(const f32x4*)(fw3 + (size_t)rr * 1024 + c8), w1 = *(const f32x4*)(fw3 + (size_t)rr * 1024 + c8 + 4);
#pragma unroll
          for (int e = 0; e < 4; ++e) { sh[rr * 65 + c8 + e] = h0[e]; sh[rr * 65 + c8 + 4 + e] = h1[e]; }
          *(LAS f32x4*)(sw + rr * 64 + c8) = w0; *(LAS f32x4*)(sw + rr * 64 + c8 + 4) = w1; }
        __syncthreads();
        float o[8];
#pragma unroll
        for (int k = 0; k < 8; ++k) o[k] = 0.f;
#pragma unroll 8
        for (int i = 0; i < 64; ++i) { const float hv = sh[lane * 65 + i]; const f32x4 w0 = *(const LAS f32x4*)(sw + i * 64 + wave * 8), w1 = *(const LAS f32x4*)(sw + i * 64 + wave * 8 + 4);
#pragma unroll
            for (int e = 0; e < 4; ++e) { o[e] += hv * w0[e]; o[4 + e] += hv * w1[e]; } }
        const int t = tt0 + lane; const float tl = (float)t / (float)(L - 1);
        float fb[8];
#pragma unroll
        for (int k = 0; k < 8; ++k) fb[k] = a->in[I_FB3][l * 1024 + cc0 + wave * 8 + k];
#pragma unroll
        for (int k = 0; k < 8; ++k) { const int cp = cc0 + wave * 8 + k, dir = cp >> 9, c = cp & 511;
            const float delta = fabsf(min_decay + (float)c * ((max_decay - min_decay) / 511.0f));
            FT[(set ? 0 : FT_SET0_OFF) + ((size_t)dir * 512 + c) * L + t] = (o[k] + fb[k]) * __expf(-tl * delta); }
        __syncthreads();
    }
}
template <int LOGN> __device__ __forceinline__ void hyena_conv_item(ArgsP a, int l, int c, LAS unsigned char* lds, const bf16_t* x1T, bf16_t* vT, const float* FT, int dry) {
    constexpr int N = 1 << LOGN, L = N / 2, SET = (LOGN == 13), NB = SET ? 4 : 8, TOK0 = SET ? TP : 0, TPA = SET ? 512 : 256, NPAR = 512 / TPA, NJ = L / TPA, NK = N / TPA;
    static_assert(NJ == 8 && NK == 16, "shape");
    LAS f32x2* d = (LAS f32x2*)lds;
    LAS f32x2* tw = (LAS f32x2*)(lds + 69632);
    const int tid = otid(), tl = tid % TPA;
    const float* hfT = FT + (SET ? 0 : FT_SET0_OFF) + (size_t)c * L; const float* hbT = hfT + (size_t)512 * L;
#pragma unroll
    for (int j = 0; j < L / 512; ++j) { const int t = tid + 512 * j;
        DP(t) = (f32x2){hfT[t], 0.f};
        if (t >= 1) DP(N - t) = (f32x2){hbT[t], 0.f};
    }
    if (tid == 0) DP(L) = (f32x2){0.f, 0.f};
    __syncthreads();
    fft_fwd<LOGN>(d, tw, tid);
    f32x2 kf[NK];
#pragma unroll
    for (int j = 0; j < NK; ++j) kf[j] = DP(tl + TPA * j) * (1.0f / (float)N);
    __syncthreads();
    const float* cw = a->in[I_HCW] + l * 3 * 1536; const float cb1 = a->in[I_HCB][l * 1536 + 512 + c], cbv = a->in[I_HCB][l * 1536 + 1024 + c];
    const float w10 = cw[512 + c], w11 = cw[1536 + 512 + c], w12 = cw[3072 + 512 + c], wv0 = cw[1024 + c], wv1 = cw[1536 + 1024 + c], wv2 = cw[3072 + 1024 + c];
    const float hbias = a->in[I_HBIAS][l * 512 + c];
    LAS f32x2* const d0 = d; d = d0 + (tid / TPA) * (N + N / 16);
#pragma unroll 1
    for (int bp0 = 0; bp0 < NB / 2; bp0 += NPAR) {
        const int bp = bp0 + tid / TPA;
        const size_t rowA = (size_t)c * T_ALL + TOK0 + (size_t)(2 * bp) * L, rowB = rowA + L;
        float zA[NJ], zB[NJ];
        {
            const int tb = tl * NJ;
            float x1a[NJ + 2], va[NJ + 2], x1b[NJ + 2], vb[NJ + 2];
            auto ldrow = [&](const bf16_t* p, float (&o)[NJ + 2]) {
                const u32x4 q = *(const u32x4*)(p + tb); o[1] = bflo(q.x); o[2] = bfhi(q.x); o[3] = bflo(q.y); o[4] = bfhi(q.y); o[5] = bflo(q.z); o[6] = bfhi(q.z); o[7] = bflo(q.w); o[8] = bfhi(q.w);
                o[0] = tb > 0 ? bf2f(p[tb - 1]) : 0.f; o[NJ + 1] = tb + NJ < L ? bf2f(p[tb + NJ]) : 0.f;
            };
            ldrow(x1T + rowA, x1a); ldrow(vT + rowA, va); ldrow(x1T + rowB, x1b); ldrow(vT + rowB, vb);
#pragma unroll
            for (int jj = 0; jj < NJ; ++jj) {
                zA[jj] = (cb1 + w10 * x1a[jj] + w11 * x1a[jj + 1] + w12 * x1a[jj + 2]) * (cbv + wv0 * va[jj] + wv1 * va[jj + 1] + wv2 * va[jj + 2]);
                zB[jj] = (cb1 + w10 * x1b[jj] + w11 * x1b[jj + 1] + w12 * x1b[jj + 2]) * (cbv + wv0 * vb[jj] + wv1 * vb[jj + 1] + wv2 * vb[jj + 2]);
                const f32x2 zz = {zA[jj], zB[jj]}; DP(tb + jj) = zz; DP(L + tb + jj) = (LOGN == 13) ? cmul(zz, tw[tb + jj]) : (f32x2){0.f, 0.f};
            }
        }
        __syncthreads();
        fft_fwd<LOGN, true, TPA>(d, tw, tl);
#pragma unroll
        for (int j = 0; j < NK; ++j) DP(tl + TPA * j) = cmul(DP(tl + TPA * j), kf[j]);
        __syncthreads();
        fft_inv<LOGN, true, TPA>(d, tw, tl);
        {   const int tb = tl * NJ; unsigned oa[NJ / 2], ob[NJ / 2];
#pragma unroll
            for (int jj = 0; jj < NJ; jj += 2) { f32x2 y0 = DP(tb + jj), y1 = DP(tb + jj + 1);
                if (LOGN == 13) { y0 = y0 + cmulc(DP(L + tb + jj), tw[tb + jj]); y1 = y1 + cmulc(DP(L + tb + jj + 1), tw[tb + jj + 1]); }
                oa[jj / 2] = pk2(y0.x + zA[jj] * hbias, y1.x + zA[jj + 1] * hbias); ob[jj / 2] = pk2(y0.y + zB[jj] * hbias, y1.y + zB[jj + 1] * hbias); }
            if (!dry) { u32x4 qa, qb; qa.x = oa[0]; qa.y = oa[1]; qa.z = oa[2]; qa.w = oa[3]; qb.x = ob[0]; qb.y = ob[1]; qb.z = ob[2]; qb.w = ob[3]; *(u32x4*)(vT + rowA + tb) = qa; *(u32x4*)(vT + rowB + tb) = qb; }
        }
        __syncthreads();
    }
}
__device__ __forceinline__ void phase_hyena_conv(ArgsP a, int l, LAS unsigned char* lds, const bf16_t* x1T, bf16_t* vT, const float* FT, int dry) {
    { LAS f32x2* tw = (LAS f32x2*)(lds + 69632); const f32x2* g = (const f32x2*)(a->ws + WS_TW); for (int i = otid(); i < 4096; i += 512) tw[i] = g[i]; }
    __syncthreads();
    for (int it = blockIdx.x; it < 1024; it += gridDim.x) {
        if (it < 512) hyena_conv_item<13>(a, l, it, lds, x1T, vT, FT, dry);
        else hyena_conv_item<12>(a, l, it - 512, lds, x1T, vT, FT, dry);
    }
}
__device__ __forceinline__ void phase_hyena_norm(ArgsP a, int l, LAS unsigned char* lds, const bf16_t* x0T, const bf16_t* yT, bf16_t* hyn) {
    constexpr int PLD = 513;
    LAS float* P = (LAS float*)lds;
    LAS float* part = (LAS float*)(lds + 64 * PLD * 4);
    const int tid = otid(), lane = tid & 63, wave = tid >> 6, tp = lane & 15, cq = lane >> 4;
    const float* cw = a->in[I_HCW] + l * 3 * 1536; const float* cb = a->in[I_HCB] + l * 1536;
    float hg[8];
#pragma unroll
    for (int j = 0; j < 4; ++j) { hg[2 * j] = a->in[I_HNORM][l * 512 + 2 * lane + 128 * j]; hg[2 * j + 1] = a->in[I_HNORM][l * 512 + 2 * lane + 128 * j + 1]; }
    for (int it = blockIdx.x; it < T_ALL / 64; it += gridDim.x) {
        const int tile0 = it * 64, t = tile0 + 4 * tp; int lo, hi; seq_bounds(tile0, lo, hi);
        const bool hasl = t > lo, hasr = t + 4 < hi;
        float ss0 = 0.f, ss1 = 0.f, ss2 = 0.f, ss3 = 0.f;
#pragma unroll 8
        for (int i = 0; i < 16; ++i) {
            const int c = wave * 64 + 4 * i + cq; const size_t row = (size_t)c * T_ALL;
            const u32x2 xc = *(const u32x2*)(x0T + row + t), yc = *(const u32x2*)(yT + row + t);
            const float xm = hasl ? bf2f(x0T[row + t - 1]) : 0.f, xp = hasr ? bf2f(x0T[row + t + 4]) : 0.f;
            const float x0 = bflo(xc.x), x1 = bfhi(xc.x), x2 = bflo(xc.y), x3 = bfhi(xc.y), w0 = cw[c], w1 = cw[1536 + c], w2 = cw[3072 + c], bb = cb[c];
            const float p0 = (bb + w0 * xm + w1 * x0 + w2 * x1) * bflo(yc.x), p1 = (bb + w0 * x0 + w1 * x1 + w2 * x2) * bfhi(yc.x);
            const float p2 = (bb + w0 * x1 + w1 * x2 + w2 * x3) * bflo(yc.y), p3 = (bb + w0 * x2 + w1 * x3 + w2 * xp) * bfhi(yc.y);
            P[(4 * tp) * PLD + c] = p0; P[(4 * tp + 1) * PLD + c] = p1; P[(4 * tp + 2) * PLD + c] = p2; P[(4 * tp + 3) * PLD + c] = p3;
            ss0 += p0 * p0; ss1 += p1 * p1; ss2 += p2 * p2; ss3 += p3 * p3;
        }
        ss0 += __shfl_xor(ss0, 16); ss1 += __shfl_xor(ss1, 16); ss2 += __shfl_xor(ss2, 16); ss3 += __shfl_xor(ss3, 16);
        ss0 += __shfl_xor(ss0, 32); ss1 += __shfl_xor(ss1, 32); ss2 += __shfl_xor(ss2, 32); ss3 += __shfl_xor(ss3, 32);
        if (lane < 16) { part[wave * 64 + 4 * lane] = ss0; part[wave * 64 + 4 * lane + 1] = ss1; part[wave * 64 + 4 * lane + 2] = ss2; part[wave * 64 + 4 * lane + 3] = ss3; }
        __syncthreads();
#pragma unroll 1
        for (int r = 0; r < 8; ++r) {
            const int tl = wave * 8 + r;
            float s = 0.f;
#pragma unroll
            for (int w = 0; w < 8; ++w) s += part[w * 64 + tl];
            const float rs = rsqrtf(s * (1.0f / 512.0f) + EPS);
            bf16_t* orow = hyn + (size_t)(tile0 + tl) * 512;
#pragma unroll
            for (int j = 0; j < 4; ++j) { const int c = 2 * lane + 128 * j;
                const float v0 = P[tl * PLD + c] * rs * hg[2 * j], v1 = P[tl * PLD + c + 1] * rs * hg[2 * j + 1];
                *(unsigned*)(orow + c) = pk2(v0, v1); }
        }
        __syncthreads();
    }
}
#define XB_TMO      128
#define XB_XCNT(j)  (256  + 64 * (j))
#define XB_XSUB(j)  (1280 + 64 * (j))
#define XB_XGEN(j)  (2304 + 64 * (j))
#define XB_TOP      3328
#define XB_TOPGEN   3392
#define XCD_BAR_WORDS 3456
#define XB_SPIN_CAP (1u << 22)
constexpr size_t WS_BAR = 106 * MiB + 524288;
__device__ __forceinline__ unsigned xb_ld(unsigned* p)              { return __hip_atomic_load(p, __ATOMIC_RELAXED, __HIP_MEMORY_SCOPE_AGENT); }
__device__ __forceinline__ unsigned xb_add(unsigned* p, unsigned v) { return __hip_atomic_fetch_add(p, v, __ATOMIC_RELAXED, __HIP_MEMORY_SCOPE_AGENT); }
__device__ __forceinline__ unsigned xb_xcc_id() { return (unsigned)__builtin_amdgcn_s_getreg((3 << 11) | 20) & 0xFu; }
#define XB_SPIN(cond, bar) do { unsigned _sp = 0; while (cond) { __builtin_amdgcn_s_sleep(1); \
    if ((++_sp & 255u) == 0u) { if (xb_ld(&(bar)[XB_TMO])) break; if (_sp > XB_SPIN_CAP) { atomicAdd(&(bar)[XB_TMO], 1u); break; } } } } while (0)
__device__ __forceinline__ void xcd_barrier_complete(unsigned* bar, unsigned x, unsigned& nloc, unsigned& nx) {
    const unsigned G = gridDim.x;
    unsigned sum, cnt, mine, sp = 0u;
    for (;;) {
        sum = 0u; cnt = 0u; mine = 0u;
#pragma unroll
        for (unsigned j = 0; j < 16; ++j) { const unsigned c = xb_ld(&bar[XB_XCNT(j)]); sum += c; cnt += (c > 0u) ? 1u : 0u; mine = (j == x) ? c : mine; }
        if (sum == G) break;
        __builtin_amdgcn_s_sleep(1);
        if ((++sp & 255u) == 0u) { if (xb_ld(&bar[XB_TMO])) break; if (sp > XB_SPIN_CAP) { atomicAdd(&bar[XB_TMO], 1u); break; } }
    }
    nloc = mine > 0u ? mine : 1u; nx = cnt > 0u ? cnt : 1u;
}
__device__ __forceinline__ void xcd_barrier(unsigned* bar, volatile LAS unsigned* st) {
    asm volatile("s_waitcnt vmcnt(0)" ::: "memory");
    __syncthreads();
    if (threadIdx.x == 0) {
        const unsigned x = xb_xcc_id();
        __builtin_amdgcn_s_waitcnt(0);
        unsigned nloc = st[0], nx = st[1];
        if (nloc == 0u) { xcd_barrier_complete(bar, x, nloc, nx); st[0] = nloc; st[1] = nx; }
        const unsigned old = xb_add(&bar[XB_XSUB(x)], 1u);
        const unsigned gen = old / nloc;
        if (old + 1u == (gen + 1u) * nloc) {
            __builtin_amdgcn_fence(__ATOMIC_RELEASE, "agent");
            asm volatile("s_waitcnt vmcnt(0)" ::: "memory");
            const unsigned og = xb_add(&bar[XB_TOP], 1u);
            const unsigned tg = og / nx;
            if (og + 1u == (tg + 1u) * nx) xb_add(&bar[XB_TOPGEN], 1u);
            else XB_SPIN(xb_ld(&bar[XB_TOPGEN]) == tg, bar);
            __builtin_amdgcn_fence(__ATOMIC_ACQUIRE, "agent");
            xb_add(&bar[XB_XGEN(x)], 1u);
            asm volatile("s_waitcnt vmcnt(0)" ::: "memory");
        } else {
            XB_SPIN(xb_ld(&bar[XB_XGEN(x)]) == gen, bar);
            __builtin_amdgcn_fence(__ATOMIC_ACQUIRE, "agent");
            asm volatile("s_waitcnt vmcnt(0)" ::: "memory");
        }
    }
    __syncthreads();
}
__device__ __forceinline__ void epi_cfg(int st, int gi, int l, unsigned char* ws, float* out, ArgsP a, Epi& E) {
    float* ssq = (float*)(ws + WS_SSQ); bf16_t* xb = (bf16_t*)(ws + WS_XB);
    bf16_t* r1a = (bf16_t*)(ws + WS_R1A); bf16_t* r1b = (bf16_t*)(ws + WS_R1B); bf16_t* r2 = (bf16_t*)(ws + WS_R2); bf16_t* r3 = (bf16_t*)(ws + WS_R3);
    bf16_t* kmat = (bf16_t*)(ws + WS_R4); bf16_t* vtm = (bf16_t*)(ws + WS_R4 + 6 * MiB);
    float* ssq_in = ssq + (size_t)(3 * l) * T_ALL; float* ssq_a = ssq_in + T_ALL; float* ssq_m = ssq_a + T_ALL; float* ssq_n = ssq_m + T_ALL;
    const int half = (st >= 16) ? ((st - 16) >> 1) : 0;
    E.kind = 0; E.O0 = r1a; E.d1 = 0; E.d2 = 0; E.ldc = 1024; E.csplit = 0; E.rsplit = 0; E.ssq = ssq_in; E.psum = (float*)(ws + WS_PSUM); E.row_off = 0; E.SCALE = 0; E.ACT = 0;
    E.X = out; E.rin0 = out; E.rin1 = out + (size_t)TP * DM; E.xb = xb; E.ssq_out = ssq_a; E.rin_bf16 = 0; E.write_x = 1; E.write_xb = 1;
    if (st == 1)       { E.O0 = r1b; E.d1 = r2 - r1b; E.d2 = r3 - r2; E.ldc = 512; E.csplit = 2; E.SCALE = 1; }
    else if (st == 8)  { E.O0 = r2; E.d1 = r1a - r2; E.d2 = r3 - r1a; E.ldc = T_ALL; E.rsplit = 2; E.SCALE = 2; }
    else if (st == 11) { E.kind = 1; E.write_x = 0; E.rin_bf16 = 1; }
    else if (st == 12) {
        if (gi == 0)      { E.SCALE = 1; E.ssq = ssq_a; }
        else              { E.O0 = kmat; }
    }
    else if (st == 13) { E.O0 = r2; E.ACT = 2; }
    else if (st == 14) { E.SCALE = 3; }
    else if (st == 15) { E.kind = 1; E.ssq_out = ssq_m; E.rin_bf16 = 1; E.write_x = 0; }
    else if (st == 16 || st == 18) { E.ldc = 4096; E.SCALE = 1; E.ACT = 1; E.ssq = ssq_m; E.row_off = half * TP; }
    else               { E.kind = 1; E.ssq_out = ssq_n; E.row_off = half * TP; E.rin_bf16 = 1; E.write_x = 0; E.write_xb = 1; }
}
template <int KIND> struct EpiT {
    static constexpr bool PERM = true;
    int st, gi, l; unsigned char* ws; float* out; ArgsP a;
    __device__ __forceinline__ void operator()(const f32x4 (&acc)[2][2][4][2], const pg8::Unit& u, int wr, int wc, int fr, int fq) const {
        int st_ = st; asm volatile("" : "+s"(st_));
        Epi E; epi_cfg(st_, gi, l, ws, out, a, E);
        pg8::Unit uu = u;
        if (st_ == 12 && gi == 1 && u.pm >= 64) { uu.pm = u.pm - 64; E.O0 = (bf16_t*)(ws + WS_R4 + 6 * MiB); E.ldc = 3072; }
        if (KIND == 0) E.bf_path(acc, uu, wr, wc, fr, fq); else E.res_path(acc, uu, wr, wc, fr, fq);
    }
};
#ifdef DBG_SCAN
constexpr size_t WS_FLAG = 106 * MiB + 262144;
__device__ __forceinline__ void dbg_scan(unsigned char* ws, float* out, int ph) {
    int bad = 0;
    const size_t gt = (size_t)blockIdx.x * 512 + otid(), gs = (size_t)gridDim.x * 512;
    { const u32x4* p = (const u32x4*)(ws + 32 * MiB); const size_t n = (70 * MiB) / 16;
      for (size_t i = gt; i < n; i += gs) { const u32x4 w = p[i];
#pragma unroll
          for (int e = 0; e < 4; ++e) { const unsigned x = w[e]; if ((x & 0x7f80u) == 0x7f80u || (x & 0x7f800000u) == 0x7f800000u) bad = 1; } } }
    { const u32x4* p = (const u32x4*)(ws + 111 * MiB); const size_t n = (140 * MiB) / 16;
      for (size_t i = gt; i < n; i += gs) { const u32x4 w = p[i];
#pragma unroll
          for (int e = 0; e < 4; ++e) { const unsigned x = w[e]; if ((x & 0x7f80u) == 0x7f80u || (x & 0x7f800000u) == 0x7f800000u) bad = 1; } } }
    { const u32x4* p = (const u32x4*)(ws + 102 * MiB); const size_t n = (9 * MiB) / 16;
      for (size_t i = gt; i < n; i += gs) { const u32x4 w = p[i];
#pragma unroll
          for (int e = 0; e < 4; ++e) { const unsigned x = w[e]; if ((x & 0x7f800000u) == 0x7f800000u) bad = 1; } } }
    { const u32x4* p = (const u32x4*)out; const size_t n = (128 * MiB) / 16;
      for (size_t i = gt; i < n; i += gs) { const u32x4 w = p[i];
#pragma unroll
          for (int e = 0; e < 4; ++e) { const unsigned x = w[e]; if ((x & 0x7f800000u) == 0x7f800000u) bad = 1; } } }
    if (bad) atomicMax((int*)(ws + WS_FLAG), 100 - (ph + 1));
}
#endif
__global__ __launch_bounds__(512, 2) void mega_fwd(Args a_by_value) {
    extern __shared__ __attribute__((aligned(16))) unsigned char shm[];
    LAS unsigned char* lds = (LAS unsigned char*)shm;
    cg::grid_group grid = cg::this_grid();
    volatile LAS unsigned* xst = (volatile LAS unsigned*)(lds + LDS_BYTES - 16);
    if (threadIdx.x == 0) { xst[0] = 0u; xst[1] = 0u; xst[2] = 0u; xst[3] = 0u; (void)xb_add(&((unsigned*)(a_by_value.ws + WS_BAR))[XB_XCNT(xb_xcc_id())], 1u); }
    __syncthreads();
#ifdef DBG_TIME
    unsigned long long t_sel = 0, t_all = 0;
#endif
#pragma unroll 1
    for (int ph = 0; ph <= 40; ++ph) {
#ifdef DBG_TIME
        const unsigned long long t_begin = __builtin_amdgcn_s_memrealtime();
#endif
        ArgsP a = (ArgsP)__builtin_amdgcn_kernarg_segment_ptr(); asm volatile("" : "+s"(a));
        unsigned char* ws = a->ws; float* out = a->out;
        float* ssq = (float*)(ws + WS_SSQ);
        bf16_t* xb = (bf16_t*)(ws + WS_XB);
        bf16_t* r1a = (bf16_t*)(ws + WS_R1A); bf16_t* r1b = (bf16_t*)(ws + WS_R1B); bf16_t* r2 = (bf16_t*)(ws + WS_R2); bf16_t* r3 = (bf16_t*)(ws + WS_R3);
        bf16_t* kmat = (bf16_t*)(ws + WS_R4); bf16_t* vtm = (bf16_t*)(ws + WS_R4 + 6 * MiB);
        float* psum = (float*)(ws + WS_PSUM);
#ifdef DBG_TIME
        if (ph == 40) { if (blockIdx.x == 0 && threadIdx.x == 0) { *(volatile float*)(ws + 106 * MiB + 262144) = 2.0f * sqrtf((float)t_sel / (float)t_all); __threadfence(); }
            xcd_barrier((unsigned*)(ws + WS_BAR), xst);
            const float cval = *(volatile float*)(ws + 106 * MiB + 262144);
            for (size_t i = (size_t)blockIdx.x * 512 + otid(); i < (size_t)T_ALL * DM; i += (size_t)gridDim.x * 512) out[i] = cval; break; }
#elif defined(DBG_SCAN)
        if (ph == 40) { const int fl = *(volatile int*)(ws + WS_FLAG); const float cval = fl < 0 ? 0.f : sqrtf((float)(100 - fl));
            for (size_t i = (size_t)blockIdx.x * 512 + otid(); i < (size_t)T_ALL * DM; i += (size_t)gridDim.x * 512) out[i] = cval; break; }
#else
        if (ph == 40) { phase_final(a, ssq + (size_t)6 * T_ALL, xb); break; }
#endif
        const int l = ph / 20, st = ph % 20;
        const float* rin0 = l == 0 ? a->in[I_XP] : out; const float* rin1 = l == 0 ? a->in[I_XS] : out + (size_t)TP * DM;
        float* ssq_in = ssq + (size_t)(3 * l) * T_ALL; float* ssq_a = ssq_in + T_ALL; float* ssq_m = ssq_a + T_ALL; float* ssq_n = ssq_m + T_ALL;
#ifndef PH_LIMIT
#define PH_LIMIT 100
#endif
        const bool is_gemm = (st == 1 || st == 8 || (st >= 11 && st <= 19));
        if (ph >= PH_LIMIT) {}
        else if (st == 0) {
#ifdef DUP_MISC
            if (l == 0) phase_prologue(a, lds); phase_wconv(a, l, lds); __syncthreads();
#endif
            if (l == 0) phase_prologue(a, lds); phase_wconv(a, l, lds); }
        else if (is_gemm) {
            const int ng = (st == 12) ? 2 : 1;
#pragma unroll 1
            for (int gi = 0; gi < ng; ++gi) {
                int nM = 128, nN = 4, mode = 0, lda = 1024, ldb = 1024, K = 1024, ks_shift = 30; size_t seg = 0;
                const void* A = xb; const void* B = ws + WS_WQ;
                const int half = (st >= 16) ? ((st - 16) >> 1) : 0;
                if (st == 1)       { nN = 6; B = ws + WS_WSSM; }
                else if (st == 8)  { nM = 6; nN = 128; A = ws + WS_WHY; B = xb; }
                else if (st == 11) { A = r1a; lda = 512; ks_shift = 3; seg = (size_t)(WS_R1B - WS_R1A); B = ws + WS_WOUT; }
                else if (st == 12) {
                    if (gi == 1)      { nM = 12; nN = 8; mode = 3; A = ws + WS_MEMB; B = ws + WS_WK; }
                }
                else if (st == 13) { mode = 1; K = 256; A = r1a; B = kmat; }
                else if (st == 14) { mode = 2; K = 256; A = r2; B = vtm; ldb = 3072; }
                else if (st == 15) { A = r1a; B = ws + WS_WO; }
                else if (st == 16 || st == 18) { nM = 64; nN = 16; A = xb + (size_t)half * TP * DM; B = ws + WS_WUP; }
                else               { nM = 64; A = r1a; lda = 4096; ldb = 4096; K = 4096; B = ws + WS_WDOWN; }
                pg8::Sched S; S.init(nM, nN, mode, A, lda, B, ldb);
                if (mode == 3) { S.A2 = (const char*)(ws + WS_WV); S.B2 = (const char*)(ws + WS_MEMB); }
                const pg8::Gemm g{lda, ldb, K, ks_shift, seg};
                const bool resid = (st == 11 || st == 15 || st == 17 || st == 19);
                if (!resid) { const EpiT<0> EK{st, gi, l, ws, out, a}; pg8::gemm_phase(lds, g, S, EK);
#ifdef DUP_GEMM
                    pg8::gemm_phase(lds, g, S, EK);
#endif
#ifdef DUP_ATT
                    if (st == 13 || st == 14) pg8::gemm_phase(lds, g, S, EK);
#endif
#ifdef DUP_WIN
                    if (st == 1 || st == 8) pg8::gemm_phase(lds, g, S, EK);
#endif
                } else { const EpiT<1> EK{st, gi, l, ws, out, a}; pg8::gemm_phase(lds, g, S, EK); }
            }
#ifdef DUP_MISC
            if (st == 1) phase_dt(a, l, xb, ssq_in);
#endif
            if (st == 1) phase_dt(a, l, xb, ssq_in);
            if (st == 8) { phase_ssm_norm(a, l, r1b); phase_filter(a, l, lds, (float*)kmat); }
        }
        else if (st == 2 || st == 5) {
#ifdef DUP_SSD
            phase_s1(a, l, st == 2 ? 0 : 128, lds, r2, r3, r1a); __syncthreads();
#endif
            phase_s1(a, l, st == 2 ? 0 : 128, lds, r2, r3, r1a); }
        else if (st == 3 || st == 6) {
#ifdef DUP_SSD
            { int dry = 1; asm volatile("" : "+s"(dry)); phase_s2(a, st == 3 ? 0 : 128, r1a, dry); }
#endif
            int dry = 0; asm volatile("" : "+s"(dry)); phase_s2(a, st == 3 ? 0 : 128, r1a, dry); }
        else if (st == 4 || st == 7) {
#ifdef DUP_SSD
            { int dry = 1; asm volatile("" : "+s"(dry)); phase_s3(a, l, st == 4 ? 0 : 128, lds, r2, r3, r1a, r1b, dry); __syncthreads(); }
#endif
            int dry = 0; asm volatile("" : "+s"(dry)); phase_s3(a, l, st == 4 ? 0 : 128, lds, r2, r3, r1a, r1b, dry); }
        else if (st == 9) {
#ifdef DUP_FFT
            { int dry = 1; asm volatile("" : "+s"(dry)); phase_hyena_conv(a, l, lds, r1a, r3, (const float*)kmat, dry); __syncthreads(); }
#endif
            int dry = 0; asm volatile("" : "+s"(dry)); phase_hyena_conv(a, l, lds, r1a, r3, (const float*)kmat, dry); }
        else if (st == 10) {
#ifdef DUP_MISC
            phase_hyena_norm(a, l, lds, r2, r3, r1a); __syncthreads();
#endif
            phase_hyena_norm(a, l, lds, r2, r3, r1a); }
        if (ph == 0) grid.sync(); else xcd_barrier((unsigned*)(ws + WS_BAR), xst);
#ifdef DBG_TIME
        { const unsigned long long dt_ = __builtin_amdgcn_s_memrealtime() - t_begin; t_all += dt_;
          const int grp = st == 0 ? 0 : (st == 2 || st == 5) ? 1 : (st == 3 || st == 6) ? 2 : (st == 4 || st == 7) ? 3 : st == 9 ? 4 : st == 10 ? 5 : (st == 1 || st == 8) ? 6 : (st == 16 || st == 18) ? 8 : (st == 17 || st == 19) ? 9 : 7;
          if (grp == DBG_TIME) t_sel += dt_; }
#endif
#ifdef DBG_SCAN
#if !defined(S3_PROBE) && !defined(S3_PROBE2)
        dbg_scan(ws, out, ph); grid.sync();
#endif
#endif
    }
}

#include <cstdio>
extern "C" void kernel_launch(void* const* d_in, const int* in_sizes, int n_in, void* d_out, int out_size, void* d_ws, size_t ws_size, hipStream_t stream) {
    static int grid = 0;
    if (grid == 0) {
        int dev = 0, cus = 0, per_cu = 0;
        if (n_in != 33 || ws_size < WS_END || out_size != T_ALL * DM) { fprintf(stderr, "kernel_launch: unexpected shapes (n_in %d, ws %zu, out %d)\n", n_in, ws_size, out_size); grid = -1; return; }
        (void)hipGetDevice(&dev); (void)hipDeviceGetAttribute(&cus, hipDeviceAttributeMultiprocessorCount, dev);
        if (hipFuncSetAttribute((const void*)mega_fwd, hipFuncAttributeMaxDynamicSharedMemorySize, LDS_BYTES) != hipSuccess) { fprintf(stderr, "kernel_launch: hipFuncSetAttribute failed\n"); grid = -1; return; }
        if (hipOccupancyMaxActiveBlocksPerMultiprocessor(&per_cu, (const void*)mega_fwd, 512, LDS_BYTES) != hipSuccess || per_cu < 1) { fprintf(stderr, "kernel_launch: occupancy query gives %d\n", per_cu); (void)hipGetLastError(); grid = -1; return; }
        grid = cus;
    }
    if (grid < 0) return;
#ifdef DBG_SCAN
    (void)hipMemsetAsync(d_ws, 0xAA, WS_END, stream); (void)hipMemsetAsync(d_out, 0xAA, (size_t)T_ALL * DM * 4, stream);
#endif
    (void)hipMemsetAsync((unsigned char*)d_ws + WS_BAR, 0, XCD_BAR_WORDS * 4, stream);
    Args a{};
    for (int i = 0; i < 33; ++i) a.in[i] = (const float*)d_in[i];
    a.out = (float*)d_out; a.ws = (unsigned char*)d_ws;
    void* args[] = {&a};
    hipError_t e = hipLaunchCooperativeKernel((const void*)mega_fwd, dim3(grid), dim3(512), args, LDS_BYTES, stream);
    if (e != hipSuccess) fprintf(stderr, "cooperative launch failed: %s (grid %d)\n", hipGetErrorString(e), grid);
}
```
